# Optimizing an MI355X kernel written in HIP

```python
import jax, jax.numpy as jnp
from jax import lax
import numpy as np

D_MODEL = 1024
BATCH = 8
SEQ = 2048
DEPTH = 2
DEC_BATCH = 32
DEC_SEQ = 1
PAST_LEN = 8192
PAGE_SIZE = 128

N_EVEN = (DEPTH + 1) // 2
N_ODD = DEPTH // 2
SB_HEADS = 8
SB_HEAD_DIM = 64
SB_WIDTH = SB_HEADS * SB_HEAD_DIM
SB_BLOCK = 128
SB_BIAS_INIT = -6.0
SSD_HEADS = 8
SSD_HEAD_DIM = 64
SSD_WIDTH = SSD_HEADS * SSD_HEAD_DIM
SSD_STATE = 128
SSD_GROUPS = 2
SSD_CONV = 4
SSD_CONV_CH = SSD_WIDTH + 2 * SSD_GROUPS * SSD_STATE
SSD_CHUNK = 128
EVEN_IN = 3 * SB_WIDTH + SSD_WIDTH + SSD_CONV_CH + SSD_HEADS
EVEN_MIX = SB_WIDTH + SSD_WIDTH
HG_EXPAND = 128
HG_HEADS = D_MODEL // HG_EXPAND
HG_KEY = HG_EXPAND
HG_VAL = D_MODEL // HG_HEADS
HG_WIDTH = HG_HEADS * HG_KEY
HG_VWIDTH = HG_HEADS * HG_VAL
HG_CHUNK = 32
ODD_IN = 2 * HG_WIDTH + 2 * HG_VWIDTH
D_FF = 4 * D_MODEL
EPS = 1e-6

kernel_name = 'hybrid_stickbreak_ssd_hgrn2_step'


def _split(a, sizes):
    idx, acc = [], 0
    for s in sizes[:-1]:
        acc += s
        idx.append(acc)
    return jnp.split(a, idx, axis=-1)


def rmsnorm(x, w):
    xf = x.astype(jnp.float32)
    y = xf * lax.rsqrt(jnp.mean(xf * xf, axis=-1, keepdims=True) + EPS)
    return (y * w.astype(jnp.float32)).astype(x.dtype)


def sq_relu_mlp(h, w1, w2):
    return jnp.square(jax.nn.relu(h @ w1)) @ w2


def _pad_time(a, pad):
    return jnp.pad(a, [(0, 0), (0, pad)] + [(0, 0)] * (a.ndim - 2))


def stick_breaking(q, k, v, bias):
    bsz, tq, nh, dh = q.shape
    tk = k.shape[1]
    q_off = tk - tq
    qb = min(SB_BLOCK, tq)
    nb = -(-tq // qb)
    pad = nb * qb - tq
    qblocks = jnp.moveaxis(_pad_time(q, pad).reshape(bsz, nb, qb, nh, dh), 1, 0)
    kpos = jnp.arange(tk)
    v32 = v.astype(jnp.float32)
    scale = dh ** -0.5
    b32 = bias.astype(jnp.float32)[None, :, None, None]

    def block(args):
        qblk, bi = args
        qpos = q_off + bi * qb + jnp.arange(qb)
        mask = kpos[None, :] < qpos[:, None]
        z = jnp.einsum('bqhd,bkhd->bhqk', qblk, k).astype(jnp.float32) * scale + b32
        log_1m = jnp.where(mask, jax.nn.log_sigmoid(-z), 0.0)
        rem = lax.cumsum(log_1m, axis=3, reverse=True) - log_1m
        w = jnp.where(mask, jnp.exp(jax.nn.log_sigmoid(z) + rem), 0.0)
        return jnp.einsum('bhqk,bkhd->bqhd', w, v32)

    out = lax.map(block, (qblocks, jnp.arange(nb)))
    return jnp.moveaxis(out, 0, 1).reshape(bsz, nb * qb, nh, dh)[:, :tq]


def causal_conv(xbc, conv_state, w, b):
    full = jnp.concatenate([conv_state.astype(xbc.dtype), xbc], axis=1)
    out = lax.conv_general_dilated(full, w[:, None, :].astype(full.dtype), window_strides=(1,),
                                   padding='VALID', dimension_numbers=('NWC', 'WIO', 'NWC'),
                                   feature_group_count=full.shape[-1])
    return out + b.astype(out.dtype), full[:, full.shape[1] - (SSD_CONV - 1):]


def ssd_chunked(x, dt, a, bm, cm, h0):
    bsz, t, nh, hp = x.shape
    rep = nh // bm.shape[2]
    bh = jnp.repeat(bm, rep, axis=2).astype(jnp.float32)
    ch = jnp.repeat(cm, rep, axis=2).astype(jnp.float32)
    L = min(SSD_CHUNK, t)
    nc = -(-t // L)
    pad = nc * L - t
    xc = _pad_time(x.astype(jnp.float32), pad).reshape(bsz, nc, L, nh, hp)
    dtc = _pad_time(dt, pad).reshape(bsz, nc, L, nh)
    bh = _pad_time(bh, pad).reshape(bsz, nc, L, nh, -1)
    ch = _pad_time(ch, pad).reshape(bsz, nc, L, nh, -1)
    cum = jnp.cumsum(dtc * a, axis=2)
    tri = jnp.arange(L)[:, None] >= jnp.arange(L)[None, :]
    seg = cum[:, :, :, None, :] - cum[:, :, None, :, :]
    decay = jnp.exp(jnp.where(tri[None, None, :, :, None], seg, -jnp.inf))
    scores = jnp.einsum('bcthn,bcshn->bctsh', ch, bh) * decay * dtc[:, :, None]
    y_intra = jnp.einsum('bctsh,bcshp->bcthp', scores, xc)
    last = cum[:, :, -1]
    wst = jnp.exp(last[:, :, None] - cum) * dtc
    chunk_states = jnp.einsum('bclhn,bclh,bclhp->bchpn', bh, wst, xc)

    def step(h, inp):
        st, dl = inp
        return jnp.exp(dl)[:, :, None, None] * h + st, h

    h_t, h_in = lax.scan(step, h0.astype(jnp.float32),
                         (jnp.moveaxis(chunk_states, 1, 0), jnp.moveaxis(last, 1, 0)))
    h_in = jnp.moveaxis(h_in, 0, 1)
    y_inter = jnp.einsum('bclhn,bchpn,bclh->bclhp', ch, h_in, jnp.exp(cum))
    y = (y_intra + y_inter).reshape(bsz, nc * L, nh, hp)[:, :t]
    return y, h_t


def hgrn2_chunked(q, log_f, k_in, v, s0):
    bsz, t, nh, _ = q.shape
    L = min(HG_CHUNK, t)
    nc = -(-t // L)
    pad = nc * L - t

    def chunks(a):
        a = _pad_time(a.astype(jnp.float32), pad)
        return jnp.moveaxis(a.reshape(bsz, nc, L, nh, a.shape[-1]), 1, 0)

    tri = jnp.arange(L)[:, None] >= jnp.arange(L)[None, :]

    def step(s, inp):
        qc, gc, kc, vc = inp
        b = jnp.cumsum(gc, axis=1)
        o_inter = jnp.einsum('blhk,bhkv->blhv', qc * jnp.exp(b), s)
        diff = b[:, :, None] - b[:, None, :]
        decay = jnp.exp(jnp.where(tri[None, :, :, None, None], diff, -jnp.inf))
        att = jnp.einsum('bthk,btshk,bshk->bths', qc, decay, kc)
        o_intra = jnp.einsum('bths,bshv->bthv', att, vc)
        b_last = b[:, -1]
        s_new = jnp.exp(b_last)[..., None] * s + jnp.einsum(
            'bshk,bshv->bhkv', jnp.exp(b_last[:, None] - b) * kc, vc)
        return s_new, o_inter + o_intra

    s_t, o = lax.scan(step, s0.astype(jnp.float32), (chunks(q), chunks(log_f), chunks(k_in), chunks(v)))
    o = jnp.moveaxis(o, 0, 1).reshape(bsz, nc * L, nh, v.shape[-1])[:, :t]
    return o, s_t


def even_mixer(h, past_k, past_v, conv_state, ssm_state, w_in, sb_bias, conv_w, conv_b, dt_bias,
               a_log, d_skip, ssd_norm, w_out):
    bsz, t, _ = h.shape
    q, k, v, z, xbc, dt_raw = _split(h @ w_in, [SB_WIDTH] * 3 + [SSD_WIDTH, SSD_CONV_CH, SSD_HEADS])
    q = q.reshape(bsz, t, SB_HEADS, SB_HEAD_DIM)
    k = k.reshape(bsz, t, SB_HEADS, SB_HEAD_DIM)
    v = v.reshape(bsz, t, SB_HEADS, SB_HEAD_DIM)
    if past_k is None:
        keys, vals = k, v
    else:
        keys = jnp.concatenate([past_k.astype(k.dtype), k], axis=1)
        vals = jnp.concatenate([past_v.astype(v.dtype), v], axis=1)
    o_sb = stick_breaking(q, keys, vals, sb_bias).reshape(bsz, t, SB_WIDTH)
    xbc, new_conv = causal_conv(xbc, conv_state, conv_w, conv_b)
    xbc = jax.nn.silu(xbc)
    xs, bm, cm = _split(xbc, [SSD_WIDTH, SSD_GROUPS * SSD_STATE, SSD_GROUPS * SSD_STATE])
    xs = xs.reshape(bsz, t, SSD_HEADS, SSD_HEAD_DIM)
    bm = bm.reshape(bsz, t, SSD_GROUPS, SSD_STATE)
    cm = cm.reshape(bsz, t, SSD_GROUPS, SSD_STATE)
    dt = jax.nn.softplus(dt_raw.astype(jnp.float32) + dt_bias.astype(jnp.float32))
    a = -jnp.exp(a_log.astype(jnp.float32))
    y, new_ssm = ssd_chunked(xs, dt, a, bm, cm, ssm_state)
    y = y + d_skip.astype(jnp.float32)[:, None] * xs.astype(jnp.float32)
    y = rmsnorm(y.reshape(bsz, t, SSD_WIDTH) * jax.nn.silu(z.astype(jnp.float32)), ssd_norm)
    out = jnp.concatenate([o_sb.astype(y.dtype), y], axis=-1).astype(h.dtype) @ w_out
    return out, k, v, new_conv, new_ssm


def odd_mixer(h, state, lb, w_in, hg_norm, w_out):
    bsz, t, _ = h.shape
    q, fpre, inp, g = _split(h @ w_in, [HG_WIDTH, HG_WIDTH, HG_VWIDTH, HG_VWIDTH])
    lb = lb.reshape(HG_HEADS, HG_KEY)
    fpre = fpre.astype(jnp.float32).reshape(bsz, t, HG_HEADS, HG_KEY)
    log_f = jnp.logaddexp(jnp.log(lb), jnp.log1p(-lb) + jax.nn.log_sigmoid(fpre))
    k_in = (1.0 - lb) * jax.nn.sigmoid(-fpre)
    o, new_state = hgrn2_chunked(q.reshape(bsz, t, HG_HEADS, HG_KEY), log_f, k_in,
                                 inp.reshape(bsz, t, HG_HEADS, HG_VAL), state)
    o = rmsnorm(o.reshape(bsz, t, HG_VWIDTH), hg_norm) * jax.nn.silu(g.astype(jnp.float32))
    return o.astype(h.dtype) @ w_out, new_state


def setup_inputs(seed: int = 0) -> dict:
    key = jax.random.key(seed)
    ks = jax.random.split(key, 32)
    f32 = jnp.float32
    n_pages = PAST_LEN // PAGE_SIZE
    n_used = DEC_BATCH * n_pages
    n_phys = n_used + (n_used + 3) // 4

    def nrm(k, shape, scale):
        return jax.random.normal(k, shape, f32) * scale

    dt0 = jnp.exp(jax.random.uniform(ks[13], (N_EVEN, SSD_HEADS), f32, np.log(1e-3), np.log(1e-1)))
    return {
        'x_prompt': nrm(ks[0], (BATCH, SEQ, D_MODEL), 1.0),
        'x_sample': nrm(ks[1], (DEC_BATCH, DEC_SEQ, D_MODEL), 1.0),
        'cache_k': nrm(ks[2], (N_EVEN, n_phys, PAGE_SIZE, SB_HEADS, SB_HEAD_DIM), 1.0),
        'cache_v': nrm(ks[3], (N_EVEN, n_phys, PAGE_SIZE, SB_HEADS, SB_HEAD_DIM), 1.0),
        'page_table': jax.random.permutation(ks[4], n_phys)[:n_used].reshape(DEC_BATCH, n_pages).astype(jnp.int32),
        'state_conv': nrm(ks[5], (N_EVEN, DEC_BATCH, SSD_CONV - 1, SSD_CONV_CH), 1.0),
        'state_ssm': nrm(ks[6], (N_EVEN, DEC_BATCH, SSD_HEADS, SSD_HEAD_DIM, SSD_STATE), 0.1),
        'state_hgrn': nrm(ks[7], (N_ODD, DEC_BATCH, HG_HEADS, HG_KEY, HG_VAL), 0.5),
        'norm_mix': 1.0 + nrm(ks[8], (DEPTH, D_MODEL), 0.02),
        'norm_ffn': 1.0 + nrm(ks[9], (DEPTH, D_MODEL), 0.02),
        'norm_final': 1.0 + nrm(ks[10], (D_MODEL,), 0.02),
        'w_in_even': nrm(ks[11], (N_EVEN, D_MODEL, EVEN_IN), D_MODEL ** -0.5),
        'sb_bias': SB_BIAS_INIT + nrm(ks[25], (N_EVEN, SB_HEADS), 0.5),
        'conv_w': nrm(ks[12], (N_EVEN, SSD_CONV, SSD_CONV_CH), SSD_CONV ** -0.5),
        'conv_b': nrm(ks[14], (N_EVEN, SSD_CONV_CH), 0.01),
        'dt_bias': dt0 + jnp.log(-jnp.expm1(-dt0)),
        'a_log': jnp.log(jax.random.uniform(ks[15], (N_EVEN, SSD_HEADS), f32, 1.0, 16.0)),
        'd_skip': 1.0 + nrm(ks[16], (N_EVEN, SSD_HEADS), 0.1),
        'ssd_norm': 1.0 + nrm(ks[17], (N_EVEN, SSD_WIDTH), 0.02),
        'w_out_even': nrm(ks[18], (N_EVEN, EVEN_MIX, D_MODEL), EVEN_MIX ** -0.5),
        'w_in_odd': nrm(ks[19], (N_ODD, D_MODEL, ODD_IN), D_MODEL ** -0.5),
        'hg_lb_raw': nrm(ks[20], (DEPTH, HG_WIDTH), 0.1),
        'hg_norm': 1.0 + nrm(ks[21], (N_ODD, HG_VWIDTH), 0.02),
        'w_out_odd': nrm(ks[22], (N_ODD, HG_VWIDTH, D_MODEL), HG_VWIDTH ** -0.5),
        'w_ff1': nrm(ks[23], (DEPTH, D_MODEL, D_FF), D_MODEL ** -0.5),
        'w_ff2': nrm(ks[24], (DEPTH, D_FF, D_MODEL), D_FF ** -0.5),
    }


def reference(x_prompt, x_sample, cache_k, cache_v, page_table, state_conv, state_ssm, state_hgrn,
              norm_mix, norm_ffn, norm_final, w_in_even, sb_bias, conv_w, conv_b, dt_bias, a_log,
              d_skip, ssd_norm, w_out_even, w_in_odd, hg_lb_raw, hg_norm, w_out_odd, w_ff1, w_ff2):
    p = jax.nn.softmax(hg_lb_raw.astype(jnp.float32), axis=0)
    lb_all = jnp.cumsum(p, axis=0) - p[0]
    n_seq, n_pages = page_table.shape
    hp, hs = x_prompt, x_sample
    bp = hp.shape[0]
    kp_l, vp_l, ks_l, vs_l, cp_l, cs_l, sp_l, ss_l, gp_l, gs_l = [], [], [], [], [], [], [], [], [], []
    for layer in range(DEPTH):
        li = layer // 2
        if layer % 2 == 0:
            wts = (w_in_even[li], sb_bias[li], conv_w[li], conv_b[li], dt_bias[li], a_log[li],
                   d_skip[li], ssd_norm[li], w_out_even[li])
            past_k = cache_k[li][page_table].reshape(n_seq, n_pages * PAGE_SIZE, SB_HEADS, SB_HEAD_DIM)
            past_v = cache_v[li][page_table].reshape(n_seq, n_pages * PAGE_SIZE, SB_HEADS, SB_HEAD_DIM)
            mp, kp, vp, cp, sp = even_mixer(
                rmsnorm(hp, norm_mix[layer]), None, None,
                jnp.zeros((bp, SSD_CONV - 1, SSD_CONV_CH), hp.dtype),
                jnp.zeros((bp, SSD_HEADS, SSD_HEAD_DIM, SSD_STATE), jnp.float32), *wts)
            ms, ks_, vs_, cs, ss = even_mixer(
                rmsnorm(hs, norm_mix[layer]), past_k, past_v, state_conv[li], state_ssm[li], *wts)
            kp_l.append(kp); vp_l.append(vp); ks_l.append(ks_); vs_l.append(vs_)
            cp_l.append(cp); cs_l.append(cs); sp_l.append(sp); ss_l.append(ss)
        else:
            wts = (lb_all[layer], w_in_odd[li], hg_norm[li], w_out_odd[li])
            mp, gp = odd_mixer(rmsnorm(hp, norm_mix[layer]),
                               jnp.zeros((bp, HG_HEADS, HG_KEY, HG_VAL), jnp.float32), *wts)
            ms, gs = odd_mixer(rmsnorm(hs, norm_mix[layer]), state_hgrn[li], *wts)
            gp_l.append(gp); gs_l.append(gs)
        hp = hp + mp.astype(hp.dtype)
        hs = hs + ms.astype(hs.dtype)
        hp = hp + sq_relu_mlp(rmsnorm(hp, norm_ffn[layer]), w_ff1[layer], w_ff2[layer]).astype(hp.dtype)
        hs = hs + sq_relu_mlp(rmsnorm(hs, norm_ffn[layer]), w_ff1[layer], w_ff2[layer]).astype(hs.dtype)
    y_prompt = rmsnorm(hp, norm_final)
    y_sample = rmsnorm(hs, norm_final)
    return (y_prompt, y_sample, jnp.stack(kp_l), jnp.stack(vp_l), jnp.stack(ks_l), jnp.stack(vs_l),
            jnp.stack(cp_l), jnp.stack(cs_l), jnp.stack(sp_l), jnp.stack(ss_l),
            jnp.stack(gp_l), jnp.stack(gs_l))
```

```cpp
#include <hip/hip_runtime.h>
#include <cstdio>
#include <cstdint>
namespace pg8 {
#define PG8_LAS __attribute__((address_space(3)))
typedef unsigned short bf16_t;
typedef short bf16x8 __attribute__((ext_vector_type(8)));
typedef float f32x4 __attribute__((ext_vector_type(4)));
typedef unsigned u32x4 __attribute__((ext_vector_type(4)));
constexpr int BM = 256, BK = 64, HALF = 128, HTB = HALF * BK * 2  , STAGE_BYTES = 8 * HTB, NXCD = 8, WGM = 8;

__host__ __device__ __forceinline__ int lds_byte(int r, int c) { const int st = (r >> 4) * 2 + (c >> 5), rr = r & 15, cc = c & 31, ob = rr * 64 + cc * 2; return st * 1024 + (ob ^ (((ob >> 9) & 1) << 5)); }
__host__ __device__ __forceinline__ void stage_rc(int b, int& R, int& C) { const int st = b / 1024, sb = b % 1024, swz = sb ^ (((sb >> 9) & 1) << 5); R = (st >> 1) * 16 + swz / 64; C = (st & 1) * 32 + (swz % 64) / 2; }
__host__ __device__ __forceinline__ int perm32(int rho) { const int n = rho >> 4, i = rho & 15; return 8 * (i >> 2) + 4 * n + (i & 3); }

struct Unit { int pm, pn; };
struct Gemm { const bf16_t* A; const bf16_t* Bt; int M, N, K; };

struct StaticOrder {
    int nM, nN, nwg, G, c;
    __host__ __device__ void init(int M, int N, int G_, int c_) { nM = M / BM; nN = N / BM; nwg = nM * nN; G = G_; c = c_; }
    __host__ __device__ bool next(int i, Unit& u) const {
        const long L = (long)i * G + c; if (L >= nwg) return false;
        int wgid = (int)L; { const int q = nwg / NXCD, r = nwg % NXCD, xcd = wgid % NXCD, off = wgid / NXCD; wgid = (xcd < r ? xcd * (q + 1) : r * (q + 1) + (xcd - r) * q) + off; }
        const int nig = WGM * nN, gid = wgid / nig, fm = gid * WGM, gsz = (nM - fm) < WGM ? (nM - fm) : WGM;
        u.pm = fm + ((wgid % nig) % gsz); u.pn = (wgid % nig) / gsz; return true;
    }
    __device__ __forceinline__ void a_ready(const Unit&) const {}
    __device__ __forceinline__ void done(const Unit&) const {}
};

__device__ __forceinline__ unsigned cvt_pk_bf16(float lo, float hi) { unsigned r; asm volatile("v_cvt_pk_bf16_f32 %0, %1, %2" : "=v"(r) : "v"(lo), "v"(hi)); return r; }
typedef unsigned u32x2 __attribute__((ext_vector_type(2)));
constexpr float RMS_EPS = 1e-6f;
__device__ __forceinline__ float sum4(f32x4 a) { return (a.x + a.y) + (a.z + a.w); }
template <int NP> __device__ __forceinline__ float rstd_from(const float* part, int row, float inv_n) {
    const f32x4* p = (const f32x4*)(part + (size_t)row * NP); float s = 0.f;
#pragma unroll
    for (int i = 0; i < NP / 4; ++i) s += sum4(p[i]);
    return 1.0f / sqrtf(s * inv_n + RMS_EPS);
}
template <int ACT, int MODE> struct EpiBf16S {
    static constexpr bool PERM = true, AFTER_DRAIN = false; static constexpr int MIDK = 0;
    bf16_t* O; int ldc; const float* ssq; float* kout; float* vout; float* convout;
    __device__ __forceinline__ void midk(f32x4 (&)[2][2][4][2], const Unit&, int, int, int, int) const {}
    __device__ __forceinline__ void operator()(const f32x4 (&acc)[2][2][4][2], const Unit& u, int wr, int wc, int fr, int fq) const {
        const int pn = u.pn;
#pragma unroll
        for (int ai = 0; ai < 2; ++ai)
#pragma unroll
            for (int m = 0; m < 4; ++m) {
                const int row = u.pm * BM + ai * HALF + wr * 64 + m * 16 + fr;
                const float rs = rstd_from<16>(ssq, row, 1.0f / 1024.0f);
#pragma unroll
                for (int bj = 0; bj < 2; ++bj) {
                    const int col0 = pn * BM + bj * HALF + wc * 32 + fq * 8;
                    f32x4 v0 = acc[ai][bj][m][0] * rs, v1 = acc[ai][bj][m][1] * rs;
                    if (ACT == 1) {
                        v0.x = fmaxf(v0.x, 0.f); v0.y = fmaxf(v0.y, 0.f); v0.z = fmaxf(v0.z, 0.f); v0.w = fmaxf(v0.w, 0.f);
                        v1.x = fmaxf(v1.x, 0.f); v1.y = fmaxf(v1.y, 0.f); v1.z = fmaxf(v1.z, 0.f); v1.w = fmaxf(v1.w, 0.f);
                        v0 = v0 * v0; v1 = v1 * v1;
                    }
                    u32x4 w; w.x = cvt_pk_bf16(v0[0], v0[1]); w.y = cvt_pk_bf16(v0[2], v0[3]); w.z = cvt_pk_bf16(v1[0], v1[1]); w.w = cvt_pk_bf16(v1[2], v1[3]);
                    *(u32x4*)(O + (size_t)row * ldc + col0) = w;
                    if (MODE == 1) {
                        if (pn >= 2 && pn < 6) {
                            float* dst = (pn < 4 ? kout + (size_t)row * 512 + (col0 - 512) : vout + (size_t)row * 512 + (col0 - 1024));
                            *(f32x4*)dst = v0; *(f32x4*)(dst + 4) = v1;
                        }
                        if (pn >= 8) {
                            const int t = row & 2047;
                            if (t >= 2045) { float* dst = convout + ((size_t)(row >> 11) * 3 + (t - 2045)) * 1024 + (col0 - 2048); *(f32x4*)dst = v0; *(f32x4*)(dst + 4) = v1; }
                        }
                    }
                }
                asm volatile("" ::: "memory");
            }
    }
};
template <int RSN, int MIDK_T> struct EpiResid {
    static constexpr bool PERM = false, AFTER_DRAIN = false; static constexpr int MIDK = MIDK_T;
    const float* hold; float* hnew; bf16_t* hb; float* ssq_out; const float* rs_part; float rs_inv; const float* mid_part;
    __device__ __forceinline__ void midk(f32x4 (&acc)[2][2][4][2], const Unit& u, int wr, int wc, int fr, int fq) const {
#pragma unroll
        for (int ai = 0; ai < 2; ++ai)
#pragma unroll
            for (int m = 0; m < 4; ++m) {
                const int row = u.pm * BM + ai * HALF + wr * 64 + m * 16 + fr;
                const f32x4* p = (const f32x4*)(mid_part + (size_t)row * 32);
                const float s = sum4(p[0]) + sum4(p[1]);
                const float rs = 1.0f / sqrtf(s * (1.0f / 512.0f) + RMS_EPS);
#pragma unroll
                for (int bj = 0; bj < 2; ++bj)
#pragma unroll
                    for (int n = 0; n < 2; ++n) acc[ai][bj][m][n] = acc[ai][bj][m][n] * rs;
            }
    }
    __device__ __forceinline__ void operator()(const f32x4 (&acc)[2][2][4][2], const Unit& u, int wr, int wc, int fr, int fq) const {
        const int pn = u.pn;
#pragma unroll
        for (int ai = 0; ai < 2; ++ai)
#pragma unroll
            for (int m = 0; m < 4; ++m) {
                const int row = u.pm * BM + ai * HALF + wr * 64 + m * 16 + fr;
                float rs = 1.0f;
                if (RSN > 0) rs = rstd_from<(RSN > 0 ? RSN : 4)>(rs_part, row, rs_inv);
                float sq = 0.f;
#pragma unroll
                for (int bj = 0; bj < 2; ++bj)
#pragma unroll
                    for (int n = 0; n < 2; ++n) {
                        const size_t off = (size_t)row * 1024 + pn * BM + bj * HALF + wc * 32 + n * 16 + fq * 4;
                        f32x4 h = *(const f32x4*)(hold + off);
                        h = h + acc[ai][bj][m][n] * rs;
                        *(f32x4*)(hnew + off) = h;
                        u32x2 w; w.x = cvt_pk_bf16(h[0], h[1]); w.y = cvt_pk_bf16(h[2], h[3]);
                        *(u32x2*)(hb + off) = w;
                        sq += (h[0] * h[0] + h[1] * h[1]) + (h[2] * h[2] + h[3] * h[3]);
                    }
                sq += __shfl_xor(sq, 16); sq += __shfl_xor(sq, 32);
                if (fq == 0) ssq_out[(size_t)row * 16 + pn * 4 + wc] = sq;
                asm volatile("" ::: "memory");
            }
    }
};
template <class Epi, class Sched, bool ALIGN_EPI = false, bool SP2 = false>
__device__ __forceinline__ void gemm_phase(PG8_LAS unsigned char* lds, const Gemm g, const Sched& S, const Epi& E) {
    const int tid = threadIdx.x, wid = __builtin_amdgcn_readfirstlane(tid >> 6), lane = tid & 63, wr = wid >> 2, wc = wid & 3, fr = lane & 15, fq = lane >> 4;
    const int K = g.K, nt = K / BK;
    unsigned voffA[2], voffB[2];
#pragma unroll
    for (int i = 0; i < 2; ++i) { int R, C; stage_rc(tid * 16 + i * 8192, R, C); const int Rb = Epi::PERM ? ((R & ~31) + perm32(R & 31)) : R;
        voffA[i] = (unsigned)(R * K + C) * 2u; voffB[i] = (unsigned)(Rb * K + C) * 2u; }
    const size_t kstep = (size_t)(BK * 2);
    const size_t hstep = (size_t)HALF * K * 2;
    const size_t tstep = 2 * hstep;
    const unsigned ldsw = (unsigned)wid * 1024u;
    const int aoff = lds_byte(wr * 64 + fr, fq * 8), boff = lds_byte(wc * 32 + fr, fq * 8);
#define PG8_SA(b, h) (((b) * 2 + (h)) * HTB)
#define PG8_SB(b, h) ((4 + (b) * 2 + (h)) * HTB)
#define PG8_STAGE(bufoff, gbase, voff) do { _Pragma("unroll") for (int _i = 0; _i < 2; ++_i) \
        __builtin_amdgcn_global_load_lds((const unsigned*)((const char*)(gbase) + (voff)[_i]), (PG8_LAS unsigned*)(lds + (bufoff) + ldsw + _i * 8192), 16, 0, 0); } while (0)
#define PG8_LDA(dst, b, h) do { _Pragma("unroll") for (int m = 0; m < 4; ++m) _Pragma("unroll") for (int k = 0; k < 2; ++k) dst[m][k] = *(const PG8_LAS bf16x8*)(lds + PG8_SA(b, h) + aoff + m * 2048 + k * 1024); } while (0)
#define PG8_LDB(dst, b, h) do { _Pragma("unroll") for (int n = 0; n < 2; ++n) _Pragma("unroll") for (int k = 0; k < 2; ++k) dst[n][k] = *(const PG8_LAS bf16x8*)(lds + PG8_SB(b, h) + boff + n * 2048 + k * 1024); } while (0)
#define PG8_MMA(ai, bj, At, Bt) do { __builtin_amdgcn_s_setprio(1); _Pragma("unroll") for (int m = 0; m < 4; ++m) _Pragma("unroll") for (int n = 0; n < 2; ++n) _Pragma("unroll") for (int k = 0; k < 2; ++k) \
        acc[ai][bj][m][n] = __builtin_amdgcn_mfma_f32_16x16x32_bf16(Bt[n][k], At[m][k], acc[ai][bj][m][n], 0, 0, 0); __builtin_amdgcn_s_setprio(0); } while (0)
#define PG8_WAIT_V(n) asm volatile("s_waitcnt vmcnt(" #n ")" ::: "memory")
#define PG8_WAIT_L(n) asm volatile("s_waitcnt lgkmcnt(" #n ")" ::: "memory")
#define PG8_BAR __builtin_amdgcn_s_barrier()
#define PG8_SCHED __builtin_amdgcn_sched_barrier(0)
    Unit cur, nxt; int ui = 0;
    if (!S.next(0, cur)) return;
    f32x4 acc[2][2][4][2];
#pragma unroll
    for (int a = 0; a < 2; ++a)
#pragma unroll
        for (int b = 0; b < 2; ++b)
#pragma unroll
            for (int m = 0; m < 4; ++m)
#pragma unroll
                for (int n = 0; n < 2; ++n) acc[a][b][m][n] = (f32x4){0.f, 0.f, 0.f, 0.f};
    bf16x8 At[4][2], B0[2][2], B1[2][2];
    const char* cA = (const char*)g.A + (size_t)cur.pm * tstep; const char* cB = (const char*)g.Bt + (size_t)cur.pn * tstep;
    S.a_ready(cur);
    if constexpr (SP2) {
        PG8_STAGE(PG8_SB(0, 0), cB, voffB); PG8_STAGE(PG8_SB(0, 1), cB + hstep, voffB); PG8_STAGE(PG8_SA(0, 0), cA, voffA); PG8_STAGE(PG8_SA(0, 1), cA + hstep, voffA);
        if (wr == 1) PG8_BAR;
        PG8_WAIT_V(2); PG8_BAR;
        PG8_STAGE(PG8_SB(1, 0), cB + kstep, voffB); PG8_STAGE(PG8_SA(1, 0), cA + kstep, voffA); PG8_STAGE(PG8_SB(1, 1), cB + hstep + kstep, voffB);
        PG8_WAIT_V(6); PG8_BAR;
    } else {
        PG8_STAGE(PG8_SB(0, 0), cB, voffB); PG8_STAGE(PG8_SA(0, 0), cA, voffA); PG8_STAGE(PG8_SB(0, 1), cB + hstep, voffB); PG8_STAGE(PG8_SA(0, 1), cA + hstep, voffA);
        if (wr == 1) PG8_BAR;
        PG8_WAIT_V(4); PG8_BAR;
        PG8_STAGE(PG8_SB(1, 0), cB + kstep, voffB); PG8_STAGE(PG8_SA(1, 0), cA + kstep, voffA); PG8_STAGE(PG8_SB(1, 1), cB + hstep + kstep, voffB);
        PG8_WAIT_V(6); PG8_BAR;
    }
    for (;;) {
        const bool has_next = S.next(ui + 1, nxt);
        const char* nA = has_next ? (const char*)g.A + (size_t)nxt.pm * tstep : cA; const char* nB = has_next ? (const char*)g.Bt + (size_t)nxt.pn * tstep : cB;
        for (int t = 0; t < nt; t += 2) {
            if constexpr (Epi::MIDK > 0) { if (t == Epi::MIDK) E.midk(acc, cur, wr, wc, fr, fq); }
            const bool last = (t == nt - 2);
            const char* a1 = cA + (size_t)(t + 1) * kstep;
            const char* a2 = last ? nA : cA + (size_t)(t + 2) * kstep; const char* b2 = last ? nB : cB + (size_t)(t + 2) * kstep;
            const char* a3 = a2 + kstep; const char* b3 = b2 + kstep;
            if (last && has_next) S.a_ready(nxt);
            if constexpr (SP2) {
            PG8_LDB(B0, 0, 0); PG8_LDB(B1, 0, 1); PG8_SCHED; PG8_LDA(At, 0, 0); PG8_STAGE(PG8_SA(1, 1), a1 + hstep, voffA);
            PG8_WAIT_V(8); PG8_WAIT_L(0); PG8_BAR; PG8_MMA(0, 0, At, B0); PG8_MMA(0, 1, At, B1); PG8_BAR; PG8_SCHED;
            PG8_LDA(At, 0, 1); PG8_STAGE(PG8_SB(0, 0), b2, voffB); PG8_STAGE(PG8_SB(0, 1), b2 + hstep, voffB); PG8_STAGE(PG8_SA(0, 0), a2, voffA);
            PG8_WAIT_V(8); PG8_WAIT_L(0); PG8_BAR; PG8_MMA(1, 0, At, B0); PG8_MMA(1, 1, At, B1); PG8_BAR; PG8_SCHED;
            PG8_LDB(B0, 1, 0); PG8_LDB(B1, 1, 1); PG8_SCHED; PG8_LDA(At, 1, 0); PG8_STAGE(PG8_SA(0, 1), a2 + hstep, voffA);
            PG8_WAIT_V(8); PG8_WAIT_L(0); PG8_BAR; PG8_MMA(0, 0, At, B0); PG8_MMA(0, 1, At, B1); PG8_BAR; PG8_SCHED;
            PG8_LDA(At, 1, 1); PG8_STAGE(PG8_SB(1, 0), b3, voffB); PG8_STAGE(PG8_SB(1, 1), b3 + hstep, voffB); PG8_STAGE(PG8_SA(1, 0), a3, voffA);
            PG8_WAIT_V(8); PG8_WAIT_L(0); PG8_BAR; PG8_MMA(1, 0, At, B0); PG8_MMA(1, 1, At, B1); PG8_BAR; PG8_SCHED;
            } else {
            PG8_LDB(B0, 0, 0); PG8_SCHED; PG8_LDA(At, 0, 0); PG8_STAGE(PG8_SA(1, 1), a1 + hstep, voffA);
            PG8_WAIT_L(8); PG8_BAR; PG8_WAIT_L(0); PG8_MMA(0, 0, At, B0); PG8_BAR; PG8_SCHED;
            PG8_LDB(B1, 0, 1); PG8_STAGE(PG8_SB(0, 0), b2, voffB);
            PG8_BAR; PG8_WAIT_L(0); PG8_MMA(0, 1, At, B1); PG8_BAR;
            PG8_LDA(At, 0, 1); PG8_STAGE(PG8_SA(0, 0), a2, voffA);
            PG8_BAR; PG8_WAIT_L(0); PG8_MMA(1, 0, At, B0); PG8_BAR; PG8_SCHED;
            PG8_STAGE(PG8_SB(0, 1), b2 + hstep, voffB);
            PG8_WAIT_V(6); PG8_BAR; PG8_MMA(1, 1, At, B1); PG8_BAR;
            PG8_LDB(B0, 1, 0); PG8_SCHED; PG8_LDA(At, 1, 0); PG8_STAGE(PG8_SA(0, 1), a2 + hstep, voffA);
            PG8_WAIT_L(8); PG8_BAR; PG8_WAIT_L(0); PG8_MMA(0, 0, At, B0); PG8_BAR; PG8_SCHED;
            PG8_LDB(B1, 1, 1); PG8_STAGE(PG8_SB(1, 0), b3, voffB);
            PG8_BAR; PG8_WAIT_L(0); PG8_MMA(0, 1, At, B1); PG8_BAR;
            PG8_LDA(At, 1, 1); PG8_STAGE(PG8_SA(1, 0), a3, voffA);
            PG8_BAR; PG8_WAIT_L(0); PG8_MMA(1, 0, At, B0); PG8_BAR; PG8_SCHED;
            PG8_STAGE(PG8_SB(1, 1), b3 + hstep, voffB);
            PG8_WAIT_V(6); PG8_BAR; PG8_MMA(1, 1, At, B1); PG8_BAR;
            }
        }
        if constexpr (ALIGN_EPI) { if (wr == 0) PG8_BAR; }
        if constexpr (!Epi::AFTER_DRAIN) { E(acc, cur, wr, wc, fr, fq); S.done(cur); }
        if (!has_next) break;
#pragma unroll
        for (int a = 0; a < 2; ++a)
#pragma unroll
            for (int b = 0; b < 2; ++b)
#pragma unroll
                for (int m = 0; m < 4; ++m)
#pragma unroll
                    for (int n = 0; n < 2; ++n) acc[a][b][m][n] = (f32x4){0.f, 0.f, 0.f, 0.f};
        cur = nxt; cA = nA; cB = nB; ++ui;
        if constexpr (ALIGN_EPI) { if (wr == 1) PG8_BAR; }
    }
    PG8_WAIT_V(0);
    if constexpr (!ALIGN_EPI) { if (wr == 0) PG8_BAR; }
    PG8_BAR;
    if constexpr (Epi::AFTER_DRAIN) { E.fused(acc, cur, wr, wc, fr, fq, lds, wid, lane); S.done(cur); }
#undef PG8_SA
#undef PG8_SB
#undef PG8_STAGE
#undef PG8_LDA
#undef PG8_LDB
#undef PG8_MMA
#undef PG8_WAIT_V
#undef PG8_WAIT_L
#undef PG8_BAR
#undef PG8_SCHED
}
}

using pg8::RMS_EPS;
constexpr int NWAVES = 8, NTHR = 512;
constexpr int NB = 8, T = 2048, D = 1024, FF = 4096, M = NB * T;
constexpr int MS = 32;
constexpr int PAST = 8192, PAGE = 128, NPAGES = 64;
constexpr int EVEN_IN = 3080, NE = 3072, NES = 3104;
constexpr int ODD_IN = 4096;
constexpr int N_PHYS = 2560;
enum { I_XP = 0, I_XS, I_CK, I_CV, I_PT, I_SCONV, I_SSSM, I_SHG, I_NMIX, I_NFFN, I_NFIN, I_WINE, I_SBB, I_CONVW, I_CONVB, I_DTB, I_ALOG, I_DSKIP, I_SSDN, I_WOUTE, I_WINO, I_LBRAW, I_HGN, I_WOUTO, I_W1, I_W2, N_IN };
constexpr size_t O_YP = 0, O_YS = O_YP + (size_t)M * D, O_KP = O_YS + (size_t)MS * D, O_VP = O_KP + (size_t)M * 512, O_KS = O_VP + (size_t)M * 512, O_VS = O_KS + (size_t)MS * 512,
                 O_CP = O_VS + (size_t)MS * 512, O_CS = O_CP + (size_t)NB * 3 * 1024, O_SP = O_CS + (size_t)MS * 3 * 1024, O_SS = O_SP + (size_t)NB * 8 * 64 * 128,
                 O_GP = O_SS + (size_t)MS * 8 * 64 * 128, O_GS = O_GP + (size_t)NB * 8 * 128 * 128, O_END = O_GS + (size_t)MS * 8 * 128 * 128;
constexpr size_t MiB = 1u << 20;
constexpr size_t WS_CTL = 0, CTL_ZERO_BYTES = 1 * MiB;
constexpr size_t WS_WINE = 2 * MiB;
constexpr size_t WS_WOUTE = 10 * MiB;
constexpr size_t WS_WINO = 12 * MiB;
constexpr size_t WS_WOUTO = 20 * MiB;
constexpr size_t WS_W1 = 22 * MiB;
constexpr size_t WS_W2 = 38 * MiB;
constexpr size_t WS_HB = 54 * MiB;
constexpr size_t WS_H = 86 * MiB;
constexpr size_t WS_SSQ = 150 * MiB;
constexpr size_t WS_DTRAW = 151 * MiB;
constexpr size_t WS_SSM = 152 * MiB;
constexpr size_t WS_MIX = 154 * MiB;
constexpr size_t WS_QKV = 186 * MiB;
constexpr size_t WS_HID = 282 * MiB;
constexpr size_t WS_SMP = 410 * MiB;
constexpr size_t SM_H = 0, SM_IN = SM_H + (size_t)MS * 1024 * 4, SM_HID = SM_IN + (size_t)MS * 4096 * 4, SM_YG = SM_HID + (size_t)MS * 4096 * 4, SM_OPART = SM_YG + (size_t)MS * 512 * 4,
                 SM_LPART = SM_OPART + (size_t)MS * 8 * 512 * 4, SM_O = SM_LPART + (size_t)MS * 8 * 8 * 4, SM_END = SM_O + (size_t)MS * 1024 * 4;
constexpr size_t WS_END = WS_SMP + 4 * MiB;
static_assert(SM_END <= 4 * MiB, "sample scratch");
constexpr int CW_TMO = 0, CW_QATT = 64, CW_BAR = 4096;

constexpr int RING_BYTES = 131072, MISC_OFF = RING_BYTES + 320, LDS_BYTES = 147456;

#define GAS __attribute__((address_space(1)))
#define LAS __attribute__((address_space(3)))
typedef unsigned short bf16;
typedef unsigned v4u __attribute__((ext_vector_type(4)));
typedef float f32x4 __attribute__((ext_vector_type(4)));
typedef short bf16x8 __attribute__((ext_vector_type(8)));
typedef GAS unsigned gu32;
typedef GAS unsigned long long gu64;
#define RLX_AGENT __ATOMIC_RELAXED, __HIP_MEMORY_SCOPE_AGENT
#define LDS_WAIT() asm volatile("s_waitcnt lgkmcnt(0)" ::: "memory")
#define VM_WAIT() asm volatile("s_waitcnt vmcnt(0)" ::: "memory")
__device__ __forceinline__ unsigned long long rt() { return __builtin_amdgcn_s_memrealtime(); }
__device__ __forceinline__ unsigned f2bf(float f) { unsigned u = __builtin_bit_cast(unsigned, f); return (u + 0x7fffu + ((u >> 16) & 1u)) >> 16; }
__device__ __forceinline__ unsigned pk2(float lo, float hi) { return f2bf(lo) | (f2bf(hi) << 16); }

#define XB_TMO      128
#define XB_XCNT(j)  (256  + 64 * (j))
#define XB_XSUB(j)  (1280 + 64 * (j))
#define XB_XGEN(j)  (2304 + 64 * (j))
#define XB_TOP      3328
#define XB_TOPGEN   3392
#define XCD_BAR_WORDS 3456
#define XB_SPIN_CAP (1u << 18)

__device__ __forceinline__ unsigned xb_ld(unsigned* p)              { return __hip_atomic_load(p, __ATOMIC_RELAXED, __HIP_MEMORY_SCOPE_AGENT); }
__device__ __forceinline__ unsigned xb_add(unsigned* p, unsigned v) { return __hip_atomic_fetch_add(p, v, __ATOMIC_RELAXED, __HIP_MEMORY_SCOPE_AGENT); }
__device__ __forceinline__ unsigned xb_xcc_id() { return (unsigned)__builtin_amdgcn_s_getreg((3 << 11) | 20) & 0xFu; }
#define XB_SPIN(cond, bar) do { unsigned _sp = 0; while (cond) { __builtin_amdgcn_s_sleep(1); \
    if ((++_sp & 255u) == 0u) { if (xb_ld(&(bar)[XB_TMO])) break; if (_sp > XB_SPIN_CAP) { atomicAdd(&(bar)[XB_TMO], 1u); break; } } } } while (0)

struct XcdBarrier {
    unsigned* bar; unsigned x;
    volatile LAS unsigned* st;
};

__device__ __forceinline__ XcdBarrier xcd_barrier_post(unsigned* bar, volatile LAS unsigned* st) {
    XcdBarrier b; b.bar = bar; b.x = xb_xcc_id(); b.st = st;
    if (threadIdx.x == 0) (void)xb_add(&bar[XB_XCNT(b.x)], 1u);
    return b;
}
__device__ __forceinline__ void xcd_barrier_complete(unsigned* bar, unsigned x, unsigned& nloc, unsigned& nx) {
    const unsigned G = gridDim.x * gridDim.y * gridDim.z;
    unsigned sum, cnt, mine, sp = 0u;
    for (;;) {
        sum = 0u; cnt = 0u; mine = 0u;
#pragma unroll
        for (unsigned j = 0; j < 16; ++j) { const unsigned c = xb_ld(&bar[XB_XCNT(j)]); sum += c; cnt += (c > 0u) ? 1u : 0u; mine = (j == x) ? c : mine; }
        if (sum == G) break;
        __builtin_amdgcn_s_sleep(1);
        if ((++sp & 255u) == 0u) { if (xb_ld(&bar[XB_TMO])) break; if (sp > XB_SPIN_CAP) { atomicAdd(&bar[XB_TMO], 1u); break; } }
    }
    nloc = mine > 0u ? mine : 1u; nx = cnt > 0u ? cnt : 1u;
}

__device__ __forceinline__ void xcd_barrier(const XcdBarrier& b) {
    asm volatile("s_waitcnt vmcnt(0)" ::: "memory");
    __syncthreads();
    if (threadIdx.x == 0) {
        unsigned* bar = b.bar;
        __builtin_amdgcn_s_waitcnt(0);
        unsigned nloc = b.st[0], nx = b.st[1];
        if (nloc == 0u) { xcd_barrier_complete(bar, b.x, nloc, nx); b.st[0] = nloc; b.st[1] = nx; }
        const unsigned old = xb_add(&bar[XB_XSUB(b.x)], 1u);
        const unsigned gen = old / nloc;
        if (old + 1u == (gen + 1u) * nloc) {
            __builtin_amdgcn_fence(__ATOMIC_RELEASE, "agent");
            asm volatile("s_waitcnt vmcnt(0)" ::: "memory");
            const unsigned og = xb_add(&bar[XB_TOP], 1u);
            const unsigned tg = og / nx;
            if (og + 1u == (tg + 1u) * nx) xb_add(&bar[XB_TOPGEN], 1u);
            else XB_SPIN(xb_ld(&bar[XB_TOPGEN]) == tg, bar);
            __builtin_amdgcn_fence(__ATOMIC_ACQUIRE, "agent");
            xb_add(&bar[XB_XGEN(b.x)], 1u);
            asm volatile("s_waitcnt vmcnt(0)" ::: "memory");
        } else {
            XB_SPIN(xb_ld(&bar[XB_XGEN(b.x)]) == gen, bar);
            __builtin_amdgcn_fence(__ATOMIC_ACQUIRE, "agent");
            asm volatile("s_waitcnt vmcnt(0)" ::: "memory");
        }
    }
    __syncthreads();
}

typedef unsigned u32x2v __attribute__((ext_vector_type(2)));
__device__ __forceinline__ float bf2f(unsigned short b) { return __uint_as_float(((unsigned)b) << 16); }
__device__ __forceinline__ float bflo(unsigned u) { return __uint_as_float(u << 16); }
__device__ __forceinline__ float bfhi(unsigned u) { return __uint_as_float(u & 0xffff0000u); }
__device__ __forceinline__ float silu_f(float x) { return x / (1.0f + __expf(-x)); }
__device__ __forceinline__ float sigmoid_f(float x) { return 1.0f / (1.0f + __expf(-x)); }
__device__ __forceinline__ float softplus_f(float x) { return fmaxf(x, 0.f) + log1pf(__expf(-fabsf(x))); }
__device__ __forceinline__ float wave_sum(float v) {
#pragma unroll
    for (int o = 1; o < 64; o <<= 1) v += __shfl_xor(v, o);
    return v;
}

struct Args { const void* in[N_IN]; float* out; unsigned char* ws; int ph_lo, ph_hi; };

__device__ __forceinline__ void p0_transpose_item(const float* W, int K, int N, int Npad, bf16* WT, int kxor, const float* scale, int sk0, LAS float* scr, int item, int lane) {
    const int nblk = Npad / 32, kb = item / nblk, nb = item % nblk, k0 = 64 * kb, n0 = 32 * nb;
    const int n = n0 + (lane & 31);
#pragma unroll 8
    for (int i = 0; i < 32; ++i) {
        const int kk = 2 * i + (lane >> 5), k = k0 + kk;
        float v = (n < N) ? W[(size_t)k * N + n] : 0.f;
        if (scale && k >= sk0) v *= scale[k - sk0];
        scr[kk * 33 + (lane & 31)] = v;
    }
    LDS_WAIT(); asm volatile("" ::: "memory");
    const int c = lane & 7;
#pragma unroll
    for (int j = 0; j < 4; ++j) {
        const int nn = (lane >> 3) + 8 * j; const LAS float* s = scr + (8 * c) * 33 + nn;
        v4u o; o.x = pk2(s[0 * 33], s[1 * 33]); o.y = pk2(s[2 * 33], s[3 * 33]); o.z = pk2(s[4 * 33], s[5 * 33]); o.w = pk2(s[6 * 33], s[7 * 33]);
        *(GAS v4u*)(WT + (size_t)(n0 + nn) * K + ((k0 + 8 * c) ^ kxor)) = o;
    }
    LDS_WAIT(); asm volatile("" ::: "memory");
}

constexpr int SK_LDA = 1024 + 8;
constexpr int SK_A_BYTES = 32 * SK_LDA * 2;
constexpr int SK_RED_OFF = 67584;
constexpr int SK_AUX_OFF = SK_RED_OFF + 8 * 4096;
template <class Builder, class Epi>
__device__ __forceinline__ void skinny_unit(unsigned char* lds, const bf16* Wt, int K, int u, const Builder& B, const Epi& E) {
    const int tid = threadIdx.x, lane = tid & 63, wid = tid >> 6, r32 = lane & 31, hi = lane >> 5;
    typedef float f32x16 __attribute__((ext_vector_type(16)));
    f32x16 acc;
#pragma unroll
    for (int i = 0; i < 16; ++i) acc[i] = 0.f;
    bf16* Al = (bf16*)lds;
    for (int kc = 0; kc < K; kc += 1024) {
        __syncthreads();
        B(Al, (float*)(lds + SK_AUX_OFF), kc);
        __syncthreads();
        const bf16* wrow = Wt + (size_t)(u * 32 + r32) * K + kc + wid * 128 + hi * 8;
        bf16x8 bfr[8];
#pragma unroll
        for (int s = 0; s < 8; ++s) bfr[s] = *(const bf16x8*)(wrow + s * 16);
#pragma unroll
        for (int s = 0; s < 8; ++s) {
            const bf16x8 afr = *(const bf16x8*)(Al + r32 * SK_LDA + wid * 128 + s * 16 + hi * 8);
            acc = __builtin_amdgcn_mfma_f32_32x32x16_bf16(afr, bfr[s], acc, 0, 0, 0);
        }
    }
    __syncthreads();
    float* red = (float*)(lds + SK_RED_OFF);
#pragma unroll
    for (int i = 0; i < 16; ++i) { const int row = (i & 3) + 8 * (i >> 2) + 4 * hi; red[wid * 1024 + row * 32 + r32] = acc[i]; }
    __syncthreads();
#pragma unroll
    for (int e = 0; e < 2; ++e) {
        const int idx = tid + e * 512; float s = 0.f;
#pragma unroll
        for (int w = 0; w < 8; ++w) s += red[w * 1024 + idx];
        E(idx >> 5, u * 32 + (idx & 31), s);
    }
    __syncthreads();
}
struct BuildNorm {
    const float* X;
    __device__ __forceinline__ void operator()(bf16* Al, float* aux, int kc) const {
        const int tid = threadIdx.x, row = tid >> 4, c16 = tid & 15;
        f32x4 v[16]; float s = 0.f;
#pragma unroll
        for (int j = 0; j < 16; ++j) { v[j] = *(const f32x4*)(X + (size_t)row * 1024 + j * 64 + c16 * 4); s += (v[j].x * v[j].x + v[j].y * v[j].y) + (v[j].z * v[j].z + v[j].w * v[j].w); }
        s += __shfl_xor(s, 1); s += __shfl_xor(s, 2); s += __shfl_xor(s, 4); s += __shfl_xor(s, 8);
        const float rs = 1.0f / sqrtf(s * (1.0f / 1024.0f) + RMS_EPS);
#pragma unroll
        for (int j = 0; j < 16; ++j) { u32x2v w; w.x = pk2(v[j].x * rs, v[j].y * rs); w.y = pk2(v[j].z * rs, v[j].w * rs); *(u32x2v*)(Al + row * SK_LDA + j * 64 + c16 * 4) = w; }
    }
};
struct BuildPlain {
    const float* X; int ldx;
    __device__ __forceinline__ void operator()(bf16* Al, float* aux, int kc) const {
        const int tid = threadIdx.x, row = tid >> 4, c16 = tid & 15;
#pragma unroll
        for (int j = 0; j < 16; ++j) { const f32x4 v = *(const f32x4*)(X + (size_t)row * ldx + kc + j * 64 + c16 * 4); u32x2v w; w.x = pk2(v.x, v.y); w.y = pk2(v.z, v.w); *(u32x2v*)(Al + row * SK_LDA + j * 64 + c16 * 4) = w; }
    }
};
struct BuildMixEven {
    const float* YG;
    const float* OPART;
    const float* LPART;
    __device__ __forceinline__ void operator()(bf16* Al, float* aux, int kc) const {
        const int tid = threadIdx.x, row = tid >> 4, c16 = tid & 15;
        {
            f32x4 v[8]; float s = 0.f;
#pragma unroll
            for (int j = 0; j < 8; ++j) { v[j] = *(const f32x4*)(YG + (size_t)row * 512 + j * 64 + c16 * 4); s += (v[j].x * v[j].x + v[j].y * v[j].y) + (v[j].z * v[j].z + v[j].w * v[j].w); }
            s += __shfl_xor(s, 1); s += __shfl_xor(s, 2); s += __shfl_xor(s, 4); s += __shfl_xor(s, 8);
            const float rs = 1.0f / sqrtf(s * (1.0f / 512.0f) + RMS_EPS);
#pragma unroll
            for (int j = 0; j < 8; ++j) { u32x2v w; w.x = pk2(v[j].x * rs, v[j].y * rs); w.y = pk2(v[j].z * rs, v[j].w * rs); *(u32x2v*)(Al + row * SK_LDA + j * 64 + c16 * 4) = w; }
        }
        {
#pragma unroll
            for (int j = 0; j < 8; ++j) {
                f32x4 o = (f32x4){0.f, 0.f, 0.f, 0.f}; float run = 0.f;
                for (int p = 7; p >= 0; --p) {
                    const f32x4 x = *(const f32x4*)(OPART + ((size_t)row * 8 + p) * 512 + j * 64 + c16 * 4);
                    const float e = __expf(run);
                    o = o + x * e;
                    run += LPART[((size_t)row * 8 + p) * 8 + j];
                }
                u32x2v w; w.x = pk2(o.x, o.y); w.y = pk2(o.z, o.w); *(u32x2v*)(Al + row * SK_LDA + 512 + j * 64 + c16 * 4) = w;
            }
        }
    }
};
struct BuildMixOdd {
    const float* O;
    const float* IN2;
    __device__ __forceinline__ void operator()(bf16* Al, float* aux, int kc) const {
        const int tid = threadIdx.x, row = tid >> 4, c16 = tid & 15;
        f32x4 v[16]; float s = 0.f;
#pragma unroll
        for (int j = 0; j < 16; ++j) { v[j] = *(const f32x4*)(O + (size_t)row * 1024 + j * 64 + c16 * 4); s += (v[j].x * v[j].x + v[j].y * v[j].y) + (v[j].z * v[j].z + v[j].w * v[j].w); }
        s += __shfl_xor(s, 1); s += __shfl_xor(s, 2); s += __shfl_xor(s, 4); s += __shfl_xor(s, 8);
        const float rs = 1.0f / sqrtf(s * (1.0f / 1024.0f) + RMS_EPS);
#pragma unroll
        for (int j = 0; j < 16; ++j) {
            const f32x4 g = *(const f32x4*)(IN2 + (size_t)row * 4096 + 3072 + j * 64 + c16 * 4);
            u32x2v w; w.x = pk2(v[j].x * rs * silu_f(g.x), v[j].y * rs * silu_f(g.y)); w.y = pk2(v[j].z * rs * silu_f(g.z), v[j].w * rs * silu_f(g.w));
            *(u32x2v*)(Al + row * SK_LDA + j * 64 + c16 * 4) = w;
        }
    }
};
struct SEpiInEven { float* IN; float* kout; float* vout;
    __device__ __forceinline__ void operator()(int row, int col, float v) const {
        IN[(size_t)row * NES + col] = v;
        if (col >= 512 && col < 1024) kout[row * 512 + col - 512] = v;
        if (col >= 1024 && col < 1536) vout[row * 512 + col - 1024] = v;
    } };
struct SEpiStore { float* O; int ldo; __device__ __forceinline__ void operator()(int row, int col, float v) const { O[(size_t)row * ldo + col] = v; } };
struct SEpiRelu2 { float* O; int ldo; __device__ __forceinline__ void operator()(int row, int col, float v) const { const float r = fmaxf(v, 0.f); O[(size_t)row * ldo + col] = r * r; } };
struct SEpiResid { const float* hold; float* hnew; __device__ __forceinline__ void operator()(int row, int col, float v) const { hnew[row * 1024 + col] = hold[row * 1024 + col] + v; } };

__device__ __forceinline__ void decode_unit(unsigned char* lds, const float* IN  , const float* ck, const float* cv, const int* ptab, const float* sb_bias,
                                            float* OPART, float* LPART, int seq, int part) {
    const int tid = threadIdx.x, lane = tid & 63, wid = tid >> 6;
    const int hsub = lane >> 4, dq = (lane & 15) * 4;
    f32x4 q0 = *(const f32x4*)(IN + (size_t)seq * NES + hsub * 64 + dq), q1 = *(const f32x4*)(IN + (size_t)seq * NES + (4 + hsub) * 64 + dq);
    q0 = q0 * 0.125f; q1 = q1 * 0.125f;
    const float b0 = sb_bias[hsub], b1 = sb_bias[4 + hsub];
    const int phys = ptab[seq * NPAGES + part * 8 + wid];
    const float* kp = ck + (size_t)phys * PAGE * 512 + lane * 4;
    const float* vp = cv + (size_t)phys * PAGE * 512 + lane * 4;
    f32x4 o0 = (f32x4){0.f, 0.f, 0.f, 0.f}, o1 = o0; float a0 = 0.f, a1 = 0.f;
    for (int tk = PAGE - 4; tk >= 0; tk -= 4) {
        f32x4 k0[4], k1[4], v0[4], v1[4];
#pragma unroll
        for (int j = 0; j < 4; ++j) {
            k0[j] = __builtin_nontemporal_load((const f32x4*)(kp + (size_t)(tk + j) * 512)); k1[j] = __builtin_nontemporal_load((const f32x4*)(kp + (size_t)(tk + j) * 512 + 256));
            v0[j] = __builtin_nontemporal_load((const f32x4*)(vp + (size_t)(tk + j) * 512)); v1[j] = __builtin_nontemporal_load((const f32x4*)(vp + (size_t)(tk + j) * 512 + 256));
        }
#pragma unroll
        for (int j = 3; j >= 0; --j) {
            float z0 = (k0[j].x * q0.x + k0[j].y * q0.y) + (k0[j].z * q0.z + k0[j].w * q0.w);
            float z1 = (k1[j].x * q1.x + k1[j].y * q1.y) + (k1[j].z * q1.z + k1[j].w * q1.w);
            z0 += __shfl_xor(z0, 1); z1 += __shfl_xor(z1, 1); z0 += __shfl_xor(z0, 2); z1 += __shfl_xor(z1, 2);
            z0 += __shfl_xor(z0, 4); z1 += __shfl_xor(z1, 4); z0 += __shfl_xor(z0, 8); z1 += __shfl_xor(z1, 8);
            z0 += b0; z1 += b1;
            const float sp0 = __logf(1.0f + __expf(-fabsf(z0))), sp1 = __logf(1.0f + __expf(-fabsf(z1)));
            const float w0 = __expf(fminf(z0, 0.f) - sp0 + a0), w1 = __expf(fminf(z1, 0.f) - sp1 + a1);
            a0 += -fmaxf(z0, 0.f) - sp0; a1 += -fmaxf(z1, 0.f) - sp1;
            o0 = o0 + v0[j] * w0; o1 = o1 + v1[j] * w1;
        }
    }
    float* Ow = (float*)lds;
    float* Lw = (float*)(lds + 8 * 512 * 4);
    __syncthreads();
    *(f32x4*)(Ow + wid * 512 + hsub * 64 + dq) = o0; *(f32x4*)(Ow + wid * 512 + (4 + hsub) * 64 + dq) = o1;
    if ((lane & 15) == 0) { Lw[wid * 8 + hsub] = a0; Lw[wid * 8 + 4 + hsub] = a1; }
    __syncthreads();
    {
        const int head = tid >> 6; float run = 0.f, o = 0.f;
        for (int w = 7; w >= 0; --w) { o += __expf(run) * Ow[w * 512 + tid]; run += Lw[w * 8 + head]; }
        OPART[((size_t)seq * 8 + part) * 512 + tid] = o;
        if ((tid & 63) == 0) LPART[((size_t)seq * 8 + part) * 8 + head] = run;
    }
    __syncthreads();
}
__device__ __forceinline__ void ssd_sample_unit(unsigned char* lds, const float* IN, const float* sconv, const float* sssm, const float* convw, const float* convb, const float* dtb, const float* alog,
                                                const float* dskip, float* conv_out, float* ssm_out, float* YG, int seq, int h) {
    const int tid = threadIdx.x; const int g = h >> 2;
    float* xc = (float*)lds; float* Bc = xc + 64; float* Cc = Bc + 128;
    __syncthreads();
    if (tid < 320) {
        const int c = tid < 64 ? h * 64 + tid : (tid < 192 ? 512 + g * 128 + (tid - 64) : 768 + g * 128 + (tid - 192));
        const float s0 = sconv[((size_t)seq * 3 + 0) * 1024 + c], s1 = sconv[((size_t)seq * 3 + 1) * 1024 + c], s2 = sconv[((size_t)seq * 3 + 2) * 1024 + c], xn = IN[(size_t)seq * NES + 2048 + c];
        const float cv = convb[c] + convw[c] * s0 + convw[1024 + c] * s1 + convw[2048 + c] * s2 + convw[3072 + c] * xn;
        xc[tid] = silu_f(cv);
    } else if (tid >= 384) {
        const int c = h * 128 + (tid - 384);
        conv_out[((size_t)seq * 3 + 0) * 1024 + c] = sconv[((size_t)seq * 3 + 1) * 1024 + c];
        conv_out[((size_t)seq * 3 + 1) * 1024 + c] = sconv[((size_t)seq * 3 + 2) * 1024 + c];
        conv_out[((size_t)seq * 3 + 2) * 1024 + c] = IN[(size_t)seq * NES + 2048 + c];
    }
    __syncthreads();
    const float dt = softplus_f(IN[(size_t)seq * NES + 3072 + h] + dtb[h]); const float a = -__expf(alog[h]); const float dA = __expf(dt * a);
    const int p = tid >> 3, ng = tid & 7;
    const float dtx = dt * xc[p];
    const size_t so = (((size_t)seq * 8 + h) * 64 + p) * 128 + ng * 16;
    float y = 0.f;
#pragma unroll
    for (int j = 0; j < 4; ++j) {
        f32x4 s = *(const f32x4*)(sssm + so + j * 4);
        const f32x4 b = *(const f32x4*)(Bc + ng * 16 + j * 4), c = *(const f32x4*)(Cc + ng * 16 + j * 4);
        s = s * dA + b * dtx;
        *(f32x4*)(ssm_out + so + j * 4) = s;
        y += (s.x * c.x + s.y * c.y) + (s.z * c.z + s.w * c.w);
    }
    y += __shfl_xor(y, 1); y += __shfl_xor(y, 2); y += __shfl_xor(y, 4);
    if (ng == 0) { const float z = IN[(size_t)seq * NES + 1536 + h * 64 + p]; YG[(size_t)seq * 512 + h * 64 + p] = (y + dskip[h] * xc[p]) * silu_f(z); }
    __syncthreads();
}
__device__ __forceinline__ void ssd_prompt_unit(unsigned char* lds, const bf16* QKV, const float* DTRAW, const float* convw, const float* convb, const float* dtb, const float* alog, const float* dskip,
                                                bf16* MIX, float* SSM, float* ssm_out, int b, int h) {
    const int tid = threadIdx.x, lane = tid & 63, wid = tid >> 6; const int g = h >> 2;
    float* xc = (float*)lds;
    float* Bc = xc + 8 * 64;
    float* Cc = Bc + 8 * 128;
    float* dtv = Cc + 8 * 128;
    float* dAv = dtv + 8;
    float* yb = dAv + 8;
    const float a = -__expf(alog[h]), dtbias = dtb[h], dsk = dskip[h];
    const int p = tid >> 3, ng = tid & 7;
    float st[16];
#pragma unroll
    for (int i = 0; i < 16; ++i) st[i] = 0.f;
    for (int t0 = 0; t0 < T; t0 += 8) {
        __syncthreads();
        for (int idx = tid; idx < 8 * 320; idx += NTHR) {
            const int j = idx / 320, cc = idx - j * 320;
            const int c = cc < 64 ? h * 64 + cc : (cc < 192 ? 512 + g * 128 + (cc - 64) : 768 + g * 128 + (cc - 192));
            const int t = t0 + j; float acc = convb[c];
#pragma unroll
            for (int jj = 0; jj < 4; ++jj) { const int tt = t - 3 + jj; if (tt >= 0) acc += convw[jj * 1024 + c] * bf2f(QKV[((size_t)b * T + tt) * NE + 2048 + c]); }
            const float v = silu_f(acc);
            if (cc < 64) xc[j * 64 + cc] = v; else if (cc < 192) Bc[j * 128 + cc - 64] = v; else Cc[j * 128 + cc - 192] = v;
        }
        if (tid < 8) { const float dt = softplus_f(DTRAW[((size_t)b * T + t0 + tid) * 8 + h] + dtbias); dtv[tid] = dt; dAv[tid] = __expf(dt * a); }
        __syncthreads();
#pragma unroll
        for (int j = 0; j < 8; ++j) {
            const float dA = dAv[j], dtx = dtv[j] * xc[j * 64 + p]; float y = 0.f;
#pragma unroll
            for (int q4 = 0; q4 < 4; ++q4) {
                const f32x4 bb = *(const f32x4*)(Bc + j * 128 + ng * 16 + q4 * 4), cc = *(const f32x4*)(Cc + j * 128 + ng * 16 + q4 * 4);
                st[q4 * 4 + 0] = st[q4 * 4 + 0] * dA + bb.x * dtx; st[q4 * 4 + 1] = st[q4 * 4 + 1] * dA + bb.y * dtx; st[q4 * 4 + 2] = st[q4 * 4 + 2] * dA + bb.z * dtx; st[q4 * 4 + 3] = st[q4 * 4 + 3] * dA + bb.w * dtx;
                y += (st[q4 * 4 + 0] * cc.x + st[q4 * 4 + 1] * cc.y) + (st[q4 * 4 + 2] * cc.z + st[q4 * 4 + 3] * cc.w);
            }
            y += __shfl_xor(y, 1); y += __shfl_xor(y, 2); y += __shfl_xor(y, 4);
            if (ng == 0) yb[j * 64 + p] = y;
        }
        __syncthreads();
        {
            const int j = wid; const size_t row = (size_t)b * T + t0 + j;
            const float z = bf2f(QKV[row * NE + 1536 + h * 64 + lane]);
            const float yg = (yb[j * 64 + lane] + dsk * xc[j * 64 + lane]) * silu_f(z);
            MIX[row * 1024 + h * 64 + lane] = (bf16)f2bf(yg);
            const float sq = wave_sum(yg * yg);
            if (lane == 0) SSM[row * 32 + h] = sq;
        }
    }
    const size_t so = (((size_t)b * 8 + h) * 64 + p) * 128 + ng * 16;
#pragma unroll
    for (int j = 0; j < 4; ++j) *(f32x4*)(ssm_out + so + j * 4) = (f32x4){st[j * 4], st[j * 4 + 1], st[j * 4 + 2], st[j * 4 + 3]};
    __syncthreads();
}
__device__ __forceinline__ void attn_prompt_item(const bf16* QKV, const float* sb_bias, bf16* MIX, int b, int h, int tb, int lane) {
    const int t = tb * 64 + lane; const size_t row = (size_t)b * T + t;
    float q[64], o[64];
    {
        const v4u* qp = (const v4u*)(QKV + row * NE + h * 64);
#pragma unroll
        for (int i = 0; i < 8; ++i) { const v4u u = qp[i]; q[i * 8 + 0] = bflo(u.x) * 0.125f; q[i * 8 + 1] = bfhi(u.x) * 0.125f; q[i * 8 + 2] = bflo(u.y) * 0.125f; q[i * 8 + 3] = bfhi(u.y) * 0.125f;
            q[i * 8 + 4] = bflo(u.z) * 0.125f; q[i * 8 + 5] = bfhi(u.z) * 0.125f; q[i * 8 + 6] = bflo(u.w) * 0.125f; q[i * 8 + 7] = bfhi(u.w) * 0.125f; }
    }
#pragma unroll
    for (int i = 0; i < 64; ++i) o[i] = 0.f;
    const float bias = sb_bias[h]; float acc = 0.f;
    for (int s = tb * 64 + 62; s >= 0; --s) {
        const v4u* kp = (const v4u*)(QKV + ((size_t)b * T + s) * NE + 512 + h * 64);
        const v4u* vp = (const v4u*)(QKV + ((size_t)b * T + s) * NE + 1024 + h * 64);
        float z0 = 0.f, z1 = 0.f;
#pragma unroll
        for (int i = 0; i < 8; ++i) { const v4u u = kp[i];
            z0 += bflo(u.x) * q[i * 8 + 0]; z1 += bfhi(u.x) * q[i * 8 + 1]; z0 += bflo(u.y) * q[i * 8 + 2]; z1 += bfhi(u.y) * q[i * 8 + 3];
            z0 += bflo(u.z) * q[i * 8 + 4]; z1 += bfhi(u.z) * q[i * 8 + 5]; z0 += bflo(u.w) * q[i * 8 + 6]; z1 += bfhi(u.w) * q[i * 8 + 7]; }
        const float z = z0 + z1 + bias;
        const bool act = s < t;
        const float sp = __logf(1.0f + __expf(-fabsf(z)));
        const float w = act ? __expf(fminf(z, 0.f) - sp + acc) : 0.f;
        acc += act ? (-fmaxf(z, 0.f) - sp) : 0.f;
#pragma unroll
        for (int i = 0; i < 8; ++i) { const v4u u = vp[i];
            o[i * 8 + 0] += w * bflo(u.x); o[i * 8 + 1] += w * bfhi(u.x); o[i * 8 + 2] += w * bflo(u.y); o[i * 8 + 3] += w * bfhi(u.y);
            o[i * 8 + 4] += w * bflo(u.z); o[i * 8 + 5] += w * bfhi(u.z); o[i * 8 + 6] += w * bflo(u.w); o[i * 8 + 7] += w * bfhi(u.w); }
    }
    v4u* op = (v4u*)(MIX + row * 1024 + 512 + h * 64);
#pragma unroll
    for (int i = 0; i < 8; ++i) { v4u u; u.x = pk2(o[i * 8 + 0], o[i * 8 + 1]); u.y = pk2(o[i * 8 + 2], o[i * 8 + 3]); u.z = pk2(o[i * 8 + 4], o[i * 8 + 5]); u.w = pk2(o[i * 8 + 6], o[i * 8 + 7]); op[i] = u; }
}

__device__ __forceinline__ void hgrn_prompt_unit(unsigned char* lds, const bf16* IN2  , const float* lbraw, const float* hgn_unused, bf16* MIX, float* SSM, float* hg_out, int b, int h, int vq) {
    const int tid = threadIdx.x;
    float* fT = (float*)lds;
    float* qT = fT + 8 * 128;
    float* vT = qT + 8 * 128;
    float* oB = vT + 8 * 32;
    const int v = tid >> 4, kg = tid & 15;
    float S[8];
#pragma unroll
    for (int i = 0; i < 8; ++i) S[i] = 0.f;
    for (int t0 = 0; t0 < T; t0 += 8) {
        __syncthreads();
        for (int idx = tid; idx < 8 * 128; idx += NTHR) {
            const int j = idx >> 7, k = idx & 127; const size_t row = (size_t)b * T + t0 + j;
            const float lb = sigmoid_f(lbraw[1024 + h * 128 + k] - lbraw[h * 128 + k]);
            const float fp = bf2f(IN2[row * 4096 + 1024 + h * 128 + k]);
            fT[idx] = lb + (1.0f - lb) * sigmoid_f(fp);
            qT[idx] = bf2f(IN2[row * 4096 + h * 128 + k]);
        }
        if (tid < 256) { const int j = tid >> 5, vv = tid & 31; vT[tid] = bf2f(IN2[((size_t)b * T + t0 + j) * 4096 + 2048 + h * 128 + vq * 32 + vv]); }
        __syncthreads();
#pragma unroll
        for (int j = 0; j < 8; ++j) {
            const float vt = vT[j * 32 + v]; float o = 0.f;
            const f32x4 f0 = *(const f32x4*)(fT + j * 128 + kg * 8), f1 = *(const f32x4*)(fT + j * 128 + kg * 8 + 4);
            const f32x4 q0 = *(const f32x4*)(qT + j * 128 + kg * 8), q1 = *(const f32x4*)(qT + j * 128 + kg * 8 + 4);
            const float ff[8] = {f0.x, f0.y, f0.z, f0.w, f1.x, f1.y, f1.z, f1.w}; const float qq[8] = {q0.x, q0.y, q0.z, q0.w, q1.x, q1.y, q1.z, q1.w};
#pragma unroll
            for (int i = 0; i < 8; ++i) { S[i] = ff[i] * S[i] + (1.0f - ff[i]) * vt; o += S[i] * qq[i]; }
            o += __shfl_xor(o, 1); o += __shfl_xor(o, 2); o += __shfl_xor(o, 4); o += __shfl_xor(o, 8);
            if (kg == 0) oB[j * 32 + v] = o;
        }
        __syncthreads();
        if (tid < 256) {
            const int j = tid >> 5, vv = tid & 31; const size_t row = (size_t)b * T + t0 + j;
            const float o = oB[tid]; const float g = bf2f(IN2[row * 4096 + 3072 + h * 128 + vq * 32 + vv]);
            MIX[row * 1024 + h * 128 + vq * 32 + vv] = (bf16)f2bf(o * silu_f(g));
            float sq = o * o; sq += __shfl_xor(sq, 1); sq += __shfl_xor(sq, 2); sq += __shfl_xor(sq, 4); sq += __shfl_xor(sq, 8); sq += __shfl_xor(sq, 16);
            if (vv == 0) SSM[row * 32 + h * 4 + vq] = sq;
        }
    }
#pragma unroll
    for (int i = 0; i < 8; ++i) hg_out[(((size_t)b * 8 + h) * 128 + kg * 8 + i) * 128 + vq * 32 + v] = S[i];
    __syncthreads();
}
__device__ __forceinline__ void hgrn_sample_unit(unsigned char* lds, const float* IN2  , const float* shg, const float* lbraw, float* hg_out, float* SO, int seq, int h) {
    const int tid = threadIdx.x;
    float* fT = (float*)lds; float* qT = fT + 128; float* red = qT + 128;
    __syncthreads();
    if (tid < 128) {
        const float lb = sigmoid_f(lbraw[1024 + h * 128 + tid] - lbraw[h * 128 + tid]);
        fT[tid] = lb + (1.0f - lb) * sigmoid_f(IN2[(size_t)seq * 4096 + 1024 + h * 128 + tid]);
        qT[tid] = IN2[(size_t)seq * 4096 + h * 128 + tid];
    }
    __syncthreads();
    const int v = tid & 127, kq = tid >> 7;
    const float vt = IN2[(size_t)seq * 4096 + 2048 + h * 128 + v]; float o = 0.f;
    for (int kk = 0; kk < 32; ++kk) {
        const int k = kq * 32 + kk; const size_t off = (((size_t)seq * 8 + h) * 128 + k) * 128 + v;
        const float f = fT[k]; const float s = f * shg[off] + (1.0f - f) * vt;
        hg_out[off] = s; o += s * qT[k];
    }
    red[kq * 128 + v] = o;
    __syncthreads();
    if (tid < 128) SO[(size_t)seq * 1024 + h * 128 + tid] = (red[tid] + red[128 + tid]) + (red[256 + tid] + red[384 + tid]);
    __syncthreads();
}

__global__ void __launch_bounds__(NTHR, 2) mk_fwd(Args args) {
    extern __shared__ __attribute__((aligned(16))) unsigned char lds[];
    const int tid = threadIdx.x, lane = tid & 63, wave = __builtin_amdgcn_readfirstlane(tid >> 6);
    const int G = gridDim.x, bid = blockIdx.x;
    LAS unsigned char* ldsl = (LAS unsigned char*)lds;
    volatile LAS unsigned* MISC = (volatile LAS unsigned*)(ldsl + MISC_OFF);
    unsigned char* ws = args.ws;
    gu32* ctl = (gu32*)(ws + WS_CTL);
    for (int u = tid; u < (LDS_BYTES - RING_BYTES) / 4; u += NTHR) ((LAS unsigned*)(ldsl + RING_BYTES))[u] = 0u;
    __syncthreads();
    const int lo = args.ph_lo, hi = args.ph_hi;
    const bool multi = (hi - lo) > 1;
    XcdBarrier bar; bar.bar = (unsigned*)(ctl + CW_BAR); bar.x = 0; bar.st = nullptr;
    if (multi) bar = xcd_barrier_post((unsigned*)(ctl + CW_BAR), MISC + 8);
#define IN(k) (lo <= (k) && (k) < hi)
#define SEAM(k) do { if (IN(k) && IN((k) + 1)) xcd_barrier(bar); } while (0)
    const float* x_p = (const float*)args.in[I_XP]; const float* x_s = (const float*)args.in[I_XS];
    const float* cache_k = (const float*)args.in[I_CK]; const float* cache_v = (const float*)args.in[I_CV]; const int* ptab = (const int*)args.in[I_PT];
    const float* s_conv = (const float*)args.in[I_SCONV]; const float* s_ssm = (const float*)args.in[I_SSSM]; const float* s_hg = (const float*)args.in[I_SHG];
    const float* n_mix = (const float*)args.in[I_NMIX]; const float* n_ffn = (const float*)args.in[I_NFFN]; const float* n_fin = (const float*)args.in[I_NFIN];
    const float* w_ine = (const float*)args.in[I_WINE]; const float* sb_bias = (const float*)args.in[I_SBB]; const float* conv_w = (const float*)args.in[I_CONVW]; const float* conv_b = (const float*)args.in[I_CONVB];
    const float* dt_bias = (const float*)args.in[I_DTB]; const float* a_log = (const float*)args.in[I_ALOG]; const float* d_skip = (const float*)args.in[I_DSKIP]; const float* ssd_norm = (const float*)args.in[I_SSDN];
    const float* w_oute = (const float*)args.in[I_WOUTE]; const float* w_ino = (const float*)args.in[I_WINO]; const float* lb_raw = (const float*)args.in[I_LBRAW]; const float* hg_norm = (const float*)args.in[I_HGN];
    const float* w_outo = (const float*)args.in[I_WOUTO]; const float* w_ff1 = (const float*)args.in[I_W1]; const float* w_ff2 = (const float*)args.in[I_W2];
    float* out = args.out;
    bf16* WINE = (bf16*)(ws + WS_WINE); bf16* WOUTE = (bf16*)(ws + WS_WOUTE); bf16* WINO = (bf16*)(ws + WS_WINO); bf16* WOUTO = (bf16*)(ws + WS_WOUTO);
    bf16* W1T = (bf16*)(ws + WS_W1); bf16* W2T = (bf16*)(ws + WS_W2);
    bf16* HB = (bf16*)(ws + WS_HB); float* H = (float*)(ws + WS_H); float* SSQ = (float*)(ws + WS_SSQ); float* DTRAW = (float*)(ws + WS_DTRAW); float* SSM = (float*)(ws + WS_SSM);
    bf16* MIX = (bf16*)(ws + WS_MIX); bf16* QKV = (bf16*)(ws + WS_QKV); bf16* HID = (bf16*)(ws + WS_HID);
    float* S_H = (float*)(ws + WS_SMP + SM_H); float* S_IN = (float*)(ws + WS_SMP + SM_IN); float* S_HID = (float*)(ws + WS_SMP + SM_HID); float* S_YG = (float*)(ws + WS_SMP + SM_YG);
    float* S_OPART = (float*)(ws + WS_SMP + SM_OPART); float* S_LPART = (float*)(ws + WS_SMP + SM_LPART); float* S_O = (float*)(ws + WS_SMP + SM_O);

    if (IN(0)) {
        LAS float* scr = (LAS float*)(ldsl + wave * 16384);
        const int gw = bid * NWAVES + wave, NGW = G * NWAVES;
        constexpr int I_INE = (D / 64) * (NES / 32), I_SQ = (D / 64) * (D / 32), I_4K = (D / 64) * (FF / 32), I_DN = (FF / 64) * (D / 32);
        constexpr int NITEMS = I_INE + I_SQ + I_4K + I_SQ + 2 * I_4K + 2 * I_DN;
        for (int it = gw; it < NITEMS; it += NGW) {
            int r = it;
            if (r < I_INE) { p0_transpose_item(w_ine, D, EVEN_IN, NES, WINE, 0, n_mix, 0, scr, r, lane); continue; } r -= I_INE;
            if (r < I_SQ) { p0_transpose_item(w_oute, D, D, D, WOUTE, 512, ssd_norm, 512, scr, r, lane); continue; } r -= I_SQ;
            if (r < I_4K) { p0_transpose_item(w_ino, D, ODD_IN, ODD_IN, WINO, 0, n_mix + 1024, 0, scr, r, lane); continue; } r -= I_4K;
            if (r < I_SQ) { p0_transpose_item(w_outo, D, D, D, WOUTO, 0, hg_norm, 0, scr, r, lane); continue; } r -= I_SQ;
            if (r < I_4K) { p0_transpose_item(w_ff1, D, FF, FF, W1T, 0, n_ffn, 0, scr, r, lane); continue; } r -= I_4K;
            if (r < I_4K) { p0_transpose_item(w_ff1 + (size_t)D * FF, D, FF, FF, W1T + (size_t)FF * D, 0, n_ffn + 1024, 0, scr, r, lane); continue; } r -= I_4K;
            if (r < I_DN) { p0_transpose_item(w_ff2, FF, D, D, W2T, 0, nullptr, 0, scr, r, lane); continue; } r -= I_DN;
            p0_transpose_item(w_ff2 + (size_t)FF * D, FF, D, D, W2T + (size_t)D * FF, 0, nullptr, 0, scr, r, lane);
        }
        __syncthreads();
        float* wd = (float*)lds;
        for (int idx = tid; idx < 8192; idx += NTHR) { const int k = idx >> 3, c = idx & 7; wd[idx] = w_ine[(size_t)k * EVEN_IN + 3072 + c] * n_mix[k]; }
        __syncthreads();
        for (int m = gw; m < M; m += NGW) {
            const GAS f32x4* xr = (const GAS f32x4*)(x_p + (size_t)m * D) + lane;
            f32x4 v[4]; float s = 0.f; float d8[8];
#pragma unroll
            for (int c = 0; c < 8; ++c) d8[c] = 0.f;
#pragma unroll
            for (int j = 0; j < 4; ++j) { v[j] = xr[64 * j]; s += (v[j].x * v[j].x + v[j].y * v[j].y) + (v[j].z * v[j].z + v[j].w * v[j].w); }
#pragma unroll
            for (int j = 0; j < 4; ++j)
#pragma unroll
                for (int e = 0; e < 4; ++e) {
                    const int k = 256 * j + 4 * lane + e; const f32x4 w0 = *(const f32x4*)(wd + k * 8), w1 = *(const f32x4*)(wd + k * 8 + 4); const float xv = v[j][e];
                    d8[0] += xv * w0.x; d8[1] += xv * w0.y; d8[2] += xv * w0.z; d8[3] += xv * w0.w; d8[4] += xv * w1.x; d8[5] += xv * w1.y; d8[6] += xv * w1.z; d8[7] += xv * w1.w;
                }
            s = wave_sum(s);
#pragma unroll
            for (int c = 0; c < 8; ++c) d8[c] = wave_sum(d8[c]);
            const float rstd = 1.0f / sqrtf(s * (1.0f / D) + RMS_EPS);
            GAS unsigned long long* o8 = (GAS unsigned long long*)(HB + (size_t)m * D) + lane;
#pragma unroll
            for (int j = 0; j < 4; ++j) o8[64 * j] = (unsigned long long)pk2(v[j].x, v[j].y) | ((unsigned long long)pk2(v[j].z, v[j].w) << 32);
            if (lane < 4) *(f32x4*)(SSQ + (size_t)m * 16 + lane * 4) = (f32x4){lane == 0 ? s : 0.f, 0.f, 0.f, 0.f};
            if (lane < 2) *(f32x4*)(DTRAW + (size_t)m * 8 + lane * 4) = lane == 0 ? (f32x4){d8[0] * rstd, d8[1] * rstd, d8[2] * rstd, d8[3] * rstd} : (f32x4){d8[4] * rstd, d8[5] * rstd, d8[6] * rstd, d8[7] * rstd};
        }
        __syncthreads();
    }
    SEAM(0);
    if (IN(1)) {
        pg8::Gemm g{HB, WINE, M, NE, D}; pg8::StaticOrder S; S.init(M, NE, G, bid);
        typedef pg8::EpiBf16S<0, 1> Epi; Epi E{QKV, NE, SSQ, out + O_KP, out + O_VP, out + O_CP};
        pg8::gemm_phase<Epi, pg8::StaticOrder, true, true>(ldsl, g, S, E);
        if (bid < NES / 32) skinny_unit(lds, WINE, D, bid, BuildNorm{x_s}, SEpiInEven{S_IN, out + O_KS, out + O_VS});
    }
    SEAM(1);
    if (IN(2)) {
        decode_unit(lds, S_IN, cache_k, cache_v, ptab, sb_bias, S_OPART, S_LPART, bid >> 3, bid & 7);
        ssd_sample_unit(lds, S_IN, s_conv, s_ssm, conv_w, conv_b, dt_bias, a_log, d_skip, out + O_CS, out + O_SS, S_YG, bid >> 3, bid & 7);
        if (bid < 64) ssd_prompt_unit(lds, QKV, DTRAW, conv_w, conv_b, dt_bias, a_log, d_skip, MIX, SSM, out + O_SP, bid >> 3, bid & 7);
        for (;;) {
            int it = 0;
            if (lane == 0) it = (int)__hip_atomic_fetch_add(ctl + CW_QATT, 1u, __ATOMIC_RELAXED, __HIP_MEMORY_SCOPE_AGENT);
            it = __builtin_amdgcn_readfirstlane(it);
            if (it >= 2048) break;
            const int tb = 31 - (it >> 6), bh = it & 63;
            attn_prompt_item(QKV, sb_bias, MIX, bh >> 3, bh & 7, tb, lane);
        }
        __syncthreads();
    }
    SEAM(2);
    if (IN(3)) {
        pg8::Gemm g{MIX, WOUTE, M, D, D}; pg8::StaticOrder S; S.init(M, D, G, bid);
        typedef pg8::EpiResid<0, 8> Epi; Epi E{x_p, H, HB, SSQ, nullptr, 0.f, SSM};
        pg8::gemm_phase<Epi, pg8::StaticOrder, true, true>(ldsl, g, S, E);
        if (bid < D / 32) skinny_unit(lds, WOUTE, D, bid, BuildMixEven{S_YG, S_OPART, S_LPART}, SEpiResid{x_s, S_H});
    }
    SEAM(3);
    if (IN(4)) {
        pg8::Gemm g{HB, W1T, M, FF, D}; pg8::StaticOrder S; S.init(M, FF, G, bid);
        typedef pg8::EpiBf16S<1, 0> Epi; Epi E{HID, FF, SSQ, nullptr, nullptr, nullptr};
        pg8::gemm_phase<Epi, pg8::StaticOrder, true, true>(ldsl, g, S, E);
        if (bid < FF / 32) skinny_unit(lds, W1T, D, bid, BuildNorm{S_H}, SEpiRelu2{S_HID, FF});
    }
    SEAM(4);
    if (IN(5)) {
        pg8::Gemm g{HID, W2T, M, D, FF}; pg8::StaticOrder S; S.init(M, D, G, bid);
        typedef pg8::EpiResid<0, 0> Epi; Epi E{H, H, HB, SSQ, nullptr, 0.f, nullptr};
        pg8::gemm_phase<Epi, pg8::StaticOrder, true, true>(ldsl, g, S, E);
        if (bid < D / 32) skinny_unit(lds, W2T, FF, bid, BuildPlain{S_HID, FF}, SEpiResid{S_H, S_H});
    }
    SEAM(5);
    if (IN(6)) {
        pg8::Gemm g{HB, WINO, M, ODD_IN, D}; pg8::StaticOrder S; S.init(M, ODD_IN, G, bid);
        typedef pg8::EpiBf16S<0, 0> Epi; Epi E{HID, ODD_IN, SSQ, nullptr, nullptr, nullptr};
        pg8::gemm_phase<Epi, pg8::StaticOrder, true, true>(ldsl, g, S, E);
        if (bid < ODD_IN / 32) skinny_unit(lds, WINO, D, bid, BuildNorm{S_H}, SEpiStore{S_IN, ODD_IN});
    }
    SEAM(6);
    if (IN(7)) {
        hgrn_sample_unit(lds, S_IN, s_hg, lb_raw, out + O_GS, S_O, bid >> 3, bid & 7);
        hgrn_prompt_unit(lds, HID, lb_raw, hg_norm, MIX, SSM, out + O_GP, bid >> 5, (bid >> 2) & 7, bid & 3);
    }
    SEAM(7);
    if (IN(8)) {
        pg8::Gemm g{MIX, WOUTO, M, D, D}; pg8::StaticOrder S; S.init(M, D, G, bid);
        typedef pg8::EpiResid<32, 0> Epi; Epi E{H, H, HB, SSQ, SSM, 1.0f / 1024.0f, nullptr};
        pg8::gemm_phase<Epi, pg8::StaticOrder, true, true>(ldsl, g, S, E);
        if (bid < D / 32) skinny_unit(lds, WOUTO, D, bid, BuildMixOdd{S_O, S_IN}, SEpiResid{S_H, S_H});
    }
    SEAM(8);
    if (IN(9)) {
        pg8::Gemm g{HB, W1T + (size_t)FF * D, M, FF, D}; pg8::StaticOrder S; S.init(M, FF, G, bid);
        typedef pg8::EpiBf16S<1, 0> Epi; Epi E{HID, FF, SSQ, nullptr, nullptr, nullptr};
        pg8::gemm_phase<Epi, pg8::StaticOrder, true, true>(ldsl, g, S, E);
        if (bid < FF / 32) skinny_unit(lds, W1T + (size_t)FF * D, D, bid, BuildNorm{S_H}, SEpiRelu2{S_HID, FF});
    }
    SEAM(9);
    if (IN(10)) {
        pg8::Gemm g{HID, W2T + (size_t)D * FF, M, D, FF}; pg8::StaticOrder S; S.init(M, D, G, bid);
        typedef pg8::EpiResid<0, 0> Epi; Epi E{H, out + O_YP, HB, SSQ, nullptr, 0.f, nullptr};
        pg8::gemm_phase<Epi, pg8::StaticOrder, true, true>(ldsl, g, S, E);
        if (bid < D / 32) skinny_unit(lds, W2T + (size_t)D * FF, FF, bid, BuildPlain{S_HID, FF}, SEpiResid{S_H, S_H});
    }
    SEAM(10);
    if (IN(11)) {
        const int gw = bid * NWAVES + wave, NGW = G * NWAVES;
        for (int m = gw; m < M + MS; m += NGW) {
            const bool smp = m >= M;
            const float* src = smp ? S_H + (size_t)(m - M) * D : out + O_YP + (size_t)m * D;
            float* dst = smp ? out + O_YS + (size_t)(m - M) * D : out + O_YP + (size_t)m * D;
            f32x4 v[4]; float s = 0.f;
#pragma unroll
            for (int j = 0; j < 4; ++j) { v[j] = *((const f32x4*)src + lane + 64 * j); s += (v[j].x * v[j].x + v[j].y * v[j].y) + (v[j].z * v[j].z + v[j].w * v[j].w); }
            s = wave_sum(s);
            const float rstd = 1.0f / sqrtf(s * (1.0f / D) + RMS_EPS);
#pragma unroll
            for (int j = 0; j < 4; ++j) { const f32x4 w = *((const f32x4*)n_fin + lane + 64 * j); *((f32x4*)dst + lane + 64 * j) = v[j] * rstd * w; }
        }
    }
#undef IN
#undef SEAM
}

constexpr int N_PHASES = 12;
#ifndef MK_SPLIT
#define MK_SPLIT 0
#endif
extern "C" void kernel_launch(void* const* d_in, const int* in_sizes, int n_in, void* d_out, int out_size, void* d_ws, size_t ws_size, hipStream_t stream) {
    static int grid = 0;
    if (grid == 0) {
        if (n_in != N_IN || (size_t)out_size != O_END || ws_size < WS_END) { fprintf(stderr, "kernel_launch: unexpected sizes n_in %d out %d ws %zu\n", n_in, out_size, ws_size); if (ws_size < WS_END) { grid = -1; return; } }
        int dev = 0, cus = 0, per_cu = 0;
        if (hipGetDevice(&dev) != hipSuccess || hipDeviceGetAttribute(&cus, hipDeviceAttributeMultiprocessorCount, dev) != hipSuccess) { grid = -1; return; }
        if (hipFuncSetAttribute((const void*)mk_fwd, hipFuncAttributeMaxDynamicSharedMemorySize, LDS_BYTES) != hipSuccess) { fprintf(stderr, "kernel_launch: hipFuncSetAttribute failed\n"); grid = -1; return; }
        if (hipOccupancyMaxActiveBlocksPerMultiprocessor(&per_cu, (const void*)mk_fwd, NTHR, LDS_BYTES) != hipSuccess || per_cu < 1) fprintf(stderr, "kernel_launch: occupancy query says %d\n", per_cu);
        (void)hipGetLastError();
        grid = cus;
        if (grid != 256) fprintf(stderr, "kernel_launch: %d CUs (built for 256)\n", grid);
    }
    if (grid < 0) return;
    (void)hipMemsetAsync((char*)d_ws + WS_CTL, 0, CTL_ZERO_BYTES, stream);
    Args a{};
    for (int i = 0; i < N_IN; ++i) a.in[i] = d_in[i];
    a.out = (float*)d_out; a.ws = (unsigned char*)d_ws;
#if MK_SPLIT
    for (int p = 0; p < N_PHASES; ++p) { a.ph_lo = p; a.ph_hi = p + 1; hipLaunchKernelGGL(mk_fwd, dim3(grid), dim3(NTHR), LDS_BYTES, stream, a); }
#else
    a.ph_lo = 0; a.ph_hi = N_PHASES; hipLaunchKernelGGL(mk_fwd, dim3(grid), dim3(NTHR), LDS_BYTES, stream, a);
#endif
}
```

```cpp
#include <hip/hip_runtime.h>
#include <cstdio>
#include <cstdint>
namespace pg8 {
#define PG8_LAS __attribute__((address_space(3)))
typedef unsigned short bf16_t;
typedef short bf16x8 __attribute__((ext_vector_type(8)));
typedef float f32x4 __attribute__((ext_vector_type(4)));
typedef unsigned u32x4 __attribute__((ext_vector_type(4)));
constexpr int BM = 256, BK = 64, HALF = 128, HTB = HALF * BK * 2  , STAGE_BYTES = 8 * HTB, NXCD = 8, WGM = 4;

__host__ __device__ __forceinline__ int lds_byte(int r, int c) { const int st = (r >> 4) * 2 + (c >> 5), rr = r & 15, cc = c & 31, ob = rr * 64 + cc * 2; return st * 1024 + (ob ^ (((ob >> 9) & 1) << 5)); }
__host__ __device__ __forceinline__ void stage_rc(int b, int& R, int& C) { const int st = b / 1024, sb = b % 1024, swz = sb ^ (((sb >> 9) & 1) << 5); R = (st >> 1) * 16 + swz / 64; C = (st & 1) * 32 + (swz % 64) / 2; }
__host__ __device__ __forceinline__ int perm32(int rho) { const int n = rho >> 4, i = rho & 15; return 8 * (i >> 2) + 4 * n + (i & 3); }

struct Unit { int pm, pn, idx; };
struct Gemm { const bf16_t* A; const bf16_t* Bt; int M, N, K; };

struct StaticOrder {
    int nM, nN, nwg, G, c;
    __host__ __device__ __forceinline__ void init(int M, int N, int G_, int c_) { nM = M / BM; nN = N / BM; nwg = nM * nN; G = G_; c = c_; }
    __host__ __device__ __forceinline__ bool next(int i, Unit& u) const {
        const long L = (long)i * G + c; if (L >= nwg) return false;
        int wgid = (int)L; { const int q = nwg / NXCD, r = nwg % NXCD, xcd = wgid % NXCD, off = wgid / NXCD; wgid = (xcd < r ? xcd * (q + 1) : r * (q + 1) + (xcd - r) * q) + off; }
        const int nig = WGM * nN, gid = wgid / nig, fm = gid * WGM, gsz = (nM - fm) < WGM ? (nM - fm) : WGM;
        u.pm = fm + ((wgid % nig) % gsz); u.pn = (wgid % nig) / gsz; u.idx = i; return true;
    }
    __device__ __forceinline__ void a_ready(const Unit&) const {}
    __device__ __forceinline__ void done(const Unit&) const {}
};

typedef float cvt_f32x2_t __attribute__((ext_vector_type(2))); typedef __bf16 cvt_bf16x2_t __attribute__((ext_vector_type(2)));
__device__ __forceinline__ unsigned cvt_pk_bf16(float lo, float hi) { const cvt_f32x2_t v = {lo, hi}; return __builtin_bit_cast(unsigned, __builtin_convertvector(v, cvt_bf16x2_t)); }
typedef unsigned u32x2 __attribute__((ext_vector_type(2)));
constexpr float RMS_EPS = 1e-6f;
constexpr float LOG2E = 1.4426950408889634f, QSCALE = 0.125f * 1.4426950408889634f;
__device__ __forceinline__ float sum4(f32x4 a) { return (a.x + a.y) + (a.z + a.w); }
template <int NP> __device__ __forceinline__ float rstd_from(const float* part, int row, float inv_n) {
    const f32x4* p = (const f32x4*)(part + (size_t)row * NP); float s = 0.f;
#pragma unroll
    for (int i = 0; i < NP / 4; ++i) s += sum4(p[i]);
    return 1.0f / sqrtf(s * inv_n + RMS_EPS);
}
template <int ACT, int MODE> struct EpiBf16S {
    static constexpr bool PERM = true, AFTER_DRAIN = false, RESID_LDS = false, RESID_REMAP = false; static constexpr int MIDK = 0;
    bf16_t* O; int ldc; const PG8_LAS float* rstab; float* kout; float* vout; float* convout;
    __device__ __forceinline__ void midk(f32x4 (&)[2][2][4][2], const Unit&, int, int, int, int) const {}
    __device__ __forceinline__ void operator()(const f32x4 (&acc)[2][2][4][2], const Unit& u, int wr, int wc, int fr, int fq) const {
        const int pn = u.pn;
#pragma unroll
        for (int ai = 0; ai < 2; ++ai)
#pragma unroll
            for (int m = 0; m < 4; ++m) {
                const int row = u.pm * BM + ai * HALF + wr * 64 + m * 16 + fr;
                float rs = rstab[u.idx * BM + ai * HALF + wr * 64 + m * 16 + fr];
                if (MODE == 1 && pn < 2) rs *= QSCALE;
#pragma unroll
                for (int bj = 0; bj < 2; ++bj) {
                    const int col0 = pn * BM + bj * HALF + wc * 32 + fq * 8;
                    f32x4 v0 = acc[ai][bj][m][0] * rs, v1 = acc[ai][bj][m][1] * rs;
                    if (ACT == 1) {
                        v0.x = fmaxf(v0.x, 0.f); v0.y = fmaxf(v0.y, 0.f); v0.z = fmaxf(v0.z, 0.f); v0.w = fmaxf(v0.w, 0.f);
                        v1.x = fmaxf(v1.x, 0.f); v1.y = fmaxf(v1.y, 0.f); v1.z = fmaxf(v1.z, 0.f); v1.w = fmaxf(v1.w, 0.f);
                        v0 = v0 * v0; v1 = v1 * v1;
                    }
                    u32x4 w; w.x = cvt_pk_bf16(v0[0], v0[1]); w.y = cvt_pk_bf16(v0[2], v0[3]); w.z = cvt_pk_bf16(v1[0], v1[1]); w.w = cvt_pk_bf16(v1[2], v1[3]);
                    *(u32x4*)(O + (size_t)row * ldc + col0) = w;
                    if (MODE == 1) {
                        if (pn >= 2 && pn < 6) {
                            float* dst = (pn < 4 ? kout + (size_t)row * 512 + (col0 - 512) : vout + (size_t)row * 512 + (col0 - 1024));
                            __builtin_nontemporal_store(v0, (f32x4*)dst); __builtin_nontemporal_store(v1, (f32x4*)(dst + 4));
                        }
                        if (pn >= 8) {
                            const int t = row & 2047;
                            if (t >= 2045) { float* dst = convout + ((size_t)(row >> 11) * 3 + (t - 2045)) * 1024 + (col0 - 2048); *(f32x4*)dst = v0; *(f32x4*)(dst + 4) = v1; }
                        }
                    }
                }
                asm volatile("" ::: "memory");
            }
    }
};
template <int RSN, int MIDK_T, bool FINAL = false, int RL = 0> struct EpiResid {
    static constexpr bool PERM = (RL != 0), AFTER_DRAIN = (RL != 0), RESID_LDS = (RL != 0), RESID_REMAP = (RL == 2); static constexpr int MIDK = MIDK_T;
    __device__ __forceinline__ const char* resid_ptr(const Unit& u) const { return (const char*)(hb + (size_t)(u.pm * BM) * 1024 + u.pn * BM); }
    __device__ __forceinline__ void fused(const f32x4 (&acc)[2][2][4][2], const Unit& u, int wr, int wc, int fr, int fq, PG8_LAS unsigned char* lds, int, int) const {
        const int pn = u.pn;
#pragma unroll
        for (int ai = 0; ai < 2; ++ai)
#pragma unroll
            for (int m = 0; m < 4; ++m) {
                const int rl = wr * 64 + m * 16 + fr;
                const int row = u.pm * BM + ai * HALF + rl;
                float rs = 1.0f;
                if (RSN > 0) rs = rs_tab[ai * HALF + rl];
                float sq = 0.f;
#pragma unroll
                for (int bj = 0; bj < 2; ++bj) {
                    const int c = wc * 32 + fq * 8;
                    const size_t off = (size_t)row * 1024 + pn * BM + bj * HALF + c;
                    const u32x4 hh = *(const PG8_LAS u32x4*)(lds + (bj * 4 + (c >> 6) * 2 + ai) * HTB + lds_byte(rl, c & 63));
                    const f32x4 a0 = acc[ai][bj][m][0] * rs, a1 = acc[ai][bj][m][1] * rs;
                    const float h0 = __uint_as_float(hh.x << 16) + a0.x, h1 = __uint_as_float(hh.x & 0xffff0000u) + a0.y;
                    const float h2 = __uint_as_float(hh.y << 16) + a0.z, h3 = __uint_as_float(hh.y & 0xffff0000u) + a0.w;
                    const float h4 = __uint_as_float(hh.z << 16) + a1.x, h5 = __uint_as_float(hh.z & 0xffff0000u) + a1.y;
                    const float h6 = __uint_as_float(hh.w << 16) + a1.z, h7 = __uint_as_float(hh.w & 0xffff0000u) + a1.w;
                    u32x4 w; w.x = cvt_pk_bf16(h0, h1); w.y = cvt_pk_bf16(h2, h3); w.z = cvt_pk_bf16(h4, h5); w.w = cvt_pk_bf16(h6, h7); *(u32x4*)(hb + off) = w;
                    sq += ((h0 * h0 + h1 * h1) + (h2 * h2 + h3 * h3)) + ((h4 * h4 + h5 * h5) + (h6 * h6 + h7 * h7));
                }
                sq += __shfl_xor(sq, 16); sq += __shfl_xor(sq, 32);
                if (fq == 0) ssq_out[(size_t)row * 16 + pn * 4 + wc] = sq;
            }
    }
    float* hnew; bf16_t* hb; float* ssq_out; const PG8_LAS float* rs_tab; const PG8_LAS float* mid_tab;
    __device__ __forceinline__ void midk(f32x4 (&acc)[2][2][4][2], const Unit& u, int wr, int wc, int fr, int fq) const {
#pragma unroll
        for (int ai = 0; ai < 2; ++ai)
#pragma unroll
            for (int m = 0; m < 4; ++m) {
                const float rs = mid_tab[ai * HALF + wr * 64 + m * 16 + fr];
#pragma unroll
                for (int bj = 0; bj < 2; ++bj)
#pragma unroll
                    for (int n = 0; n < 2; ++n) acc[ai][bj][m][n] = acc[ai][bj][m][n] * rs;
            }
    }
    __device__ __forceinline__ void operator()(const f32x4 (&acc)[2][2][4][2], const Unit& u, int wr, int wc, int fr, int fq) const {
        const int pn = u.pn;
#pragma unroll
        for (int ai = 0; ai < 2; ++ai) {
            u32x2 ho[4][2][2];
#pragma unroll
            for (int m = 0; m < 4; ++m)
#pragma unroll
                for (int bj = 0; bj < 2; ++bj)
#pragma unroll
                    for (int n = 0; n < 2; ++n)
                        ho[m][bj][n] = *(const u32x2*)(hb + (size_t)(u.pm * BM + ai * HALF + wr * 64 + m * 16 + fr) * 1024 + pn * BM + bj * HALF + wc * 32 + n * 16 + fq * 4);
#pragma unroll
            for (int m = 0; m < 4; ++m) {
                const int row = u.pm * BM + ai * HALF + wr * 64 + m * 16 + fr;
                float rs = 1.0f;
                if (RSN > 0) rs = rs_tab[ai * HALF + wr * 64 + m * 16 + fr];
                float sq = 0.f;
#pragma unroll
                for (int bj = 0; bj < 2; ++bj)
#pragma unroll
                    for (int n = 0; n < 2; ++n) {
                        const size_t off = (size_t)row * 1024 + pn * BM + bj * HALF + wc * 32 + n * 16 + fq * 4;
                        const u32x2 hh = ho[m][bj][n];
                        const f32x4 av = acc[ai][bj][m][n] * rs;
                        const float h0 = __uint_as_float(hh.x << 16) + av.x, h1 = __uint_as_float(hh.x & 0xffff0000u) + av.y;
                        const float h2 = __uint_as_float(hh.y << 16) + av.z, h3 = __uint_as_float(hh.y & 0xffff0000u) + av.w;
                        if (FINAL) *(f32x4*)(hnew + off) = (f32x4){h0, h1, h2, h3};
                        else { u32x2 w; w.x = cvt_pk_bf16(h0, h1); w.y = cvt_pk_bf16(h2, h3); *(u32x2*)(hb + off) = w; }
                        sq += (h0 * h0 + h1 * h1) + (h2 * h2 + h3 * h3);
                    }
                sq += __shfl_xor(sq, 16); sq += __shfl_xor(sq, 32);
                if (fq == 0) ssq_out[(size_t)row * 16 + pn * 4 + wc] = sq;
            }
            asm volatile("" ::: "memory");
        }
    }
};
struct NoPre { __device__ __forceinline__ void operator()() const {} };
template <class Epi, class Sched, bool ALIGN_EPI = false, bool SP2 = false, int AUXA = 0, class Pre = NoPre>
__device__ __forceinline__ void gemm_phase(PG8_LAS unsigned char* lds, const Gemm g, const Sched& S, const Epi& E, const Pre& pre = Pre()) {
    const int tid = threadIdx.x, wid = __builtin_amdgcn_readfirstlane(tid >> 6), lane = tid & 63, wr = wid >> 2, wc = wid & 3, fr = lane & 15, fq = lane >> 4;
    const int K = g.K, nt = K / BK;
    unsigned voffA[2], voffB[2];
#pragma unroll
    for (int i = 0; i < 2; ++i) { int R, C; stage_rc(tid * 16 + i * 8192, R, C); const int Rb = Epi::PERM ? ((R & ~31) + perm32(R & 31)) : R;
        voffA[i] = (unsigned)(R * K + C) * 2u; voffB[i] = (unsigned)(Rb * K + C) * 2u; }
    unsigned voffR[2];
#pragma unroll
    for (int i = 0; i < 2; ++i) { int R, C; stage_rc(tid * 16 + i * 8192, R, C); voffR[i] = (unsigned)(R * 1024 + C) * 2u; }
    const size_t hstepR = (size_t)HALF * 1024 * 2;
    const size_t kstep = (size_t)(BK * 2);
    const size_t hstep = (size_t)HALF * K * 2;
    const size_t tstep = 2 * hstep;
    const unsigned ldsw = (unsigned)wid * 1024u;
    const int aoff = lds_byte(wr * 64 + fr, fq * 8), boff = lds_byte(wc * 32 + fr, fq * 8);
#define PG8_SA(b, h) (((b) * 2 + (h)) * HTB)
#define PG8_SB(b, h) ((4 + (b) * 2 + (h)) * HTB)
#define PG8_STAGE(bufoff, gbase, voff) do { _Pragma("unroll") for (int _i = 0; _i < 2; ++_i) \
        __builtin_amdgcn_global_load_lds((const unsigned*)((const char*)(gbase) + (voff)[_i]), (PG8_LAS unsigned*)(lds + (bufoff) + ldsw + _i * 8192), 16, 0, (&(voff)[0] == &voffA[0]) ? AUXA : 0); } while (0)
#define PG8_LDA(dst, b, h) do { _Pragma("unroll") for (int m = 0; m < 4; ++m) _Pragma("unroll") for (int k = 0; k < 2; ++k) dst[m][k] = *(const PG8_LAS bf16x8*)(lds + PG8_SA(b, h) + aoff + m * 2048 + k * 1024); } while (0)
#define PG8_LDB(dst, b, h) do { _Pragma("unroll") for (int n = 0; n < 2; ++n) _Pragma("unroll") for (int k = 0; k < 2; ++k) dst[n][k] = *(const PG8_LAS bf16x8*)(lds + PG8_SB(b, h) + boff + n * 2048 + k * 1024); } while (0)
#define PG8_MMA(ai, bj, At, Bt) do { __builtin_amdgcn_s_setprio(1); _Pragma("unroll") for (int m = 0; m < 4; ++m) _Pragma("unroll") for (int n = 0; n < 2; ++n) _Pragma("unroll") for (int k = 0; k < 2; ++k) \
        acc[ai][bj][m][n] = __builtin_amdgcn_mfma_f32_16x16x32_bf16(Bt[n][k], At[m][k], acc[ai][bj][m][n], 0, 0, 0); __builtin_amdgcn_s_setprio(0); } while (0)
#define PG8_WAIT_V(n) asm volatile("s_waitcnt vmcnt(" #n ")" ::: "memory")
#define PG8_WAIT_L(n) asm volatile("s_waitcnt lgkmcnt(" #n ")" ::: "memory")
#define PG8_BAR __builtin_amdgcn_s_barrier()
#define PG8_SCHED __builtin_amdgcn_sched_barrier(0)
    Unit cur, nxt; int ui = 0;
    if (!S.next(0, cur)) return;
    f32x4 acc[2][2][4][2];
#pragma unroll
    for (int a = 0; a < 2; ++a)
#pragma unroll
        for (int b = 0; b < 2; ++b)
#pragma unroll
            for (int m = 0; m < 4; ++m)
#pragma unroll
                for (int n = 0; n < 2; ++n) acc[a][b][m][n] = (f32x4){0.f, 0.f, 0.f, 0.f};
    bf16x8 At[4][2], B0[2][2], B1[2][2];
    const char* cA = (const char*)g.A + (size_t)cur.pm * tstep; const char* cB = (const char*)g.Bt + (size_t)cur.pn * tstep;
    S.a_ready(cur);
    if constexpr (SP2) {
        PG8_STAGE(PG8_SB(0, 0), cB, voffB); PG8_STAGE(PG8_SB(0, 1), cB + hstep, voffB); PG8_STAGE(PG8_SA(0, 0), cA, voffA); PG8_STAGE(PG8_SA(0, 1), cA + hstep, voffA);
        pre();
        if (wr == 1) PG8_BAR;
        PG8_WAIT_V(2); PG8_BAR;
        PG8_STAGE(PG8_SB(1, 0), cB + kstep, voffB); PG8_STAGE(PG8_SA(1, 0), cA + kstep, voffA); PG8_STAGE(PG8_SB(1, 1), cB + hstep + kstep, voffB);
        PG8_WAIT_V(6); PG8_BAR;
    } else {
        PG8_STAGE(PG8_SB(0, 0), cB, voffB); PG8_STAGE(PG8_SA(0, 0), cA, voffA); PG8_STAGE(PG8_SB(0, 1), cB + hstep, voffB); PG8_STAGE(PG8_SA(0, 1), cA + hstep, voffA);
        if (wr == 1) PG8_BAR;
        PG8_WAIT_V(4); PG8_BAR;
        PG8_STAGE(PG8_SB(1, 0), cB + kstep, voffB); PG8_STAGE(PG8_SA(1, 0), cA + kstep, voffA); PG8_STAGE(PG8_SB(1, 1), cB + hstep + kstep, voffB);
        PG8_WAIT_V(6); PG8_BAR;
    }
    for (;;) {
        const bool has_next = S.next(ui + 1, nxt);
        const char* nA = has_next ? (const char*)g.A + (size_t)nxt.pm * tstep : cA; const char* nB = has_next ? (const char*)g.Bt + (size_t)nxt.pn * tstep : cB;
        if constexpr (Epi::RESID_LDS) { if (!has_next) { nA = E.resid_ptr(cur); nB = nA + 2 * kstep; } }
        for (int t = 0; t < nt; t += 2) {
            if constexpr (Epi::MIDK > 0) { if (t == Epi::MIDK) E.midk(acc, cur, wr, wc, fr, fq); }
            const bool last = (t == nt - 2);
            const char* a1 = cA + (size_t)(t + 1) * kstep;
            const char* a2 = last ? nA : cA + (size_t)(t + 2) * kstep; const char* b2 = last ? nB : cB + (size_t)(t + 2) * kstep;
            const char* a3 = a2 + kstep; const char* b3 = b2 + kstep;
            if (last && has_next) S.a_ready(nxt);
            unsigned tA[2] = {voffA[0], voffA[1]}, tB[2] = {voffB[0], voffB[1]}; size_t th = hstep;
            if constexpr (Epi::RESID_REMAP) { if (last && !has_next) { tA[0] = voffR[0]; tA[1] = voffR[1]; tB[0] = voffR[0]; tB[1] = voffR[1]; th = hstepR; } }
            if constexpr (SP2) {
            PG8_LDB(B0, 0, 0); PG8_LDB(B1, 0, 1); PG8_SCHED; PG8_LDA(At, 0, 0); PG8_STAGE(PG8_SA(1, 1), a1 + hstep, voffA);
            PG8_WAIT_V(8); PG8_WAIT_L(0); PG8_BAR; PG8_MMA(0, 0, At, B0); PG8_MMA(0, 1, At, B1); PG8_BAR; PG8_SCHED;
            PG8_LDA(At, 0, 1); PG8_STAGE(PG8_SB(0, 0), b2, tB); PG8_STAGE(PG8_SB(0, 1), b2 + th, tB); PG8_STAGE(PG8_SA(0, 0), a2, tA);
            PG8_WAIT_V(8); PG8_WAIT_L(0); PG8_BAR; PG8_MMA(1, 0, At, B0); PG8_MMA(1, 1, At, B1); PG8_BAR; PG8_SCHED;
            PG8_LDB(B0, 1, 0); PG8_LDB(B1, 1, 1); PG8_SCHED; PG8_LDA(At, 1, 0); PG8_STAGE(PG8_SA(0, 1), a2 + th, tA);
            PG8_WAIT_V(8); PG8_WAIT_L(0); PG8_BAR; PG8_MMA(0, 0, At, B0); PG8_MMA(0, 1, At, B1); PG8_BAR; PG8_SCHED;
            PG8_LDA(At, 1, 1); PG8_STAGE(PG8_SB(1, 0), b3, tB); PG8_STAGE(PG8_SB(1, 1), b3 + th, tB); PG8_STAGE(PG8_SA(1, 0), a3, tA);
            PG8_WAIT_V(8); PG8_WAIT_L(0); PG8_BAR; PG8_MMA(1, 0, At, B0); PG8_MMA(1, 1, At, B1); PG8_BAR; PG8_SCHED;
            } else {
            PG8_LDB(B0, 0, 0); PG8_SCHED; PG8_LDA(At, 0, 0); PG8_STAGE(PG8_SA(1, 1), a1 + hstep, voffA);
            PG8_WAIT_L(8); PG8_BAR; PG8_WAIT_L(0); PG8_MMA(0, 0, At, B0); PG8_BAR; PG8_SCHED;
            PG8_LDB(B1, 0, 1); PG8_STAGE(PG8_SB(0, 0), b2, voffB);
            PG8_BAR; PG8_WAIT_L(0); PG8_MMA(0, 1, At, B1); PG8_BAR;
            PG8_LDA(At, 0, 1); PG8_STAGE(PG8_SA(0, 0), a2, voffA);
            PG8_BAR; PG8_WAIT_L(0); PG8_MMA(1, 0, At, B0); PG8_BAR; PG8_SCHED;
            PG8_STAGE(PG8_SB(0, 1), b2 + hstep, voffB);
            PG8_WAIT_V(6); PG8_BAR; PG8_MMA(1, 1, At, B1); PG8_BAR;
            PG8_LDB(B0, 1, 0); PG8_SCHED; PG8_LDA(At, 1, 0); PG8_STAGE(PG8_SA(0, 1), a2 + hstep, voffA);
            PG8_WAIT_L(8); PG8_BAR; PG8_WAIT_L(0); PG8_MMA(0, 0, At, B0); PG8_BAR; PG8_SCHED;
            PG8_LDB(B1, 1, 1); PG8_STAGE(PG8_SB(1, 0), b3, voffB);
            PG8_BAR; PG8_WAIT_L(0); PG8_MMA(0, 1, At, B1); PG8_BAR;
            PG8_LDA(At, 1, 1); PG8_STAGE(PG8_SA(1, 0), a3, voffA);
            PG8_BAR; PG8_WAIT_L(0); PG8_MMA(1, 0, At, B0); PG8_BAR; PG8_SCHED;
            PG8_STAGE(PG8_SB(1, 1), b3 + hstep, voffB);
            PG8_WAIT_V(6); PG8_BAR; PG8_MMA(1, 1, At, B1); PG8_BAR;
            }
        }
        if constexpr (ALIGN_EPI) { if (wr == 0) PG8_BAR; }
        if constexpr (Epi::RESID_LDS) { if (!has_next) { if constexpr (Epi::RESID_REMAP) PG8_STAGE(PG8_SA(1, 1), nA + kstep + hstepR, voffR); else PG8_STAGE(PG8_SA(1, 1), nA + kstep + hstep, voffA); } }
        if constexpr (!Epi::AFTER_DRAIN) { E(acc, cur, wr, wc, fr, fq); S.done(cur); }
        if (!has_next) break;
#pragma unroll
        for (int a = 0; a < 2; ++a)
#pragma unroll
            for (int b = 0; b < 2; ++b)
#pragma unroll
                for (int m = 0; m < 4; ++m)
#pragma unroll
                    for (int n = 0; n < 2; ++n) acc[a][b][m][n] = (f32x4){0.f, 0.f, 0.f, 0.f};
        cur = nxt; cA = nA; cB = nB; ++ui;
        if constexpr (ALIGN_EPI) { if (wr == 1) PG8_BAR; }
    }
    PG8_WAIT_V(0);
    if constexpr (!ALIGN_EPI) { if (wr == 0) PG8_BAR; }
    PG8_BAR;
    if constexpr (Epi::AFTER_DRAIN) { E.fused(acc, cur, wr, wc, fr, fq, lds, wid, lane); S.done(cur); }
#undef PG8_SA
#undef PG8_SB
#undef PG8_STAGE
#undef PG8_LDA
#undef PG8_LDB
#undef PG8_MMA
#undef PG8_WAIT_V
#undef PG8_WAIT_L
#undef PG8_BAR
#undef PG8_SCHED
}
}

using pg8::RMS_EPS; using pg8::LOG2E; using pg8::u32x4;
constexpr int NWAVES = 8, NTHR = 512;
constexpr int NB = 8, T = 2048, D = 1024, FF = 4096, M = NB * T;
constexpr int MS = 32;
constexpr int PAST = 8192, PAGE = 128, NPAGES = 64;
constexpr int EVEN_IN = 3080, NE = 3072, NES = 3104;
constexpr int ODD_IN = 4096;
constexpr int N_PHYS = 2560;
constexpr int DRING = 6;
constexpr int NDP = 8;
enum { I_XP = 0, I_XS, I_CK, I_CV, I_PT, I_SCONV, I_SSSM, I_SHG, I_NMIX, I_NFFN, I_NFIN, I_WINE, I_SBB, I_CONVW, I_CONVB, I_DTB, I_ALOG, I_DSKIP, I_SSDN, I_WOUTE, I_WINO, I_LBRAW, I_HGN, I_WOUTO, I_W1, I_W2, N_IN };
constexpr size_t O_YP = 0, O_YS = O_YP + (size_t)M * D, O_KP = O_YS + (size_t)MS * D, O_VP = O_KP + (size_t)M * 512, O_KS = O_VP + (size_t)M * 512, O_VS = O_KS + (size_t)MS * 512,
                 O_CP = O_VS + (size_t)MS * 512, O_CS = O_CP + (size_t)NB * 3 * 1024, O_SP = O_CS + (size_t)MS * 3 * 1024, O_SS = O_SP + (size_t)NB * 8 * 64 * 128,
                 O_GP = O_SS + (size_t)MS * 8 * 64 * 128, O_GS = O_GP + (size_t)NB * 8 * 128 * 128, O_END = O_GS + (size_t)MS * 8 * 128 * 128;
constexpr size_t MiB = 1u << 20;
constexpr size_t WS_CTL = 0, CTL_ZERO_BYTES = 1 * MiB;
constexpr size_t WS_WINE = 2 * MiB;
constexpr size_t WS_WOUTE = 10 * MiB;
constexpr size_t WS_WINO = 12 * MiB;
constexpr size_t WS_WOUTO = 20 * MiB;
constexpr size_t WS_W1 = 22 * MiB;
constexpr size_t WS_W2 = 38 * MiB;
constexpr size_t WS_HB = 54 * MiB;
constexpr size_t WS_H = 86 * MiB;
constexpr size_t WS_SSQ = 150 * MiB;
constexpr size_t WS_DTRAW = 151 * MiB;
constexpr size_t WS_SSM = 152 * MiB;
constexpr size_t WS_MIX = 154 * MiB;
constexpr size_t WS_QKV = 186 * MiB;
constexpr size_t WS_HID = 282 * MiB;
constexpr size_t WS_SMP = 410 * MiB;
constexpr size_t SM_H = 0, SM_IN = SM_H + (size_t)MS * 1024 * 4, SM_HID = SM_IN + (size_t)MS * 4096 * 4, SM_YG = SM_HID + (size_t)MS * 4096 * 4, SM_OPART = SM_YG + (size_t)MS * 512 * 4,
                 SM_LPART = SM_OPART + (size_t)MS * NDP * 512 * 4, SM_O = SM_LPART + (size_t)MS * NDP * 8 * 4, SM_END = SM_O + (size_t)MS * 1024 * 4;
constexpr size_t WS_END = WS_SMP + 4 * MiB;
static_assert(SM_END <= 4 * MiB, "sample scratch");
constexpr int CW_TS = 1024, CW_TMO = 0, CW_QATT = 64, CW_QDEC = 128, CW_QSSD = 192, CW_CONV = 224, CW_BAR = 4096;

constexpr int RING_BYTES = 131072, MISC_OFF = RING_BYTES + 320, LDS_BYTES = 147456;

#define GAS __attribute__((address_space(1)))
#define LAS __attribute__((address_space(3)))
typedef unsigned short bf16;
typedef unsigned v4u __attribute__((ext_vector_type(4)));
typedef float f32x4 __attribute__((ext_vector_type(4)));
typedef short bf16x8 __attribute__((ext_vector_type(8)));
typedef GAS unsigned gu32;
typedef GAS unsigned long long gu64;
#define RLX_AGENT __ATOMIC_RELAXED, __HIP_MEMORY_SCOPE_AGENT
#define LDS_WAIT() asm volatile("s_waitcnt lgkmcnt(0)" ::: "memory")
#define VM_WAIT() asm volatile("s_waitcnt vmcnt(0)" ::: "memory")
__device__ __forceinline__ unsigned long long rt() { return __builtin_amdgcn_s_memrealtime(); }
__device__ __forceinline__ unsigned f2bf(float f) { unsigned u = __builtin_bit_cast(unsigned, f); return (u + 0x7fffu + ((u >> 16) & 1u)) >> 16; }
__device__ __forceinline__ unsigned pk2(float lo, float hi) { return pg8::cvt_pk_bf16(lo, hi); }

#define XB_TMO      128
#define XB_XCNT(j)  (256  + 64 * (j))
#define XB_XSUB(j)  (1280 + 64 * (j))
#define XB_XGEN(j)  (2304 + 64 * (j))
#define XB_TOP      3328
#define XB_TOPGEN   3392
#define XCD_BAR_WORDS 3456
#define XB_SPIN_CAP (1u << 18)

__device__ __forceinline__ unsigned xb_ld(unsigned* p)              { return __hip_atomic_load(p, __ATOMIC_RELAXED, __HIP_MEMORY_SCOPE_AGENT); }
__device__ __forceinline__ unsigned xb_add(unsigned* p, unsigned v) { return __hip_atomic_fetch_add(p, v, __ATOMIC_RELAXED, __HIP_MEMORY_SCOPE_AGENT); }
__device__ __forceinline__ unsigned xb_xcc_id() { return (unsigned)__builtin_amdgcn_s_getreg((3 << 11) | 20) & 0xFu; }
#define XB_SPIN(cond, bar) do { unsigned _sp = 0; while (cond) { __builtin_amdgcn_s_sleep(1); \
    if ((++_sp & 255u) == 0u) { if (xb_ld(&(bar)[XB_TMO])) break; if (_sp > XB_SPIN_CAP) { atomicAdd(&(bar)[XB_TMO], 1u); break; } } } } while (0)

struct XcdBarrier {
    unsigned* bar; unsigned x;
    volatile LAS unsigned* st;
};

__device__ __forceinline__ XcdBarrier xcd_barrier_post(unsigned* bar, volatile LAS unsigned* st) {
    XcdBarrier b; b.bar = bar; b.x = xb_xcc_id(); b.st = st;
    if (threadIdx.x == 0) (void)xb_add(&bar[XB_XCNT(b.x)], 1u);
    return b;
}
__device__ __forceinline__ void xcd_barrier_complete(unsigned* bar, unsigned x, unsigned& nloc, unsigned& nx) {
    const unsigned G = gridDim.x * gridDim.y * gridDim.z;
    unsigned sum, cnt, mine, sp = 0u;
    for (;;) {
        sum = 0u; cnt = 0u; mine = 0u;
#pragma unroll
        for (unsigned j = 0; j < 16; ++j) { const unsigned c = xb_ld(&bar[XB_XCNT(j)]); sum += c; cnt += (c > 0u) ? 1u : 0u; mine = (j == x) ? c : mine; }
        if (sum == G) break;
        __builtin_amdgcn_s_sleep(1);
        if ((++sp & 255u) == 0u) { if (xb_ld(&bar[XB_TMO])) break; if (sp > XB_SPIN_CAP) { atomicAdd(&bar[XB_TMO], 1u); break; } }
    }
    nloc = mine > 0u ? mine : 1u; nx = cnt > 0u ? cnt : 1u;
}

__device__ __forceinline__ void xcd_barrier(const XcdBarrier& b) {
    asm volatile("s_waitcnt vmcnt(0)" ::: "memory");
    __syncthreads();
    if (threadIdx.x == 0) {
        unsigned* bar = b.bar;
        __builtin_amdgcn_s_waitcnt(0);
        unsigned nloc = b.st[0], nx = b.st[1];
        if (nloc == 0u) { xcd_barrier_complete(bar, b.x, nloc, nx); b.st[0] = nloc; b.st[1] = nx; }
        const unsigned old = xb_add(&bar[XB_XSUB(b.x)], 1u);
        const unsigned gen = old / nloc;
        if (old + 1u == (gen + 1u) * nloc) {
            __builtin_amdgcn_fence(__ATOMIC_RELEASE, "agent");
            asm volatile("s_waitcnt vmcnt(0)" ::: "memory");
            const unsigned og = xb_add(&bar[XB_TOP], 1u);
            const unsigned tg = og / nx;
            if (og + 1u == (tg + 1u) * nx) xb_add(&bar[XB_TOPGEN], 1u);
            else XB_SPIN(xb_ld(&bar[XB_TOPGEN]) == tg, bar);
            __builtin_amdgcn_fence(__ATOMIC_ACQUIRE, "agent");
            xb_add(&bar[XB_XGEN(b.x)], 1u);
            asm volatile("s_waitcnt vmcnt(0)" ::: "memory");
        } else {
            XB_SPIN(xb_ld(&bar[XB_XGEN(b.x)]) == gen, bar);
            __builtin_amdgcn_fence(__ATOMIC_ACQUIRE, "agent");
            asm volatile("s_waitcnt vmcnt(0)" ::: "memory");
        }
    }
    __syncthreads();
}

typedef unsigned u32x2v __attribute__((ext_vector_type(2)));
typedef float f32x2v __attribute__((ext_vector_type(2)));
__device__ __forceinline__ float bf2f(unsigned short b) { return __uint_as_float(((unsigned)b) << 16); }
__device__ __forceinline__ float bflo(unsigned u) { return __uint_as_float(u << 16); }
__device__ __forceinline__ float bfhi(unsigned u) { return __uint_as_float(u & 0xffff0000u); }
__device__ __forceinline__ float silu_f(float x) { return x / (1.0f + __expf(-x)); }
__device__ __forceinline__ float silu_fast(float x) { return x * __builtin_amdgcn_rcpf(1.0f + __builtin_amdgcn_exp2f(-1.4426950408889634f * x)); }
__device__ __forceinline__ float sigmoid_f(float x) { return 1.0f / (1.0f + __expf(-x)); }
__device__ __forceinline__ float softplus_f(float x) { return fmaxf(x, 0.f) + log1pf(__expf(-fabsf(x))); }
__device__ __forceinline__ float wave_sum(float v) {
#pragma unroll
    for (int o = 1; o < 64; o <<= 1) v += __shfl_xor(v, o);
    return v;
}

struct Args { const void* in[N_IN]; float* out; unsigned char* ws; int ph_lo, ph_hi; };

__device__ __forceinline__ unsigned cvtpk0(float lo, float hi) { return pg8::cvt_pk_bf16(lo, hi); }
struct P0Desc { const float* W; bf16* WT; const float* scale; int K, N, Npad, kxor, sk0, item; };
__device__ __forceinline__ void p0_load(const P0Desc& d, float (&v)[32], int lane) {
    const int nblk = d.Npad / 32, kb = d.item / nblk, nb = d.item % nblk, k0 = 64 * kb, n = 32 * nb + (lane & 31);
#pragma unroll
    for (int i = 0; i < 32; ++i) {
        const int k = k0 + 2 * i + (lane >> 5);
        v[i] = (n < d.N) ? d.W[(size_t)k * d.N + n] : 0.f;
    }
}
__device__ __forceinline__ void p0_store(const P0Desc& d, const float (&v)[32], LAS float* scr, int lane) {
    const int nblk = d.Npad / 32, kb = d.item / nblk, nb = d.item % nblk, k0 = 64 * kb, n0 = 32 * nb;
#pragma unroll
    for (int i = 0; i < 32; ++i) scr[(2 * i + (lane >> 5)) * 33 + (lane & 31)] = v[i];
    LDS_WAIT(); asm volatile("" ::: "memory");
    const int c = lane & 7;
    f32x4 g0 = (f32x4){1.f, 1.f, 1.f, 1.f}, g1 = g0;
    if (d.scale && k0 + 8 * c >= d.sk0) { g0 = *(const f32x4*)(d.scale + (k0 + 8 * c - d.sk0)); g1 = *(const f32x4*)(d.scale + (k0 + 8 * c - d.sk0) + 4); }
#pragma unroll
    for (int j = 0; j < 4; ++j) {
        const int nn = (lane >> 3) + 8 * j; const LAS float* s = scr + (8 * c) * 33 + nn;
        v4u o; o.x = cvtpk0(s[0 * 33] * g0.x, s[1 * 33] * g0.y); o.y = cvtpk0(s[2 * 33] * g0.z, s[3 * 33] * g0.w); o.z = cvtpk0(s[4 * 33] * g1.x, s[5 * 33] * g1.y); o.w = cvtpk0(s[6 * 33] * g1.z, s[7 * 33] * g1.w);
        *(GAS v4u*)(d.WT + (size_t)(n0 + nn) * d.K + ((k0 + 8 * c) ^ d.kxor)) = o;
    }
    LDS_WAIT(); asm volatile("" ::: "memory");
}

typedef short v4i16_t __attribute__((ext_vector_type(4)));
struct P0W { const float* W; bf16* WT; const float* scale; int K, N, kxor, sk0, kb32, nb, late; };
constexpr int P0W_STR = 320;
__device__ __forceinline__ void p0w_load(const P0W& d, f32x4 (&v)[16], float& sv, int lane) {
    const int k0 = 32 * d.kb32; const size_t col = (size_t)128 * d.nb + 4 * (lane & 31);
    sv = 1.0f;
    if (d.scale) { const int k = k0 + (lane & 31); if (k >= d.sk0) sv = d.scale[k - d.sk0]; }
#pragma unroll
    for (int i = 0; i < 16; ++i) v[i] = __builtin_nontemporal_load((const f32x4*)(d.W + (size_t)(k0 + 2 * i + (lane >> 5)) * d.N + col));
}
__device__ __forceinline__ void p0w_store(const P0W& d, const f32x4 (&v)[16], float sv, unsigned char* scr, int lane) {
    const int par = lane >> 5;
#pragma unroll
    for (int i = 0; i < 16; ++i) {
        const float se = __int_as_float(__builtin_amdgcn_readlane(__float_as_int(sv), 2 * i)), so = __int_as_float(__builtin_amdgcn_readlane(__float_as_int(sv), 2 * i + 1));
        const float sc = par ? so : se;
        u32x2v w; w.x = cvtpk0(v[i].x * sc, v[i].y * sc); w.y = cvtpk0(v[i].z * sc, v[i].w * sc);
        *(u32x2v*)(scr + (2 * i + par) * P0W_STR + (lane & 31) * 8) = w;
    }
    LDS_WAIT(); asm volatile("" ::: "memory");
    const int g = lane >> 4, q = (lane & 15) >> 2, pp = lane & 3;
    const LAS unsigned char* s3 = (const LAS unsigned char*)scr;
#pragma unroll
    for (int it = 0; it < 8; ++it) {
        const int kc = it & 3, colblk = (it >> 2) * 64 + g * 16;
        const LAS unsigned char* a = s3 + (8 * kc + q) * P0W_STR + (colblk + 4 * pp) * 2;
        const v4i16_t r0 = __builtin_amdgcn_ds_read_tr16_b64_v4i16((LAS v4i16_t*)a);
        const v4i16_t r1 = __builtin_amdgcn_ds_read_tr16_b64_v4i16((LAS v4i16_t*)(a + 4 * P0W_STR));
        const int n = 128 * d.nb + colblk + (lane & 15), kd = (32 * d.kb32 + 8 * kc) ^ d.kxor;
        typedef short s16x8 __attribute__((ext_vector_type(8)));
        const s16x8 ov = (s16x8){r0[0], r0[1], r0[2], r0[3], r1[0], r1[1], r1[2], r1[3]};
        if (d.late) __builtin_nontemporal_store(ov, (s16x8*)(d.WT + (size_t)n * d.K + kd)); else *(GAS s16x8*)(d.WT + (size_t)n * d.K + kd) = ov;
    }
    LDS_WAIT(); asm volatile("" ::: "memory");
}

constexpr int SK_LDA = 1024 + 8;
constexpr int SK_A_BYTES = 32 * SK_LDA * 2;
constexpr int SK_RED_OFF = 67584;
constexpr int SK_AUX_OFF = SK_RED_OFF + 8 * 4096;
template <class Builder, class Epi>
__device__ __forceinline__ void skinny_unit(unsigned char* lds, const bf16* Wt, int K, int u, int kc, const Builder& B, const Epi& E) {
    const int tid = threadIdx.x, lane = tid & 63, wid = tid >> 6, r32 = lane & 31, hi = lane >> 5;
    typedef float f32x16 __attribute__((ext_vector_type(16)));
    f32x16 acc;
#pragma unroll
    for (int i = 0; i < 16; ++i) acc[i] = 0.f;
    bf16* Al = (bf16*)lds;
    const bf16* wrow = Wt + (size_t)(u * 32 + r32) * K + kc + wid * 128 + hi * 8;
    bf16x8 bfr[8];
#pragma unroll
    for (int s = 0; s < 8; ++s) bfr[s] = *(const bf16x8*)(wrow + s * 16);
    __syncthreads();
    B(Al, (float*)(lds + SK_AUX_OFF), kc);
    __syncthreads();
#pragma unroll
    for (int s = 0; s < 8; ++s) {
        const bf16x8 afr = *(const bf16x8*)(Al + r32 * SK_LDA + wid * 128 + s * 16 + hi * 8);
        acc = __builtin_amdgcn_mfma_f32_32x32x16_bf16(afr, bfr[s], acc, 0, 0, 0);
    }
    float* red = (float*)(lds + SK_RED_OFF);
#pragma unroll
    for (int i = 0; i < 16; ++i) { const int row = (i & 3) + 8 * (i >> 2) + 4 * hi; red[wid * 1024 + row * 32 + r32] = acc[i]; }
    __syncthreads();
#pragma unroll
    for (int e = 0; e < 2; ++e) {
        const int idx = tid + e * 512; float s = 0.f;
#pragma unroll
        for (int w = 0; w < 8; ++w) s += red[w * 1024 + idx];
        E(idx >> 5, u * 32 + (idx & 31), s);
    }
    __syncthreads();
}
struct BuildNorm {
    const float* X;
    __device__ __forceinline__ void operator()(bf16* Al, float* aux, int kc) const {
        const int tid = threadIdx.x, row = tid >> 4, c16 = tid & 15;
        f32x4 v[16]; float s = 0.f;
#pragma unroll
        for (int j = 0; j < 16; ++j) { v[j] = *(const f32x4*)(X + (size_t)row * 1024 + j * 64 + c16 * 4); s += (v[j].x * v[j].x + v[j].y * v[j].y) + (v[j].z * v[j].z + v[j].w * v[j].w); }
        s += __shfl_xor(s, 1); s += __shfl_xor(s, 2); s += __shfl_xor(s, 4); s += __shfl_xor(s, 8);
        const float rs = 1.0f / sqrtf(s * (1.0f / 1024.0f) + RMS_EPS);
#pragma unroll
        for (int j = 0; j < 16; ++j) { u32x2v w; w.x = pk2(v[j].x * rs, v[j].y * rs); w.y = pk2(v[j].z * rs, v[j].w * rs); *(u32x2v*)(Al + row * SK_LDA + j * 64 + c16 * 4) = w; }
    }
};
struct BuildPlain {
    const float* X; int ldx;
    __device__ __forceinline__ void operator()(bf16* Al, float* aux, int kc) const {
        const int tid = threadIdx.x, row = tid >> 4, c16 = tid & 15;
#pragma unroll
        for (int j = 0; j < 16; ++j) { const f32x4 v = *(const f32x4*)(X + (size_t)row * ldx + kc + j * 64 + c16 * 4); u32x2v w; w.x = pk2(v.x, v.y); w.y = pk2(v.z, v.w); *(u32x2v*)(Al + row * SK_LDA + j * 64 + c16 * 4) = w; }
    }
};
struct BuildMixEven {
    const float* YG;
    const float* OPART;
    const float* LPART;
    __device__ __forceinline__ void operator()(bf16* Al, float* aux, int kc) const {
        const int tid = threadIdx.x, row = tid >> 4, c16 = tid & 15;
        {
            f32x4 v[8]; float s = 0.f;
#pragma unroll
            for (int j = 0; j < 8; ++j) { v[j] = *(const f32x4*)(YG + (size_t)row * 512 + j * 64 + c16 * 4); s += (v[j].x * v[j].x + v[j].y * v[j].y) + (v[j].z * v[j].z + v[j].w * v[j].w); }
            s += __shfl_xor(s, 1); s += __shfl_xor(s, 2); s += __shfl_xor(s, 4); s += __shfl_xor(s, 8);
            const float rs = 1.0f / sqrtf(s * (1.0f / 512.0f) + RMS_EPS);
#pragma unroll
            for (int j = 0; j < 8; ++j) { u32x2v w; w.x = pk2(v[j].x * rs, v[j].y * rs); w.y = pk2(v[j].z * rs, v[j].w * rs); *(u32x2v*)(Al + row * SK_LDA + j * 64 + c16 * 4) = w; }
        }
        {
#pragma unroll 1
            for (int j = 0; j < 8; ++j) {
                f32x4 x[NDP]; float lp[NDP];
#pragma unroll
                for (int p = 0; p < NDP; ++p) { x[p] = *(const f32x4*)(OPART + ((size_t)row * NDP + p) * 512 + j * 64 + c16 * 4); lp[p] = LPART[((size_t)row * NDP + p) * 8 + j]; }
                f32x4 o = (f32x4){0.f, 0.f, 0.f, 0.f}; float run = 0.f;
#pragma unroll
                for (int p = NDP - 1; p >= 0; --p) { o = o + x[p] * __expf(run); run += lp[p]; }
                u32x2v w; w.x = pk2(o.x, o.y); w.y = pk2(o.z, o.w); *(u32x2v*)(Al + row * SK_LDA + 512 + j * 64 + c16 * 4) = w;
            }
        }
    }
};
struct BuildMixOdd {
    const float* O;
    const float* IN2;
    __device__ __forceinline__ void operator()(bf16* Al, float* aux, int kc) const {
        const int tid = threadIdx.x, row = tid >> 4, c16 = tid & 15;
        f32x4 v[16]; float s = 0.f;
#pragma unroll
        for (int j = 0; j < 16; ++j) { v[j] = *(const f32x4*)(O + (size_t)row * 1024 + j * 64 + c16 * 4); s += (v[j].x * v[j].x + v[j].y * v[j].y) + (v[j].z * v[j].z + v[j].w * v[j].w); }
        s += __shfl_xor(s, 1); s += __shfl_xor(s, 2); s += __shfl_xor(s, 4); s += __shfl_xor(s, 8);
        const float rs = 1.0f / sqrtf(s * (1.0f / 1024.0f) + RMS_EPS);
#pragma unroll
        for (int j = 0; j < 16; ++j) {
            const f32x4 g = *(const f32x4*)(IN2 + (size_t)row * 4096 + 3072 + j * 64 + c16 * 4);
            u32x2v w; w.x = pk2(v[j].x * rs * silu_f(g.x), v[j].y * rs * silu_f(g.y)); w.y = pk2(v[j].z * rs * silu_f(g.z), v[j].w * rs * silu_f(g.w));
            *(u32x2v*)(Al + row * SK_LDA + j * 64 + c16 * 4) = w;
        }
    }
};
struct SEpiInEven { float* IN; float* kout; float* vout;
    __device__ __forceinline__ void operator()(int row, int col, float v) const {
        IN[(size_t)row * NES + col] = v;
        if (col >= 512 && col < 1024) kout[row * 512 + col - 512] = v;
        if (col >= 1024 && col < 1536) vout[row * 512 + col - 1024] = v;
    } };
struct SEpiStore { float* O; int ldo; __device__ __forceinline__ void operator()(int row, int col, float v) const { O[(size_t)row * ldo + col] = v; } };
struct SEpiRelu2 { float* O; int ldo; __device__ __forceinline__ void operator()(int row, int col, float v) const { const float r = fmaxf(v, 0.f); O[(size_t)row * ldo + col] = r * r; } };
struct SEpiAtomic { float* h; __device__ __forceinline__ void operator()(int row, int col, float v) const { atomicAdd(h + row * 1024 + col, v); } };
struct SEpiResid { const float* hold; float* hnew; __device__ __forceinline__ void operator()(int row, int col, float v) const { hnew[row * 1024 + col] = hold[row * 1024 + col] + v; } };

template <int CTRL> __device__ __forceinline__ float dppmov(float v) { return __int_as_float(__builtin_amdgcn_mov_dpp(__float_as_int(v), CTRL, 0xF, 0xF, true)); }
__device__ __forceinline__ float red16(float z) { z += dppmov<0xB1>(z); z += dppmov<0x4E>(z); z += dppmov<0x141>(z); z += dppmov<0x140>(z); return z; }
__device__ __forceinline__ void decode_unit(unsigned char* lds, const float* IN  , const float* ck, const float* cv, const int* ptab, const float* sb_bias,
                                            float* OPART, float* LPART, int seq, int part) {
    const int tid = threadIdx.x, lane = tid & 63, wid = tid >> 6;
    const int hsub = lane >> 4, dq = (lane & 15) * 4;
    f32x4 q0 = *(const f32x4*)(IN + (size_t)seq * NES + hsub * 64 + dq), q1 = *(const f32x4*)(IN + (size_t)seq * NES + (4 + hsub) * 64 + dq);
    q0 = q0 * 0.125f; q1 = q1 * 0.125f;
    const float b0 = sb_bias[hsub], b1 = sb_bias[4 + hsub];
    const int phys = ptab[seq * NPAGES + part * 8 + wid];
    const float* kp = ck + (size_t)phys * PAGE * 512 + lane * 4;
    const float* vp = cv + (size_t)phys * PAGE * 512 + lane * 4;
    f32x4 o0 = (f32x4){0.f, 0.f, 0.f, 0.f}, o1 = o0; float a0 = 0.f, a1 = 0.f;
    f32x4 K0[DRING], K1[DRING], V0[DRING], V1[DRING];
#define DEC_LOAD(s_, tk_) do { const float* kq_ = kp + (size_t)(tk_) * 512; const float* vq_ = vp + (size_t)(tk_) * 512; \
        K0[s_] = __builtin_nontemporal_load((const f32x4*)(kq_)); K1[s_] = __builtin_nontemporal_load((const f32x4*)(kq_ + 256)); \
        V0[s_] = __builtin_nontemporal_load((const f32x4*)(vq_)); V1[s_] = __builtin_nontemporal_load((const f32x4*)(vq_ + 256)); } while (0)
#define DEC_PROC(s_) do { \
        float z0 = (K0[s_].x * q0.x + K0[s_].y * q0.y) + (K0[s_].z * q0.z + K0[s_].w * q0.w); \
        float z1 = (K1[s_].x * q1.x + K1[s_].y * q1.y) + (K1[s_].z * q1.z + K1[s_].w * q1.w); \
        z0 = red16(z0) + b0; z1 = red16(z1) + b1; \
        const float sp0 = __logf(1.0f + __expf(-fabsf(z0))), sp1 = __logf(1.0f + __expf(-fabsf(z1))); \
        const float w0 = __expf(fminf(z0, 0.f) - sp0 + a0), w1 = __expf(fminf(z1, 0.f) - sp1 + a1); \
        a0 += -fmaxf(z0, 0.f) - sp0; a1 += -fmaxf(z1, 0.f) - sp1; \
        o0 = o0 + V0[s_] * w0; o1 = o1 + V1[s_] * w1; } while (0)
    static_assert(DRING == 6 && PAGE == 128, "ring schedule: 6 slots, 128-token pages: 21 full turns (tokens 127..2), then tokens 1 and 0 are left in slots 0 and 1");
#pragma unroll
    for (int j = 0; j < DRING; ++j) DEC_LOAD(j, PAGE - 1 - j);
#pragma unroll 3
    for (int tk = PAGE - 1; tk >= 2; tk -= DRING) {
#pragma unroll
        for (int sl = 0; sl < DRING; ++sl) { DEC_PROC(sl); __builtin_amdgcn_sched_barrier(0); const int tn = tk - sl - DRING; DEC_LOAD(sl, tn < 0 ? 0 : tn); __builtin_amdgcn_sched_barrier(0); }
    }
    DEC_PROC(0); DEC_PROC(1);
#undef DEC_PROC
#undef DEC_LOAD
    float* Ow = (float*)lds;
    float* Lw = (float*)(lds + 8 * 512 * 4);
    __syncthreads();
    *(f32x4*)(Ow + wid * 512 + hsub * 64 + dq) = o0; *(f32x4*)(Ow + wid * 512 + (4 + hsub) * 64 + dq) = o1;
    if ((lane & 15) == 0) { Lw[wid * 8 + hsub] = a0; Lw[wid * 8 + 4 + hsub] = a1; }
    __syncthreads();
    {
        const int head = tid >> 6; float run = 0.f, o = 0.f;
        for (int w = 7; w >= 0; --w) { o += __expf(run) * Ow[w * 512 + tid]; run += Lw[w * 8 + head]; }
        OPART[((size_t)seq * NDP + part) * 512 + tid] = o;
        if ((tid & 63) == 0) LPART[((size_t)seq * NDP + part) * 8 + head] = run;
    }
    __syncthreads();
}
__device__ __forceinline__ void ssd_sample_unit(unsigned char* lds, const float* IN, const float* sconv, const float* sssm, const float* convw, const float* convb, const float* dtb, const float* alog,
                                                const float* dskip, float* conv_out, float* ssm_out, float* YG, int seq, int h) {
    const int tid = threadIdx.x; const int g = h >> 2;
    float* xc = (float*)lds; float* Bc = xc + 64; float* Cc = Bc + 128;
    __syncthreads();
    if (tid < 320) {
        const int c = tid < 64 ? h * 64 + tid : (tid < 192 ? 512 + g * 128 + (tid - 64) : 768 + g * 128 + (tid - 192));
        const float s0 = sconv[((size_t)seq * 3 + 0) * 1024 + c], s1 = sconv[((size_t)seq * 3 + 1) * 1024 + c], s2 = sconv[((size_t)seq * 3 + 2) * 1024 + c], xn = IN[(size_t)seq * NES + 2048 + c];
        const float cv = convb[c] + convw[c] * s0 + convw[1024 + c] * s1 + convw[2048 + c] * s2 + convw[3072 + c] * xn;
        xc[tid] = silu_f(cv);
    } else if (tid >= 384) {
        const int c = h * 128 + (tid - 384);
        conv_out[((size_t)seq * 3 + 0) * 1024 + c] = sconv[((size_t)seq * 3 + 1) * 1024 + c];
        conv_out[((size_t)seq * 3 + 1) * 1024 + c] = sconv[((size_t)seq * 3 + 2) * 1024 + c];
        conv_out[((size_t)seq * 3 + 2) * 1024 + c] = IN[(size_t)seq * NES + 2048 + c];
    }
    __syncthreads();
    const float dt = softplus_f(IN[(size_t)seq * NES + 3072 + h] + dtb[h]); const float a = -__expf(alog[h]); const float dA = __expf(dt * a);
    const int p = tid >> 3, ng = tid & 7;
    const float dtx = dt * xc[p];
    const size_t so = (((size_t)seq * 8 + h) * 64 + p) * 128 + ng * 16;
    float y = 0.f;
#pragma unroll
    for (int j = 0; j < 4; ++j) {
        f32x4 s = __builtin_nontemporal_load((const f32x4*)(sssm + so + j * 4));
        const f32x4 b = *(const f32x4*)(Bc + ng * 16 + j * 4), c = *(const f32x4*)(Cc + ng * 16 + j * 4);
        s = s * dA + b * dtx;
        __builtin_nontemporal_store(s, (f32x4*)(ssm_out + so + j * 4));
        y += (s.x * c.x + s.y * c.y) + (s.z * c.z + s.w * c.w);
    }
    y += __shfl_xor(y, 1); y += __shfl_xor(y, 2); y += __shfl_xor(y, 4);
    if (ng == 0) { const float z = IN[(size_t)seq * NES + 1536 + h * 64 + p]; YG[(size_t)seq * 512 + h * 64 + p] = (y + dskip[h] * xc[p]) * silu_f(z); }
    __syncthreads();
}
typedef float f32x16 __attribute__((ext_vector_type(16)));
constexpr int AT_KSTR = 144, AT_VSTR = 192, AT_VOFF = 64 * AT_KSTR, AT_SLOT = AT_VOFF + 64 * AT_VSTR;
__device__ __forceinline__ unsigned cvtpk(float lo, float hi) { return pg8::cvt_pk_bf16(lo, hi); }
__device__ __forceinline__ void attn_unit_mfma(unsigned char* lds, const bf16* QKV, const float* sb_bias, bf16* MIX, int b, int h, int qb) {
    const int tid = threadIdx.x, lane = tid & 63, wid = __builtin_amdgcn_readfirstlane(tid >> 6), r32 = lane & 31, hi = lane >> 5;
    const int q0 = qb * 256, tw0 = q0 + wid * 32;
    const bf16* base = QKV + (size_t)b * T * NE;
    const LAS unsigned char* L3 = (const LAS unsigned char*)lds;
    bf16x8 qf[4];
#pragma unroll
    for (int ks = 0; ks < 4; ++ks) qf[ks] = *(const bf16x8*)(base + (size_t)(tw0 + r32) * NE + h * 64 + 16 * ks + 8 * hi);
    bf16x8 tri[2];
#pragma unroll
    for (int ks = 0; ks < 2; ++ks)
#pragma unroll
        for (int j = 0; j < 8; ++j) { const int kap = 16 * ks + 8 * (j >> 2) + 4 * hi + (j & 3); tri[ks][j] = (kap >= r32) ? (short)0x3F80 : (short)0; }
    const float bias2 = sb_bias[h] * LOG2E;
    f32x16 o0, o1, biasv;
#pragma unroll
    for (int i = 0; i < 16; ++i) { o0[i] = 0.f; o1[i] = 0.f; biasv[i] = bias2; }
    float runoff = 0.f;
    const int srow = tid >> 3, sch = tid & 7;
    const int itop = qb * 4 + 3;
    v4u kreg = *(const v4u*)(base + (size_t)(64 * itop + srow) * NE + 512 + h * 64 + sch * 8);
    v4u vreg = *(const v4u*)(base + (size_t)(64 * itop + srow) * NE + 1024 + h * 64 + sch * 8);
    __syncthreads();
    *(v4u*)(lds + srow * AT_KSTR + sch * 16) = kreg; *(v4u*)(lds + AT_VOFF + srow * AT_VSTR + sch * 16) = vreg;
    __syncthreads();
    const int trq = (lane & 15) >> 2, trp = lane & 3, trg = (lane >> 4) & 1;
    const int troff = (4 * hi + trq) * AT_VSTR + (16 * trg + 4 * trp) * 2;
    int sl = 0;
    for (int i = itop; i >= 0; --i, sl ^= 1) {
        if (i > 0) {
            kreg = *(const v4u*)(base + (size_t)(64 * (i - 1) + srow) * NE + 512 + h * 64 + sch * 8);
            vreg = *(const v4u*)(base + (size_t)(64 * (i - 1) + srow) * NE + 1024 + h * 64 + sch * 8);
        }
        const int sbase = sl * AT_SLOT;
        if (64 * i + 64 <= tw0) {
            bf16x8 kfa[4], kfb[4];
#pragma unroll
            for (int ks = 0; ks < 4; ++ks) { kfa[ks] = *(const LAS bf16x8*)(L3 + sbase + (32 + r32) * AT_KSTR + (16 * ks + 8 * hi) * 2); kfb[ks] = *(const LAS bf16x8*)(L3 + sbase + r32 * AT_KSTR + (16 * ks + 8 * hi) * 2); }
            f32x16 za = biasv, zb = biasv;
#pragma unroll
            for (int ks = 0; ks < 4; ++ks) { za = __builtin_amdgcn_mfma_f32_32x32x16_bf16(kfa[ks], qf[ks], za, 0, 0, 0); zb = __builtin_amdgcn_mfma_f32_32x32x16_bf16(kfb[ks], qf[ks], zb, 0, 0, 0); }
            const LAS unsigned char* vba = L3 + sbase + AT_VOFF + 32 * AT_VSTR + troff; const LAS unsigned char* vbb = L3 + sbase + AT_VOFF + troff;
            v4i16_t vra[2][2][2], vrb[2][2][2];
#pragma unroll
            for (int mb = 0; mb < 2; ++mb)
#pragma unroll
                for (int ks = 0; ks < 2; ++ks) {
                    vra[mb][ks][0] = __builtin_amdgcn_ds_read_tr16_b64_v4i16((LAS v4i16_t*)(vba + (16 * ks) * AT_VSTR + 64 * mb)); vra[mb][ks][1] = __builtin_amdgcn_ds_read_tr16_b64_v4i16((LAS v4i16_t*)(vba + (16 * ks + 8) * AT_VSTR + 64 * mb));
                    vrb[mb][ks][0] = __builtin_amdgcn_ds_read_tr16_b64_v4i16((LAS v4i16_t*)(vbb + (16 * ks) * AT_VSTR + 64 * mb)); vrb[mb][ks][1] = __builtin_amdgcn_ds_read_tr16_b64_v4i16((LAS v4i16_t*)(vbb + (16 * ks + 8) * AT_VSTR + 64 * mb));
                }
            u32x4 la0, la1, lb0, lb1;
            {
                float La[16], Lb[16];
#pragma unroll
                for (int r = 0; r < 16; ++r) { La[r] = -__builtin_amdgcn_logf(1.0f + __builtin_amdgcn_exp2f(fminf(za[r], 126.0f))); Lb[r] = -__builtin_amdgcn_logf(1.0f + __builtin_amdgcn_exp2f(fminf(zb[r], 126.0f))); }
                la0.x = cvtpk(La[0], La[1]); la0.y = cvtpk(La[2], La[3]); la0.z = cvtpk(La[4], La[5]); la0.w = cvtpk(La[6], La[7]);
                la1.x = cvtpk(La[8], La[9]); la1.y = cvtpk(La[10], La[11]); la1.z = cvtpk(La[12], La[13]); la1.w = cvtpk(La[14], La[15]);
                lb0.x = cvtpk(Lb[0], Lb[1]); lb0.y = cvtpk(Lb[2], Lb[3]); lb0.z = cvtpk(Lb[4], Lb[5]); lb0.w = cvtpk(Lb[6], Lb[7]);
                lb1.x = cvtpk(Lb[8], Lb[9]); lb1.y = cvtpk(Lb[10], Lb[11]); lb1.z = cvtpk(Lb[12], Lb[13]); lb1.w = cvtpk(Lb[14], Lb[15]);
            }
            const float za0 = za[0], zb0 = zb[0];
            f32x16 ya = __builtin_amdgcn_mfma_f32_32x32x16_bf16(tri[0], __builtin_bit_cast(bf16x8, la0), za, 0, 0, 0);
            f32x16 yb = __builtin_amdgcn_mfma_f32_32x32x16_bf16(tri[0], __builtin_bit_cast(bf16x8, lb0), zb, 0, 0, 0);
            ya = __builtin_amdgcn_mfma_f32_32x32x16_bf16(tri[1], __builtin_bit_cast(bf16x8, la1), ya, 0, 0, 0);
            yb = __builtin_amdgcn_mfma_f32_32x32x16_bf16(tri[1], __builtin_bit_cast(bf16x8, lb1), yb, 0, 0, 0);
            const float tota = __shfl(ya[0] - za0, r32), totb = __shfl(yb[0] - zb0, r32);
            const float roa = runoff, rob = runoff + tota;
            runoff = rob + totb;
            u32x4 wa0, wa1, wb0, wb1;
            {
                float Wa[16], Wb[16];
#pragma unroll
                for (int r = 0; r < 16; ++r) { Wa[r] = __builtin_amdgcn_exp2f(ya[r] + roa); Wb[r] = __builtin_amdgcn_exp2f(yb[r] + rob); }
                wa0.x = cvtpk(Wa[0], Wa[1]); wa0.y = cvtpk(Wa[2], Wa[3]); wa0.z = cvtpk(Wa[4], Wa[5]); wa0.w = cvtpk(Wa[6], Wa[7]);
                wa1.x = cvtpk(Wa[8], Wa[9]); wa1.y = cvtpk(Wa[10], Wa[11]); wa1.z = cvtpk(Wa[12], Wa[13]); wa1.w = cvtpk(Wa[14], Wa[15]);
                wb0.x = cvtpk(Wb[0], Wb[1]); wb0.y = cvtpk(Wb[2], Wb[3]); wb0.z = cvtpk(Wb[4], Wb[5]); wb0.w = cvtpk(Wb[6], Wb[7]);
                wb1.x = cvtpk(Wb[8], Wb[9]); wb1.y = cvtpk(Wb[10], Wb[11]); wb1.z = cvtpk(Wb[12], Wb[13]); wb1.w = cvtpk(Wb[14], Wb[15]);
            }
#define AT_VF(V_, mb_, ks_) ((bf16x8){V_[mb_][ks_][0][0], V_[mb_][ks_][0][1], V_[mb_][ks_][0][2], V_[mb_][ks_][0][3], V_[mb_][ks_][1][0], V_[mb_][ks_][1][1], V_[mb_][ks_][1][2], V_[mb_][ks_][1][3]})
            o0 = __builtin_amdgcn_mfma_f32_32x32x16_bf16(AT_VF(vra, 0, 0), __builtin_bit_cast(bf16x8, wa0), o0, 0, 0, 0);
            o1 = __builtin_amdgcn_mfma_f32_32x32x16_bf16(AT_VF(vra, 1, 0), __builtin_bit_cast(bf16x8, wa0), o1, 0, 0, 0);
            o0 = __builtin_amdgcn_mfma_f32_32x32x16_bf16(AT_VF(vra, 0, 1), __builtin_bit_cast(bf16x8, wa1), o0, 0, 0, 0);
            o1 = __builtin_amdgcn_mfma_f32_32x32x16_bf16(AT_VF(vra, 1, 1), __builtin_bit_cast(bf16x8, wa1), o1, 0, 0, 0);
            o0 = __builtin_amdgcn_mfma_f32_32x32x16_bf16(AT_VF(vrb, 0, 0), __builtin_bit_cast(bf16x8, wb0), o0, 0, 0, 0);
            o1 = __builtin_amdgcn_mfma_f32_32x32x16_bf16(AT_VF(vrb, 1, 0), __builtin_bit_cast(bf16x8, wb0), o1, 0, 0, 0);
            o0 = __builtin_amdgcn_mfma_f32_32x32x16_bf16(AT_VF(vrb, 0, 1), __builtin_bit_cast(bf16x8, wb1), o0, 0, 0, 0);
            o1 = __builtin_amdgcn_mfma_f32_32x32x16_bf16(AT_VF(vrb, 1, 1), __builtin_bit_cast(bf16x8, wb1), o1, 0, 0, 0);
#undef AT_VF
        } else
#pragma unroll
        for (int sub = 1; sub >= 0; --sub) {
            const int kb = 64 * i + 32 * sub;
            if (kb <= tw0) {
                const bool diag = (kb == tw0);
                bf16x8 kf[4];
#pragma unroll
                for (int ks = 0; ks < 4; ++ks) kf[ks] = *(const LAS bf16x8*)(L3 + sbase + (sub * 32 + r32) * AT_KSTR + (16 * ks + 8 * hi) * 2);
                const LAS unsigned char* vb = L3 + sbase + AT_VOFF + sub * 32 * AT_VSTR + troff;
                v4i16_t vr[2][2][2];
#pragma unroll
                for (int mb = 0; mb < 2; ++mb)
#pragma unroll
                    for (int ks = 0; ks < 2; ++ks) {
                        vr[mb][ks][0] = __builtin_amdgcn_ds_read_tr16_b64_v4i16((LAS v4i16_t*)(vb + (16 * ks) * AT_VSTR + 64 * mb));
                        vr[mb][ks][1] = __builtin_amdgcn_ds_read_tr16_b64_v4i16((LAS v4i16_t*)(vb + (16 * ks + 8) * AT_VSTR + 64 * mb));
                    }
                asm volatile("" ::: "memory"); __builtin_amdgcn_sched_barrier(0);
                f32x16 z = biasv;
#pragma unroll
                for (int ks = 0; ks < 4; ++ks) z = __builtin_amdgcn_mfma_f32_32x32x16_bf16(kf[ks], qf[ks], z, 0, 0, 0);
                float Lv[16];
#pragma unroll
                for (int r = 0; r < 16; ++r) {
                    const float p2 = __builtin_amdgcn_exp2f(fminf(z[r], 126.0f));
                    float L = -__builtin_amdgcn_logf(1.0f + p2);
                    if (diag) { const int krow = (r & 3) + 8 * (r >> 2) + 4 * hi; if (!(krow < r32)) L = 0.f; }
                    Lv[r] = L;
                }
                u32x4 lp0, lp1;
                lp0.x = cvtpk(Lv[0], Lv[1]); lp0.y = cvtpk(Lv[2], Lv[3]); lp0.z = cvtpk(Lv[4], Lv[5]); lp0.w = cvtpk(Lv[6], Lv[7]);
                lp1.x = cvtpk(Lv[8], Lv[9]); lp1.y = cvtpk(Lv[10], Lv[11]); lp1.z = cvtpk(Lv[12], Lv[13]); lp1.w = cvtpk(Lv[14], Lv[15]);
                const float z0 = z[0];
                f32x16 y = __builtin_amdgcn_mfma_f32_32x32x16_bf16(tri[0], __builtin_bit_cast(bf16x8, lp0), z, 0, 0, 0);
                y = __builtin_amdgcn_mfma_f32_32x32x16_bf16(tri[1], __builtin_bit_cast(bf16x8, lp1), y, 0, 0, 0);
                const float tot = __shfl(y[0] - z0, r32);
                float Wv[16];
#pragma unroll
                for (int r = 0; r < 16; ++r) {
                    float w = __builtin_amdgcn_exp2f(y[r] + runoff);
                    if (diag) { const int krow = (r & 3) + 8 * (r >> 2) + 4 * hi; if (!(krow < r32)) w = 0.f; }
                    Wv[r] = w;
                }
                runoff += tot;
                u32x4 wp0, wp1;
                wp0.x = cvtpk(Wv[0], Wv[1]); wp0.y = cvtpk(Wv[2], Wv[3]); wp0.z = cvtpk(Wv[4], Wv[5]); wp0.w = cvtpk(Wv[6], Wv[7]);
                wp1.x = cvtpk(Wv[8], Wv[9]); wp1.y = cvtpk(Wv[10], Wv[11]); wp1.z = cvtpk(Wv[12], Wv[13]); wp1.w = cvtpk(Wv[14], Wv[15]);
                const bf16x8 wf0 = __builtin_bit_cast(bf16x8, wp0), wf1 = __builtin_bit_cast(bf16x8, wp1);
#pragma unroll
                for (int mb = 0; mb < 2; ++mb) {
#pragma unroll
                    for (int ks = 0; ks < 2; ++ks) {
                        const v4i16_t a0 = vr[mb][ks][0];
                        const v4i16_t a1 = vr[mb][ks][1];
                        const bf16x8 vf = (bf16x8){a0[0], a0[1], a0[2], a0[3], a1[0], a1[1], a1[2], a1[3]};
                        if (mb == 0) o0 = __builtin_amdgcn_mfma_f32_32x32x16_bf16(vf, ks == 0 ? wf0 : wf1, o0, 0, 0, 0);
                        else o1 = __builtin_amdgcn_mfma_f32_32x32x16_bf16(vf, ks == 0 ? wf0 : wf1, o1, 0, 0, 0);
                    }
                }
            }
        }
        if (i > 0) { *(v4u*)(lds + (sl ^ 1) * AT_SLOT + srow * AT_KSTR + sch * 16) = kreg; *(v4u*)(lds + (sl ^ 1) * AT_SLOT + AT_VOFF + srow * AT_VSTR + sch * 16) = vreg; }
        __syncthreads();
    }
    bf16* orow = MIX + ((size_t)b * T + tw0 + r32) * 1024 + 512 + h * 64;
#pragma unroll
    for (int g4 = 0; g4 < 4; ++g4) {
        u32x2v w0; w0.x = cvtpk(o0[4 * g4], o0[4 * g4 + 1]); w0.y = cvtpk(o0[4 * g4 + 2], o0[4 * g4 + 3]);
        u32x2v w1; w1.x = cvtpk(o1[4 * g4], o1[4 * g4 + 1]); w1.y = cvtpk(o1[4 * g4 + 2], o1[4 * g4 + 3]);
        *(u32x2v*)(orow + 8 * g4 + 4 * hi) = w0; *(u32x2v*)(orow + 32 + 8 * g4 + 4 * hi) = w1;
    }
}

__device__ __forceinline__ int off128(int row, int ch) { return 256 * row + 16 * (ch ^ (((row & 3) << 2) | ((row >> 2) & 3))); }
__device__ __forceinline__ bf16x8 ldsrow128(const LAS unsigned char* tile, int row, int ch) { return *(const LAS bf16x8*)(tile + off128(row, ch)); }
__device__ __forceinline__ bf16x8 trfrag128(const LAS unsigned char* tile, int r0a, int r0b, int colbase, int lane) {
    const int q = (lane & 15) >> 2, p = lane & 3, c0 = (colbase >> 3) + 2 * ((lane >> 4) & 1) + (p >> 1), hb = 8 * (p & 1);
    const v4i16_t a0 = __builtin_amdgcn_ds_read_tr16_b64_v4i16((LAS v4i16_t*)(tile + off128(r0a + q, c0) + hb));
    const v4i16_t a1 = __builtin_amdgcn_ds_read_tr16_b64_v4i16((LAS v4i16_t*)(tile + off128(r0b + q, c0) + hb));
    return (bf16x8){a0[0], a0[1], a0[2], a0[3], a1[0], a1[1], a1[2], a1[3]};
}
constexpr int X64_STR = 192;
__device__ __forceinline__ bf16x8 trfrag64(const LAS unsigned char* tile, int r0a, int r0b, int colbase, int lane) {
    const int q = (lane & 15) >> 2, p = lane & 3, cb = (colbase + 16 * ((lane >> 4) & 1) + 4 * p) * 2;
    const v4i16_t a0 = __builtin_amdgcn_ds_read_tr16_b64_v4i16((LAS v4i16_t*)(tile + (r0a + q) * X64_STR + cb));
    const v4i16_t a1 = __builtin_amdgcn_ds_read_tr16_b64_v4i16((LAS v4i16_t*)(tile + (r0b + q) * X64_STR + cb));
    return (bf16x8){a0[0], a0[1], a0[2], a0[3], a1[0], a1[1], a1[2], a1[3]};
}
__device__ __forceinline__ int krow16(int r, int hi) { return (r & 3) + 8 * (r >> 2) + 4 * hi; }

__device__ __forceinline__ void conv_prepass(const bf16* QKV, const float* convw, const float* convb, bf16* XC, int bid) {
    const int tid = threadIdx.x, c0 = 2 * tid;
    float w0[4], w1[4];
#pragma unroll
    for (int j = 0; j < 4; ++j) { w0[j] = convw[j * 1024 + c0]; w1[j] = convw[j * 1024 + c0 + 1]; }
    const float b0 = convb[c0], b1 = convb[c0 + 1];
    const int t0 = (bid & 31) * 64; const size_t rowb = (size_t)(bid >> 5) * T;
    const unsigned* src = (const unsigned*)(QKV + (rowb + t0) * NE + 2048 + c0);
    unsigned* dst = (unsigned*)(XC + (rowb + t0) * 1024 + c0);
    float xa[3], xb[3];
#pragma unroll
    for (int j = 0; j < 3; ++j) { unsigned u = 0u; if (t0 > 0) u = src[(long)(j - 3) * (NE / 2)]; xa[j] = bflo(u); xb[j] = bfhi(u); }
    for (int i0 = 0; i0 < 64; i0 += 16) {
        unsigned u[16];
#pragma unroll
        for (int i = 0; i < 16; ++i) u[i] = __builtin_nontemporal_load(src + (long)(i0 + i) * (NE / 2));
#pragma unroll
        for (int i = 0; i < 16; ++i) {
            const float a = bflo(u[i]), b = bfhi(u[i]);
            const float ca = b0 + w0[0] * xa[0] + w0[1] * xa[1] + w0[2] * xa[2] + w0[3] * a;
            const float cb = b1 + w1[0] * xb[0] + w1[1] * xb[1] + w1[2] * xb[2] + w1[3] * b;
            dst[(long)(i0 + i) * 512] = cvtpk(silu_fast(ca), silu_fast(cb));
            xa[0] = xa[1]; xa[1] = xa[2]; xa[2] = a; xb[0] = xb[1]; xb[1] = xb[2]; xb[2] = b;
        }
    }
}

template <int STR> __device__ __forceinline__ bf16x8 trfragS(const LAS unsigned char* tile, int r0a, int r0b, int colbase, int lane) {
    const int q = (lane & 15) >> 2, p = lane & 3, cb = (colbase + 16 * ((lane >> 4) & 1) + 4 * p) * 2;
    const v4i16_t a0 = __builtin_amdgcn_ds_read_tr16_b64_v4i16((LAS v4i16_t*)(tile + (r0a + q) * STR + cb));
    const v4i16_t a1 = __builtin_amdgcn_ds_read_tr16_b64_v4i16((LAS v4i16_t*)(tile + (r0b + q) * STR + cb));
    return (bf16x8){a0[0], a0[1], a0[2], a0[3], a1[0], a1[1], a1[2], a1[3]};
}
constexpr int SL_STR = 80;
constexpr int S2_XS = 0, S2_XW = S2_XS + 64 * SL_STR, S2_ZS = S2_XW + 64 * SL_STR, S2_BC = S2_ZS + 64 * SL_STR, S2_CC = S2_BC + 64 * 256, S2_BUF = S2_CC + 64 * 256;
constexpr int S2_HI = 2 * S2_BUF, S2_TAB = S2_HI + 2 * 32 * 256, S2_END = S2_TAB + 2 * 2048 * 4;
static_assert(S2_END <= 131072, "SSD LDS map");
__device__ __forceinline__ void ssd_unit2(unsigned char* lds, const bf16* XC, const bf16* QKV, const float* DTRAW, const float* dtb, const float* alog, const float* dskip,
                                          bf16* MIX, float* SSM, float* ssm_out, int b, int h, int pb) {
    const int tid = threadIdx.x, lane = tid & 63, wid = __builtin_amdgcn_readfirstlane(tid >> 6), r32 = lane & 31, hi = lane >> 5; const int g = h >> 2;
    const LAS unsigned char* L3 = (const LAS unsigned char*)lds;
    const float a2 = -__expf(alog[h]) * LOG2E, dtbias = dtb[h], dsk = dskip[h];
    const size_t rowb = (size_t)b * T;
    float* dtT = (float*)(lds + S2_TAB); float* cumT = dtT + 2048;
    f32x16 hacc;
#pragma unroll
    for (int i = 0; i < 16; ++i) hacc[i] = 0.f;
    const int srow = tid >> 3, sch = tid & 7;
    const int t2 = tid & 255, lrow = t2 >> 2, lch = t2 & 3; const bool ldx = tid < 256;
    __syncthreads();
    float dtr[4];
#pragma unroll
    for (int q = 0; q < 4; ++q) dtr[q] = DTRAW[(rowb + (wid + 8 * q) * 64 + lane) * 8 + h];
#pragma unroll
    for (int q = 0; q < 4; ++q) { const int cc = wid + 8 * q;
        const float dt = softplus_f(dtr[q] + dtbias); float cs = dt * a2;
#pragma unroll
        for (int o = 1; o < 64; o <<= 1) { const float t = __shfl_up(cs, o); if (lane >= o) cs += t; }
        dtT[cc * 64 + lane] = dt; cumT[cc * 64 + lane] = cs;
    }
    *(v4u*)(lds + S2_HI + tid * 16) = (v4u){0u, 0u, 0u, 0u};
    v4u rs_, rb0, rb1, rc0, rc1;
#define S2_LOAD(c_) do { const size_t rn_ = rowb + (size_t)(c_) * 64; \
        rs_ = ldx ? *(const v4u*)(XC + (rn_ + lrow) * 1024 + h * 64 + pb * 32 + lch * 8) : *(const v4u*)(QKV + (rn_ + lrow) * NE + 1536 + h * 64 + pb * 32 + lch * 8); \
        rb0 = *(const v4u*)(XC + (rn_ + srow) * 1024 + 512 + g * 128 + sch * 8); rb1 = *(const v4u*)(XC + (rn_ + srow) * 1024 + 512 + g * 128 + 64 + sch * 8); \
        rc0 = *(const v4u*)(XC + (rn_ + srow) * 1024 + 768 + g * 128 + sch * 8); rc1 = *(const v4u*)(XC + (rn_ + srow) * 1024 + 768 + g * 128 + 64 + sch * 8); } while (0)
#define S2_STORE(c_, buf_) do { unsigned char* B_ = lds + (buf_) * S2_BUF; \
        if (ldx) { const float wst = __builtin_amdgcn_exp2f(cumT[(c_) * 64 + 63] - cumT[(c_) * 64 + lrow]) * dtT[(c_) * 64 + lrow]; \
            *(v4u*)(B_ + S2_XS + lrow * SL_STR + lch * 16) = rs_; \
            v4u xw; xw.x = cvtpk(bflo(rs_.x) * wst, bfhi(rs_.x) * wst); xw.y = cvtpk(bflo(rs_.y) * wst, bfhi(rs_.y) * wst); xw.z = cvtpk(bflo(rs_.z) * wst, bfhi(rs_.z) * wst); xw.w = cvtpk(bflo(rs_.w) * wst, bfhi(rs_.w) * wst); \
            *(v4u*)(B_ + S2_XW + lrow * SL_STR + lch * 16) = xw; } \
        else *(v4u*)(B_ + S2_ZS + lrow * SL_STR + lch * 16) = rs_; \
        *(v4u*)(B_ + S2_BC + off128(srow, sch)) = rb0; *(v4u*)(B_ + S2_BC + off128(srow, 8 + sch)) = rb1; \
        *(v4u*)(B_ + S2_CC + off128(srow, sch)) = rc0; *(v4u*)(B_ + S2_CC + off128(srow, 8 + sch)) = rc1; } while (0)
    S2_LOAD(0);
    __syncthreads();
    S2_STORE(0, 0);
    __syncthreads();
    for (int c = 0; c < T / 64; ++c) {
        const int cur = c & 1; const size_t row0 = rowb + (size_t)c * 64;
        const LAS unsigned char* Bf = L3 + cur * S2_BUF;
        const LAS unsigned char* HIc = L3 + S2_HI + cur * 8192;
        if (c + 1 < T / 64) S2_LOAD(c + 1);
        if (wid < 2) {
            const int tbk = wid;
            bf16x8 cf[8], af[8];
#pragma unroll
            for (int ks = 0; ks < 8; ++ks) cf[ks] = ldsrow128(Bf + S2_CC, tbk * 32 + r32, 2 * ks + hi);
            const float cumt = cumT[c * 64 + tbk * 32 + r32];
            f32x16 y;
#pragma unroll
            for (int i = 0; i < 16; ++i) y[i] = 0.f;
#pragma unroll
            for (int ks = 0; ks < 8; ++ks) af[ks] = ldsrow128(HIc, r32, 2 * ks + hi);
            asm volatile("" ::: "memory"); __builtin_amdgcn_sched_barrier(0);
#pragma unroll
            for (int ks = 0; ks < 8; ++ks) y = __builtin_amdgcn_mfma_f32_32x32x16_bf16(af[ks], cf[ks], y, 0, 0, 0);
            { const float e = __builtin_amdgcn_exp2f(cumt);
#pragma unroll
              for (int i = 0; i < 16; ++i) y[i] *= e; }
#pragma unroll
            for (int sb = 0; sb < 2; ++sb) {
                if (sb <= tbk) {
                    f32x16 s;
#pragma unroll
                    for (int i = 0; i < 16; ++i) s[i] = 0.f;
#pragma unroll
                    for (int ks = 0; ks < 8; ++ks) af[ks] = ldsrow128(Bf + S2_BC, sb * 32 + r32, 2 * ks + hi);
                    const bf16x8 xt0 = trfragS<SL_STR>(Bf + S2_XS, sb * 32 + 4 * hi, sb * 32 + 8 + 4 * hi, 0, lane), xt1 = trfragS<SL_STR>(Bf + S2_XS, sb * 32 + 16 + 4 * hi, sb * 32 + 24 + 4 * hi, 0, lane);
                    asm volatile("" ::: "memory"); __builtin_amdgcn_sched_barrier(0);
#pragma unroll
                    for (int ks = 0; ks < 8; ++ks) s = __builtin_amdgcn_mfma_f32_32x32x16_bf16(af[ks], cf[ks], s, 0, 0, 0);
                    float pv[16];
#pragma unroll
                    for (int q4 = 0; q4 < 4; ++q4) {
                        const f32x4 cs = *(const f32x4*)(cumT + c * 64 + sb * 32 + 8 * q4 + 4 * hi), ds = *(const f32x4*)(dtT + c * 64 + sb * 32 + 8 * q4 + 4 * hi);
#pragma unroll
                        for (int e = 0; e < 4; ++e) {
                            const int r = 4 * q4 + e; const int kr = 8 * q4 + 4 * hi + e;
                            float v = s[r] * __builtin_amdgcn_exp2f(fminf(cumt - cs[e], 0.f)) * ds[e];
                            if (sb == tbk && kr > r32) v = 0.f;
                            pv[r] = v;
                        }
                    }
                    u32x4 p0, p1;
                    p0.x = cvtpk(pv[0], pv[1]); p0.y = cvtpk(pv[2], pv[3]); p0.z = cvtpk(pv[4], pv[5]); p0.w = cvtpk(pv[6], pv[7]);
                    p1.x = cvtpk(pv[8], pv[9]); p1.y = cvtpk(pv[10], pv[11]); p1.z = cvtpk(pv[12], pv[13]); p1.w = cvtpk(pv[14], pv[15]);
                    y = __builtin_amdgcn_mfma_f32_32x32x16_bf16(xt0, __builtin_bit_cast(bf16x8, p0), y, 0, 0, 0);
                    y = __builtin_amdgcn_mfma_f32_32x32x16_bf16(xt1, __builtin_bit_cast(bf16x8, p1), y, 0, 0, 0);
                }
            }
            const int tl = tbk * 32 + r32; const size_t row = row0 + tl; float sq = 0.f;
#pragma unroll
            for (int q4 = 0; q4 < 4; ++q4) {
                const int p0 = 8 * q4 + 4 * hi;
                const u32x2v xr = *(const LAS u32x2v*)(Bf + S2_XS + tl * SL_STR + p0 * 2);
                const u32x2v zr = *(const LAS u32x2v*)(Bf + S2_ZS + tl * SL_STR + p0 * 2);
                const float o0 = (y[4 * q4 + 0] + dsk * bflo(xr.x)) * silu_fast(bflo(zr.x)), o1 = (y[4 * q4 + 1] + dsk * bfhi(xr.x)) * silu_fast(bfhi(zr.x));
                const float o2 = (y[4 * q4 + 2] + dsk * bflo(xr.y)) * silu_fast(bflo(zr.y)), o3 = (y[4 * q4 + 3] + dsk * bfhi(xr.y)) * silu_fast(bfhi(zr.y));
                u32x2v w; w.x = cvtpk(o0, o1); w.y = cvtpk(o2, o3);
                *(u32x2v*)(MIX + row * 1024 + h * 64 + pb * 32 + p0) = w;
                sq += (o0 * o0 + o1 * o1) + (o2 * o2 + o3 * o3);
            }
            sq += __shfl_xor(sq, 32);
            if (hi == 0) SSM[row * 32 + h * 2 + pb] = sq;
        } else if (wid < 6) {
            const int nb = wid - 2;
            const float e = __builtin_amdgcn_exp2f(cumT[c * 64 + 63]);
#pragma unroll
            for (int i = 0; i < 16; ++i) hacc[i] *= e;
            bf16x8 xa[4], bb[4];
#pragma unroll
            for (int ks = 0; ks < 4; ++ks) { xa[ks] = trfragS<SL_STR>(Bf + S2_XW, 16 * ks + 8 * hi, 16 * ks + 8 * hi + 4, 0, lane); bb[ks] = trfrag128(Bf + S2_BC, 16 * ks + 8 * hi, 16 * ks + 8 * hi + 4, nb * 32, lane); }
            asm volatile("" ::: "memory"); __builtin_amdgcn_sched_barrier(0);
#pragma unroll
            for (int ks = 0; ks < 4; ++ks) hacc = __builtin_amdgcn_mfma_f32_32x32x16_bf16(xa[ks], bb[ks], hacc, 0, 0, 0);
            unsigned char* HIn = lds + S2_HI + (cur ^ 1) * 8192; const int n = nb * 32 + r32;
#pragma unroll
            for (int r = 0; r < 16; r += 2) { const unsigned pkv = cvtpk(hacc[r], hacc[r + 1]); const int p = krow16(r, hi);
                *(bf16*)(HIn + off128(p, n >> 3) + (n & 7) * 2) = (bf16)(pkv & 0xffffu); *(bf16*)(HIn + off128(p + 1, n >> 3) + (n & 7) * 2) = (bf16)(pkv >> 16); }
        }
        if (c + 1 < T / 64) S2_STORE(c + 1, cur ^ 1);
        __syncthreads();
    }
#undef S2_LOAD
#undef S2_STORE
    if (wid >= 2 && wid < 6) {
        const int n = (wid - 2) * 32 + r32;
#pragma unroll
        for (int r = 0; r < 16; ++r) { const int p = pb * 32 + krow16(r, hi); ssm_out[(((size_t)b * 8 + h) * 64 + p) * 128 + n] = hacc[r]; }
    }
    __syncthreads();
}

__device__ __forceinline__ void hgrn_prepass(const bf16* IN2, const float* lbraw, bf16* QP, bf16* KP, float* DL, int bid) {
    const int tid = threadIdx.x, c0 = 2 * tid;
    const float lb0 = sigmoid_f(lbraw[1024 + c0] - lbraw[c0]), lb1 = sigmoid_f(lbraw[1024 + c0 + 1] - lbraw[c0 + 1]);
    const size_t row0 = (size_t)bid * 64;
    const unsigned* qs = (const unsigned*)(IN2 + row0 * 4096 + c0); const unsigned* fs = (const unsigned*)(IN2 + row0 * 4096 + 1024 + c0);
    unsigned* qd = (unsigned*)(QP + row0 * 1024 + c0); unsigned* kd = (unsigned*)(KP + row0 * 1024 + c0);
    float r0 = 0.f, r1 = 0.f;
    for (int i0 = 0; i0 < 64; i0 += 16) {
        unsigned uq[16], uf[16];
#pragma unroll
        for (int i = 0; i < 16; ++i) { uq[i] = __builtin_nontemporal_load(qs + (long)(i0 + i) * 2048); uf[i] = __builtin_nontemporal_load(fs + (long)(i0 + i) * 2048); }
#pragma unroll
        for (int i = 0; i < 16; ++i) {
            const float f0 = lb0 + (1.0f - lb0) * sigmoid_f(bflo(uf[i])), f1 = lb1 + (1.0f - lb1) * sigmoid_f(bfhi(uf[i]));
            r0 += __builtin_amdgcn_logf(f0); r1 += __builtin_amdgcn_logf(f1);
            const float e0 = __builtin_amdgcn_exp2f(r0), e1 = __builtin_amdgcn_exp2f(r1);
            const float i0v = __builtin_amdgcn_exp2f(fminf(-r0, 120.f)), i1v = __builtin_amdgcn_exp2f(fminf(-r1, 120.f));
            qd[(long)(i0 + i) * 512] = pk2(bflo(uq[i]) * e0, bfhi(uq[i]) * e1);
            kd[(long)(i0 + i) * 512] = pk2((1.0f - f0) * i0v, (1.0f - f1) * i1v);
        }
    }
    *(f32x2v*)(DL + (size_t)bid * 1024 + c0) = (f32x2v){__builtin_amdgcn_exp2f(r0), __builtin_amdgcn_exp2f(r1)};
}
constexpr int H2_QP = 0, H2_KP = H2_QP + 64 * 256, H2_VS = H2_KP + 64 * 256, H2_GS = H2_VS + 64 * SL_STR, H2_DL = H2_GS + 64 * SL_STR, H2_BUF = H2_DL + 512;
constexpr int H2_ST = 2 * H2_BUF, H2_END = H2_ST + 2 * 32 * 256;
static_assert(H2_END <= 131072, "HGRN LDS map");
__device__ __forceinline__ void hgrn_body(unsigned char* lds, const LAS unsigned char* Bf, const LAS unsigned char* STc, int cur, size_t row0, int h, int vq, int wid, int lane, int r32, int hi,
                                          f32x16& sacc, bf16* MIX, float* SSM) {
        if (wid < 2) {
            const int tbk = wid;
            bf16x8 qf[8], af[4];
#pragma unroll
            for (int ks = 0; ks < 8; ++ks) qf[ks] = ldsrow128(Bf + H2_QP, tbk * 32 + r32, 2 * ks + hi);
            f32x16 o;
#pragma unroll
            for (int i = 0; i < 16; ++i) o[i] = 0.f;
#pragma unroll
            for (int kh = 0; kh < 2; ++kh) {
#pragma unroll
                for (int ks = 0; ks < 4; ++ks) af[ks] = ldsrow128(STc, r32, 2 * (4 * kh + ks) + hi);
                asm volatile("" ::: "memory"); __builtin_amdgcn_sched_barrier(0);
#pragma unroll
                for (int ks = 0; ks < 4; ++ks) o = __builtin_amdgcn_mfma_f32_32x32x16_bf16(af[ks], qf[4 * kh + ks], o, 0, 0, 0);
            }
#pragma unroll
            for (int sb = 0; sb < 2; ++sb) {
                if (sb <= tbk) {
                    f32x16 s;
#pragma unroll
                    for (int i = 0; i < 16; ++i) s[i] = 0.f;
#pragma unroll
                    for (int kh = 0; kh < 2; ++kh) {
#pragma unroll
                        for (int ks = 0; ks < 4; ++ks) af[ks] = ldsrow128(Bf + H2_KP, sb * 32 + r32, 2 * (4 * kh + ks) + hi);
                        asm volatile("" ::: "memory"); __builtin_amdgcn_sched_barrier(0);
#pragma unroll
                        for (int ks = 0; ks < 4; ++ks) s = __builtin_amdgcn_mfma_f32_32x32x16_bf16(af[ks], qf[4 * kh + ks], s, 0, 0, 0);
                    }
                    const bf16x8 vt0 = trfragS<SL_STR>(Bf + H2_VS, sb * 32 + 4 * hi, sb * 32 + 8 + 4 * hi, 0, lane), vt1 = trfragS<SL_STR>(Bf + H2_VS, sb * 32 + 16 + 4 * hi, sb * 32 + 24 + 4 * hi, 0, lane);
                    if (sb == tbk) {
#pragma unroll
                        for (int r = 0; r < 16; ++r) if (krow16(r, hi) > r32) s[r] = 0.f;
                    }
                    u32x4 p0, p1;
                    p0.x = cvtpk(s[0], s[1]); p0.y = cvtpk(s[2], s[3]); p0.z = cvtpk(s[4], s[5]); p0.w = cvtpk(s[6], s[7]);
                    p1.x = cvtpk(s[8], s[9]); p1.y = cvtpk(s[10], s[11]); p1.z = cvtpk(s[12], s[13]); p1.w = cvtpk(s[14], s[15]);
                    o = __builtin_amdgcn_mfma_f32_32x32x16_bf16(vt0, __builtin_bit_cast(bf16x8, p0), o, 0, 0, 0);
                    o = __builtin_amdgcn_mfma_f32_32x32x16_bf16(vt1, __builtin_bit_cast(bf16x8, p1), o, 0, 0, 0);
                }
            }
            const int tl = tbk * 32 + r32; const size_t row = row0 + tl; float sq = 0.f;
#pragma unroll
            for (int q4 = 0; q4 < 4; ++q4) {
                const int v0 = 8 * q4 + 4 * hi;
                const u32x2v gr = *(const LAS u32x2v*)(Bf + H2_GS + tl * SL_STR + v0 * 2);
                const float o0 = o[4 * q4], o1 = o[4 * q4 + 1], o2 = o[4 * q4 + 2], o3 = o[4 * q4 + 3];
                u32x2v w; w.x = cvtpk(o0 * silu_fast(bflo(gr.x)), o1 * silu_fast(bfhi(gr.x))); w.y = cvtpk(o2 * silu_fast(bflo(gr.y)), o3 * silu_fast(bfhi(gr.y)));
                *(u32x2v*)(MIX + row * 1024 + h * 128 + vq * 32 + v0) = w;
                sq += (o0 * o0 + o1 * o1) + (o2 * o2 + o3 * o3);
            }
            sq += __shfl_xor(sq, 32);
            if (hi == 0) SSM[row * 32 + h * 4 + vq] = sq;
        } else if (wid < 6) {
            const int kb = wid - 2;
            bf16x8 ka[4], vb4[4];
#pragma unroll
            for (int ks = 0; ks < 4; ++ks) { ka[ks] = trfrag128(Bf + H2_KP, 16 * ks + 8 * hi, 16 * ks + 8 * hi + 4, kb * 32, lane); vb4[ks] = trfragS<SL_STR>(Bf + H2_VS, 16 * ks + 8 * hi, 16 * ks + 8 * hi + 4, 0, lane); }
            asm volatile("" ::: "memory"); __builtin_amdgcn_sched_barrier(0);
#pragma unroll
            for (int ks = 0; ks < 4; ++ks) sacc = __builtin_amdgcn_mfma_f32_32x32x16_bf16(ka[ks], vb4[ks], sacc, 0, 0, 0);
            unsigned char* STn = lds + H2_ST + (cur ^ 1) * 8192;
#pragma unroll
            for (int q4 = 0; q4 < 4; ++q4) {
                const f32x4 d = *(const LAS f32x4*)(Bf + H2_DL + (kb * 32 + 8 * q4 + 4 * hi) * 4);
#pragma unroll
                for (int e = 0; e < 4; ++e) sacc[4 * q4 + e] *= d[e];
                u32x2v w; w.x = cvtpk(sacc[4 * q4], sacc[4 * q4 + 1]); w.y = cvtpk(sacc[4 * q4 + 2], sacc[4 * q4 + 3]);
                *(u32x2v*)(STn + off128(r32, 4 * kb + q4) + 8 * hi) = w;
            }
        }
}
__device__ __forceinline__ void hgrn_unit2(unsigned char* lds, const bf16* QP, const bf16* KP, const float* DL, const bf16* IN2, bf16* MIX, float* SSM, float* hg_out, int b, int h, int vq) {
    const int tid = threadIdx.x, lane = tid & 63, wid = __builtin_amdgcn_readfirstlane(tid >> 6), r32 = lane & 31, hi = lane >> 5;
    const LAS unsigned char* L3 = (const LAS unsigned char*)lds;
    const size_t rowb = (size_t)b * T;
    f32x16 sacc;
#pragma unroll
    for (int i = 0; i < 16; ++i) sacc[i] = 0.f;
    const bool loader = tid >= 256; const int u = tid & 255;
    const int qrow = u >> 4, qch = u & 15, vrow = u >> 2, vch = u & 3;
    __syncthreads();
    *(v4u*)(lds + H2_ST + tid * 16) = (v4u){0u, 0u, 0u, 0u};
    v4u rq[2][2], rk[2][2], rvg[2]; float rdl[2] = {0.f, 0.f};
    const int prow = tid >> 4, pch = tid & 15, t2 = tid & 255, srow = t2 >> 2, sch = t2 & 3; const int vgoff = (tid < 256 ? 2048 : 3072), vgdst = (tid < 256 ? H2_VS : H2_GS);
#define H2_LOAD(c_, s_) do { const size_t rn_ = rowb + (size_t)(c_) * 64; \
        _Pragma("unroll") for (int j = 0; j < 2; ++j) { rq[s_][j] = *(const v4u*)(QP + (rn_ + prow + 32 * j) * 1024 + h * 128 + pch * 8); rk[s_][j] = *(const v4u*)(KP + (rn_ + prow + 32 * j) * 1024 + h * 128 + pch * 8); } \
        rvg[s_] = *(const v4u*)(IN2 + (rn_ + srow) * 4096 + vgoff + h * 128 + vq * 32 + sch * 8); \
        if (tid < 128) rdl[s_] = DL[((size_t)b * 32 + (c_)) * 1024 + h * 128 + tid]; } while (0)
#define H2_STORE(buf_, s_) do { unsigned char* B_ = lds + (buf_) * H2_BUF; \
        _Pragma("unroll") for (int j = 0; j < 2; ++j) { *(v4u*)(B_ + H2_QP + off128(prow + 32 * j, pch)) = rq[s_][j]; *(v4u*)(B_ + H2_KP + off128(prow + 32 * j, pch)) = rk[s_][j]; } \
        *(v4u*)(B_ + vgdst + srow * SL_STR + sch * 16) = rvg[s_]; \
        if (tid < 128) *(float*)(B_ + H2_DL + tid * 4) = rdl[s_]; } while (0)
    H2_LOAD(0, 0);
    H2_STORE(0, 0);
    H2_LOAD(1, 1);
    __syncthreads();
    static_assert((T / 64) % 2 == 0, "two chunks per loop trip");
    for (int c = 0; c < T / 64; c += 2) {
        if (c + 2 < T / 64) H2_LOAD(c + 2, 0);
        hgrn_body(lds, L3, L3 + H2_ST, 0, rowb + (size_t)c * 64, h, vq, wid, lane, r32, hi, sacc, MIX, SSM);
        H2_STORE(1, 1);
        __syncthreads();
        if (c + 3 < T / 64) H2_LOAD(c + 3, 1);
        hgrn_body(lds, L3 + H2_BUF, L3 + H2_ST + 8192, 1, rowb + (size_t)(c + 1) * 64, h, vq, wid, lane, r32, hi, sacc, MIX, SSM);
        if (c + 2 < T / 64) H2_STORE(0, 0);
        __syncthreads();
    }
#undef H2_LOAD
#undef H2_STORE
    if (wid >= 2 && wid < 6) {
        const int kb = wid - 2;
#pragma unroll
        for (int r = 0; r < 16; ++r) { const int k = kb * 32 + krow16(r, hi); hg_out[(((size_t)b * 8 + h) * 128 + k) * 128 + vq * 32 + r32] = sacc[r]; }
    }
    __syncthreads();
}

__device__ __forceinline__ void hgrn_sample_unit(unsigned char* lds, const float* IN2  , const float* shg, const float* lbraw, float* hg_out, float* SO, int seq, int h) {
    const int tid = threadIdx.x;
    float* fT = (float*)lds; float* qT = fT + 128; float* red = qT + 128;
    __syncthreads();
    if (tid < 128) {
        const float lb = sigmoid_f(lbraw[1024 + h * 128 + tid] - lbraw[h * 128 + tid]);
        fT[tid] = lb + (1.0f - lb) * sigmoid_f(IN2[(size_t)seq * 4096 + 1024 + h * 128 + tid]);
        qT[tid] = IN2[(size_t)seq * 4096 + h * 128 + tid];
    }
    __syncthreads();
    const int v = tid & 127, kq = tid >> 7;
    const float vt = IN2[(size_t)seq * 4096 + 2048 + h * 128 + v]; float o = 0.f;
    for (int k0 = 0; k0 < 32; k0 += 16) {
        float sv[16];
#pragma unroll
        for (int kk = 0; kk < 16; ++kk) sv[kk] = __builtin_nontemporal_load(shg + (((size_t)seq * 8 + h) * 128 + kq * 32 + k0 + kk) * 128 + v);
#pragma unroll
        for (int kk = 0; kk < 16; ++kk) {
            const int k = kq * 32 + k0 + kk; const size_t off = (((size_t)seq * 8 + h) * 128 + k) * 128 + v;
            const float f = fT[k]; const float s = f * sv[kk] + (1.0f - f) * vt;
            __builtin_nontemporal_store(s, hg_out + off); o += s * qT[k];
        }
    }
    red[kq * 128 + v] = o;
    __syncthreads();
    if (tid < 128) SO[(size_t)seq * 1024 + h * 128 + tid] = (red[tid] + red[128 + tid]) + (red[256 + tid] + red[384 + tid]);
    __syncthreads();
}

__global__ void __launch_bounds__(NTHR, 2) mk_fwd(Args args) {
    extern __shared__ __attribute__((aligned(16))) unsigned char lds[];
    const int tid = threadIdx.x, lane = tid & 63, wave = __builtin_amdgcn_readfirstlane(tid >> 6);
    const int G = gridDim.x, bid = blockIdx.x;
    LAS unsigned char* ldsl = (LAS unsigned char*)lds;
    volatile LAS unsigned* MISC = (volatile LAS unsigned*)(ldsl + MISC_OFF);
    unsigned char* ws = args.ws;
    gu32* ctl = (gu32*)(ws + WS_CTL);
    for (int u = tid; u < (LDS_BYTES - RING_BYTES) / 4; u += NTHR) ((LAS unsigned*)(ldsl + RING_BYTES))[u] = 0u;
    __syncthreads();
    const int lo = args.ph_lo, hi = args.ph_hi;
    const bool multi = (hi - lo) > 1;
    XcdBarrier bar; bar.bar = (unsigned*)(ctl + CW_BAR); bar.x = 0; bar.st = nullptr;
    if (multi) bar = xcd_barrier_post((unsigned*)(ctl + CW_BAR), MISC + 8);
#ifndef REP_MASK
#define REP_MASK 0
#endif
#if defined(PROBE_A0)
#define PROBE_STAMP(k) do { if (bid == 0 && tid == 0) ((unsigned long long*)(ctl + CW_TS))[k] = __builtin_amdgcn_s_memrealtime(); } while (0)
#define PROBE_STAMP1(k) do { if (bid == 1 && tid == 0) ((unsigned long long*)(ctl + CW_TS))[k] = __builtin_amdgcn_s_memrealtime(); } while (0)
#else
#define PROBE_STAMP(k) do { } while (0)
#define PROBE_STAMP1(k) do { } while (0)
#endif
#define NREP(k) ((((REP_MASK) >> (k)) & 1) ? 2 : 1)
#ifdef ONLY_PH
#define IN(k) ((k) == ONLY_PH && lo <= (k) && (k) < hi)
#else
#define IN(k) (lo <= (k) && (k) < hi)
#endif
#define SEAM(k) do { if (IN(k) && IN((k) + 1)) xcd_barrier(bar); } while (0)
#define x_p ((const float*)args.in[I_XP])
#define x_s ((const float*)args.in[I_XS])
#define cache_k ((const float*)args.in[I_CK])
#define cache_v ((const float*)args.in[I_CV])
#define ptab ((const int*)args.in[I_PT])
#define s_conv ((const float*)args.in[I_SCONV])
#define s_ssm ((const float*)args.in[I_SSSM])
#define s_hg ((const float*)args.in[I_SHG])
#define n_mix ((const float*)args.in[I_NMIX])
#define n_ffn ((const float*)args.in[I_NFFN])
#define n_fin ((const float*)args.in[I_NFIN])
#define w_ine ((const float*)args.in[I_WINE])
#define sb_bias ((const float*)args.in[I_SBB])
#define conv_w ((const float*)args.in[I_CONVW])
#define conv_b ((const float*)args.in[I_CONVB])
#define dt_bias ((const float*)args.in[I_DTB])
#define a_log ((const float*)args.in[I_ALOG])
#define d_skip ((const float*)args.in[I_DSKIP])
#define ssd_norm ((const float*)args.in[I_SSDN])
#define w_oute ((const float*)args.in[I_WOUTE])
#define w_ino ((const float*)args.in[I_WINO])
#define lb_raw ((const float*)args.in[I_LBRAW])
#define hg_norm ((const float*)args.in[I_HGN])
#define w_outo ((const float*)args.in[I_WOUTO])
#define w_ff1 ((const float*)args.in[I_W1])
#define w_ff2 ((const float*)args.in[I_W2])
#define out (args.out)
#define WINE ((bf16*)(ws + WS_WINE))
#define WOUTE ((bf16*)(ws + WS_WOUTE))
#define WINO ((bf16*)(ws + WS_WINO))
#define WOUTO ((bf16*)(ws + WS_WOUTO))
#define W1T ((bf16*)(ws + WS_W1))
#define W2T ((bf16*)(ws + WS_W2))
#define HB ((bf16*)(ws + WS_HB))
#define H ((float*)(ws + WS_H))
#define SSQ ((float*)(ws + WS_SSQ))
#define DTRAW ((float*)(ws + WS_DTRAW))
#define SSM ((float*)(ws + WS_SSM))
#define MIX ((bf16*)(ws + WS_MIX))
#define QKV ((bf16*)(ws + WS_QKV))
#define HID ((bf16*)(ws + WS_HID))
#define S_H ((float*)(ws + WS_SMP + SM_H))
#define S_IN ((float*)(ws + WS_SMP + SM_IN))
#define S_HID ((float*)(ws + WS_SMP + SM_HID))
#define S_YG ((float*)(ws + WS_SMP + SM_YG))
#define S_OPART ((float*)(ws + WS_SMP + SM_OPART))
#define S_LPART ((float*)(ws + WS_SMP + SM_LPART))
#define S_O ((float*)(ws + WS_SMP + SM_O))

    LAS float* rstab = (LAS float*)(ldsl + RING_BYTES + 2048);
    LAS float* midtab = (LAS float*)(ldsl + RING_BYTES + 1024);
#define RSTAB_FILL(S_, SRC_, NP_, INV_) do {   \
        pg8::Unit u_[4]; bool has_[4]; _Pragma("unroll") for (int i_ = 0; i_ < 4; ++i_) has_[i_] = (S_).next(i_, u_[i_]); \
        if (tid < 256) { f32x4 pp_[4][NP_ / 4]; \
            _Pragma("unroll") for (int i_ = 0; i_ < 4; ++i_) if (has_[i_]) { _Pragma("unroll") for (int q_ = 0; q_ < NP_ / 4; ++q_) pp_[i_][q_] = ((const f32x4*)((SRC_) + (size_t)(u_[i_].pm * 256 + tid) * NP_))[q_]; } \
            _Pragma("unroll") for (int i_ = 0; i_ < 4; ++i_) if (has_[i_]) { float sm_ = 0.f; _Pragma("unroll") for (int q_ = 0; q_ < NP_ / 4; ++q_) sm_ += pg8::sum4(pp_[i_][q_]); \
                rstab[i_ * 256 + tid] = 1.0f / sqrtf(sm_ * (INV_) + RMS_EPS); } } \
        } while (0)
    PROBE_STAMP(0);
    if (IN(0)) for (int rep = 0; rep < NREP(0); ++rep) {
        LAS float* scr = (LAS float*)(ldsl + wave * 16384);
        const int gw = bid * NWAVES + wave, NGW = G * NWAVES;
        constexpr int I_INE = (D / 64) * (NES / 32), I_SQ = (D / 64) * (D / 32), I_4K = (D / 64) * (FF / 32), I_DN = (FF / 64) * (D / 32);
        constexpr int NITEMS = I_INE + I_SQ + I_4K + I_SQ + 2 * I_4K + 2 * I_DN;
        {
            constexpr int F_INE = 16 * 24, F_SQ = 16 * 8, F_4K = 16 * 32, F_DN = 64 * 8;
            constexpr int NHALF = 2 * (F_INE + F_SQ + F_4K + F_SQ + 2 * F_4K + 2 * F_DN);
#define P0W_DESC(idx_) ({ int r_ = (idx_) >> 1; const int hf_ = (idx_) & 1; P0W d_; int nbk_; \
            if (r_ < F_INE) { d_ = P0W{w_ine, WINE, n_mix, D, EVEN_IN, 0, 0, 0, 0}; nbk_ = 24; } \
            else if ((r_ -= F_INE) < F_SQ) { d_ = P0W{w_oute, WOUTE, ssd_norm, D, D, 512, 512, 0, 0}; nbk_ = 8; } \
            else if ((r_ -= F_SQ) < F_4K) { d_ = P0W{w_ino, WINO, n_mix + 1024, D, ODD_IN, 0, 0, 0, 0}; nbk_ = 32; } \
            else if ((r_ -= F_4K) < F_SQ) { d_ = P0W{w_outo, WOUTO, hg_norm, D, D, 0, 0, 0, 0}; nbk_ = 8; } \
            else if ((r_ -= F_SQ) < F_4K) { d_ = P0W{w_ff1, W1T, n_ffn, D, FF, 0, 0, 0, 0}; nbk_ = 32; } \
            else if ((r_ -= F_4K) < F_4K) { d_ = P0W{w_ff1 + (size_t)D * FF, W1T + (size_t)FF * D, n_ffn + 1024, D, FF, 0, 0, 0, 0}; nbk_ = 32; } \
            else if ((r_ -= F_4K) < F_DN) { d_ = P0W{w_ff2, W2T, nullptr, FF, D, 0, 0, 0, 0}; nbk_ = 8; } \
            else { r_ -= F_DN; d_ = P0W{w_ff2 + (size_t)FF * D, W2T + (size_t)D * FF, nullptr, FF, D, 0, 0, 0, 0}; nbk_ = 8; } \
            d_.kb32 = 2 * (r_ / nbk_) + hf_; d_.nb = r_ % nbk_; d_.late = 0; d_; })
            unsigned char* wscr = lds + wave * (32 * P0W_STR);
            f32x4 va[16], vb[16]; float sa = 1.f, sb = 1.f;
            int it = gw;
            P0W da = P0W_DESC(it < NHALF ? it : 0), db = da;
            if (it < NHALF) p0w_load(da, va, sa, lane);
            for (; it < NHALF; it += 2 * NGW) {
                const bool hb_ = it + NGW < NHALF;
                if (hb_) { db = P0W_DESC(it + NGW); p0w_load(db, vb, sb, lane); }
                p0w_store(da, va, sa, wscr, lane);
                const bool ha_ = it + 2 * NGW < NHALF;
                if (ha_) { da = P0W_DESC(it + 2 * NGW); p0w_load(da, va, sa, lane); }
                if (hb_) p0w_store(db, vb, sb, wscr, lane);
            }
#undef P0W_DESC
            if (bid < 2) { __syncthreads();     float vn_[32]; const P0Desc dn{w_ine, WINE, n_mix, D, EVEN_IN, NES, 0, 0, gw * (NES / 32) + 96}; p0_load(dn, vn_, lane); p0_store(dn, vn_, scr, lane); }
        }
        __syncthreads();
        float* wd = (float*)lds;
        for (int idx = tid; idx < 8192; idx += NTHR) { const int k = idx >> 3, c = idx & 7; wd[idx] = w_ine[(size_t)k * EVEN_IN + 3072 + c] * n_mix[k]; }
        __syncthreads();
        f32x4 vn[4];
        if (gw < M) {
#pragma unroll
            for (int j = 0; j < 4; ++j) vn[j] = __builtin_nontemporal_load((const f32x4*)(x_p + (size_t)gw * D) + lane + 64 * j);
        }
        for (int m = gw; m < M; m += NGW) {
            f32x4 v[4]; float s = 0.f; float d8[8];
#pragma unroll
            for (int c = 0; c < 8; ++c) d8[c] = 0.f;
#pragma unroll
            for (int j = 0; j < 4; ++j) v[j] = vn[j];
            if (m + NGW < M) {
#pragma unroll
                for (int j = 0; j < 4; ++j) vn[j] = __builtin_nontemporal_load((const f32x4*)(x_p + (size_t)(m + NGW) * D) + lane + 64 * j);
            }
#pragma unroll
            for (int j = 0; j < 4; ++j) s += (v[j].x * v[j].x + v[j].y * v[j].y) + (v[j].z * v[j].z + v[j].w * v[j].w);
#pragma unroll
            for (int j = 0; j < 4; ++j)
#pragma unroll
                for (int e = 0; e < 4; ++e) {
                    const int k = 256 * j + 4 * lane + e; const f32x4 w0 = *(const f32x4*)(wd + k * 8), w1 = *(const f32x4*)(wd + k * 8 + 4); const float xv = v[j][e];
                    d8[0] += xv * w0.x; d8[1] += xv * w0.y; d8[2] += xv * w0.z; d8[3] += xv * w0.w; d8[4] += xv * w1.x; d8[5] += xv * w1.y; d8[6] += xv * w1.z; d8[7] += xv * w1.w;
                }
            s = wave_sum(s);
#pragma unroll
            for (int c = 0; c < 8; ++c) d8[c] = wave_sum(d8[c]);
            const float rstd = 1.0f / sqrtf(s * (1.0f / D) + RMS_EPS);
            GAS unsigned long long* o8 = (GAS unsigned long long*)(HB + (size_t)m * D) + lane;
#pragma unroll
            for (int j = 0; j < 4; ++j) o8[64 * j] = (unsigned long long)pk2(v[j].x, v[j].y) | ((unsigned long long)pk2(v[j].z, v[j].w) << 32);
            if (lane < 4) *(f32x4*)(SSQ + (size_t)m * 16 + lane * 4) = (f32x4){lane == 0 ? s : 0.f, 0.f, 0.f, 0.f};
            if (lane < 2) *(f32x4*)(DTRAW + (size_t)m * 8 + lane * 4) = lane == 0 ? (f32x4){d8[0] * rstd, d8[1] * rstd, d8[2] * rstd, d8[3] * rstd} : (f32x4){d8[4] * rstd, d8[5] * rstd, d8[6] * rstd, d8[7] * rstd};
        }
        __syncthreads();
        if (rep + 1 < NREP(0)) xcd_barrier(bar);
    }
    SEAM(0);
    PROBE_STAMP(1);
    if (IN(1)) for (int rep = 0; rep < NREP(1); ++rep) {
        pg8::Gemm g{HB, WINE, M, NE, D}; pg8::StaticOrder S; S.init(M, NE, G, bid);
        auto pre = [&]() { RSTAB_FILL(S, SSQ, 16, 1.0f / 1024.0f); };
        typedef pg8::EpiBf16S<0, 1> Epi; Epi E{QKV, NE, rstab, out + O_KP, out + O_VP, out + O_CP};
        if (bid < NES / 32) skinny_unit(lds, WINE, D, bid, 0, BuildNorm{x_s}, SEpiInEven{S_IN, out + O_KS, out + O_VS});
        pg8::gemm_phase<Epi, pg8::StaticOrder, true, true>(ldsl, g, S, E, pre);
        if (rep + 1 < NREP(1)) xcd_barrier(bar);
    }
    SEAM(1);
    PROBE_STAMP(2);
    if (IN(2)) for (int rep = 0; rep < NREP(2); ++rep) {
        conv_prepass(QKV, conv_w, conv_b, HID  , bid);
        asm volatile("s_waitcnt vmcnt(0)" ::: "memory");
        __syncthreads();
        if (tid == 0) { __builtin_amdgcn_fence(__ATOMIC_RELEASE, "agent"); asm volatile("s_waitcnt vmcnt(0)" ::: "memory"); __hip_atomic_fetch_add(ctl + CW_CONV + 256 * rep, 1u, __ATOMIC_RELAXED, __HIP_MEMORY_SCOPE_AGENT); }
        ssd_sample_unit(lds, S_IN, s_conv, s_ssm, conv_w, conv_b, dt_bias, a_log, d_skip, out + O_CS, out + O_SS, S_YG, bid >> 3, bid & 7);
#define PULL(cw_) ({ __syncthreads(); if (tid == 0) MISC[16] = __hip_atomic_fetch_add(ctl + (cw_) + 256 * rep, 1u, __ATOMIC_RELAXED, __HIP_MEMORY_SCOPE_AGENT); __syncthreads(); (int)MISC[16]; })
#define RUN_DEC() for (int item; (item = PULL(CW_QDEC)) < MS * NDP; ) decode_unit(lds, S_IN, cache_k, cache_v, ptab, sb_bias, S_OPART, S_LPART, item / NDP, item % NDP)
        if ((bid & 1) == 0) RUN_DEC();
        if (rep + 1 < NREP(2)) xcd_barrier(bar);
    }
    PROBE_STAMP(3);
    if (IN(3)) for (int rep = 0; rep < NREP(3); ++rep) {
        PROBE_STAMP1(20);
        if (bid & 1) {
            const int o_ = bid >> 1, gid_ = (o_ & 3) * 4 + (o_ >> 5), mem_ = (o_ >> 2) & 7;
            const int item = ((gid_ >> 1) << 4) | (((gid_ & 1) * 4 + (mem_ >> 1)) << 1) | (mem_ & 1);
            if (tid == 0) { unsigned sp_ = 0; while (__hip_atomic_load(ctl + CW_CONV + 256 * rep, __ATOMIC_RELAXED, __HIP_MEMORY_SCOPE_AGENT) < (unsigned)G && ++sp_ < (1u << 22)) __builtin_amdgcn_s_sleep(2);
                            __builtin_amdgcn_fence(__ATOMIC_ACQUIRE, "agent"); asm volatile("s_waitcnt vmcnt(0)" ::: "memory"); }
            __syncthreads();
            ssd_unit2(lds, HID  , QKV, DTRAW, dt_bias, a_log, d_skip, MIX, SSM, out + O_SP, item >> 4, (item >> 1) & 7, item & 1);
        }
        PROBE_STAMP1(21);
        for (int item; (item = PULL(CW_QATT)) < 512; ) { const int bh = item & 63; attn_unit_mfma(lds, QKV, sb_bias, MIX, bh >> 3, bh & 7, 7 - (item >> 6)); }
        PROBE_STAMP1(22);
        RUN_DEC();
        PROBE_STAMP1(23);
        __syncthreads();
        if (rep + 1 < NREP(3)) xcd_barrier(bar);
    }
#undef RUN_DEC
#undef PULL
    SEAM(3);
    PROBE_STAMP(4);
    if (IN(4)) for (int rep = 0; rep < NREP(4); ++rep) {
        pg8::Gemm g{MIX, WOUTE, M, D, D}; pg8::StaticOrder S; S.init(M, D, G, bid);
        auto pre = [&]() {
            pg8::Unit u0; if (S.next(0, u0) && tid < 256) {
                const f32x4* p = (const f32x4*)(SSM + (size_t)(u0.pm * 256 + tid) * 32);
                const float sm = (pg8::sum4(p[0]) + pg8::sum4(p[1])) + (pg8::sum4(p[2]) + pg8::sum4(p[3]));
                midtab[tid] = 1.0f / sqrtf(sm * (1.0f / 512.0f) + RMS_EPS);
            }
        };
        typedef pg8::EpiResid<0, 8, false, 2> Epi; Epi E{nullptr, HB, SSQ, nullptr, midtab};
        pg8::gemm_phase<Epi, pg8::StaticOrder, true, true>(ldsl, g, S, E, pre);
        if (bid < D / 32) skinny_unit(lds, WOUTE, D, bid, 0, BuildMixEven{S_YG, S_OPART, S_LPART}, SEpiResid{x_s, S_H});
        if (rep + 1 < NREP(4)) xcd_barrier(bar);
    }
    SEAM(4);
    PROBE_STAMP(5);
    if (IN(5)) for (int rep = 0; rep < NREP(5); ++rep) {
        pg8::Gemm g{HB, W1T, M, FF, D}; pg8::StaticOrder S; S.init(M, FF, G, bid);
        auto pre = [&]() { RSTAB_FILL(S, SSQ, 16, 1.0f / 1024.0f); };
        typedef pg8::EpiBf16S<1, 0> Epi; Epi E{HID, FF, rstab, nullptr, nullptr, nullptr};
        if (bid < FF / 32) skinny_unit(lds, W1T, D, bid, 0, BuildNorm{S_H}, SEpiRelu2{S_HID, FF});
        pg8::gemm_phase<Epi, pg8::StaticOrder, true, true>(ldsl, g, S, E, pre);
        if (rep + 1 < NREP(5)) xcd_barrier(bar);
    }
    SEAM(5);
    PROBE_STAMP(6);
    if (IN(6)) for (int rep = 0; rep < NREP(6); ++rep) {
        pg8::Gemm g{HID, W2T, M, D, FF}; pg8::StaticOrder S; S.init(M, D, G, bid);
        typedef pg8::EpiResid<0, 0, false, 2> Epi; Epi E{nullptr, HB, SSQ, nullptr, nullptr};
        if (bid < 4 * (D / 32)) skinny_unit(lds, W2T, FF, bid & 31, (bid >> 5) * 1024, BuildPlain{S_HID, FF}, SEpiAtomic{S_H});
        pg8::gemm_phase<Epi, pg8::StaticOrder, true, true>(ldsl, g, S, E);
        if (rep + 1 < NREP(6)) xcd_barrier(bar);
    }
    SEAM(6);
    PROBE_STAMP(7);
    if (IN(7)) for (int rep = 0; rep < NREP(7); ++rep) {
        pg8::Gemm g{HB, WINO, M, ODD_IN, D}; pg8::StaticOrder S; S.init(M, ODD_IN, G, bid);
        auto pre = [&]() { RSTAB_FILL(S, SSQ, 16, 1.0f / 1024.0f); };
        typedef pg8::EpiBf16S<0, 0> Epi; Epi E{HID, ODD_IN, rstab, nullptr, nullptr, nullptr};
        if (bid < ODD_IN / 32) skinny_unit(lds, WINO, D, bid, 0, BuildNorm{S_H}, SEpiStore{S_IN, ODD_IN});
        pg8::gemm_phase<Epi, pg8::StaticOrder, true, true>(ldsl, g, S, E, pre);
        if (rep + 1 < NREP(7)) xcd_barrier(bar);
    }
    SEAM(7);
    PROBE_STAMP(8);
    if (IN(8)) for (int rep = 0; rep < NREP(8); ++rep) {
        hgrn_prepass(HID, lb_raw, QKV  , QKV + (size_t)M * 1024  , (float*)(QKV + (size_t)2 * M * 1024)  , bid);
        hgrn_sample_unit(lds, S_IN, s_hg, lb_raw, out + O_GS, S_O, bid >> 3, bid & 7);
        if (rep + 1 < NREP(8)) xcd_barrier(bar);
    }
    SEAM(8);
    PROBE_STAMP(9);
    if (IN(9)) for (int rep = 0; rep < NREP(9); ++rep) {
        {
            const int bh = (bid & 7) | ((bid >> 5) << 3), vq = (bid >> 3) & 3;
            hgrn_unit2(lds, QKV, QKV + (size_t)M * 1024, (const float*)(QKV + (size_t)2 * M * 1024), HID, MIX, SSM, out + O_GP, bh >> 3, bh & 7, vq);
        }
        if (rep + 1 < NREP(9)) xcd_barrier(bar);
    }
    SEAM(9);
    PROBE_STAMP(10);
    if (IN(10)) for (int rep = 0; rep < NREP(10); ++rep) {
        pg8::Gemm g{MIX, WOUTO, M, D, D}; pg8::StaticOrder S; S.init(M, D, G, bid);
        auto pre = [&]() { RSTAB_FILL(S, SSM, 32, 1.0f / 1024.0f); };
        typedef pg8::EpiResid<32, 0, false, 2> Epi; Epi E{nullptr, HB, SSQ, rstab, nullptr};
        pg8::gemm_phase<Epi, pg8::StaticOrder, true, true>(ldsl, g, S, E, pre);
        if (bid < D / 32) skinny_unit(lds, WOUTO, D, bid, 0, BuildMixOdd{S_O, S_IN}, SEpiResid{S_H, S_H});
        if (rep + 1 < NREP(10)) xcd_barrier(bar);
    }
    SEAM(10);
    PROBE_STAMP(11);
    if (IN(11)) for (int rep = 0; rep < NREP(11); ++rep) {
        pg8::Gemm g{HB, W1T + (size_t)FF * D, M, FF, D}; pg8::StaticOrder S; S.init(M, FF, G, bid);
        auto pre = [&]() { RSTAB_FILL(S, SSQ, 16, 1.0f / 1024.0f); };
        typedef pg8::EpiBf16S<1, 0> Epi; Epi E{HID, FF, rstab, nullptr, nullptr, nullptr};
        if (bid < FF / 32) skinny_unit(lds, W1T + (size_t)FF * D, D, bid, 0, BuildNorm{S_H}, SEpiRelu2{S_HID, FF});
        pg8::gemm_phase<Epi, pg8::StaticOrder, true, true>(ldsl, g, S, E, pre);
        if (rep + 1 < NREP(11)) xcd_barrier(bar);
    }
    SEAM(11);
    PROBE_STAMP(12);
    if (IN(12)) for (int rep = 0; rep < NREP(12); ++rep) {
        pg8::Gemm g{HID, W2T + (size_t)D * FF, M, D, FF}; pg8::StaticOrder S; S.init(M, D, G, bid);
        typedef pg8::EpiResid<0, 0, false, 2> Epi; Epi E{nullptr, HB, SSQ, nullptr, nullptr};
        if (bid < 4 * (D / 32)) skinny_unit(lds, W2T + (size_t)D * FF, FF, bid & 31, (bid >> 5) * 1024, BuildPlain{S_HID, FF}, SEpiAtomic{S_H});
        pg8::gemm_phase<Epi, pg8::StaticOrder, true, true>(ldsl, g, S, E);
        if (rep + 1 < NREP(12)) xcd_barrier(bar);
    }
    SEAM(12);
    PROBE_STAMP(13);
    if (IN(13)) for (int rep = 0; rep < NREP(13); ++rep) {
        const int gw = bid * NWAVES + wave, NGW = G * NWAVES;
        f32x4 wf[4];
#pragma unroll
        for (int j = 0; j < 4; ++j) wf[j] = *((const f32x4*)n_fin + lane + 64 * j);
        u32x2v vnx[4]; f32x4 spn[4];
        if (gw < M) {
#pragma unroll
            for (int j = 0; j < 4; ++j) { vnx[j] = __builtin_nontemporal_load((const u32x2v*)(HB + (size_t)gw * D) + lane + 64 * j); spn[j] = ((const f32x4*)(SSQ + (size_t)gw * 16))[j]; }
        }
        for (int m = gw; m < M; m += NGW) {
            u32x2v v[4]; f32x4 sp[4];
#pragma unroll
            for (int j = 0; j < 4; ++j) { v[j] = vnx[j]; sp[j] = spn[j]; }
            if (m + NGW < M) {
#pragma unroll
                for (int j = 0; j < 4; ++j) { vnx[j] = __builtin_nontemporal_load((const u32x2v*)(HB + (size_t)(m + NGW) * D) + lane + 64 * j); spn[j] = ((const f32x4*)(SSQ + (size_t)(m + NGW) * 16))[j]; }
            }
            const float ssum = (pg8::sum4(sp[0]) + pg8::sum4(sp[1])) + (pg8::sum4(sp[2]) + pg8::sum4(sp[3]));
            const float rstd = 1.0f / sqrtf(ssum * (1.0f / D) + RMS_EPS);
            float* dst = out + O_YP + (size_t)m * D;
#pragma unroll
            for (int j = 0; j < 4; ++j) { const f32x4 x = (f32x4){bflo(v[j].x), bfhi(v[j].x), bflo(v[j].y), bfhi(v[j].y)}; __builtin_nontemporal_store(x * rstd * wf[j], (f32x4*)dst + lane + 64 * j); }
        }
#if defined(PROBE_A0)
        float probe_eps = 0.f;
        {
            const unsigned long long* ts = (const unsigned long long*)(ctl + CW_TS);
            const float usB = (float)(long long)(ts[PROBE_B1] - ts[PROBE_B0]) * 0.01f, usA = (float)(long long)(ts[PROBE_A1] - ts[PROBE_A0]) * 0.01f;
            probe_eps = sqrtf(1e-6f * usB);
            if (bid == 0 && tid == 0) out[O_KS] += 0.01f * usA;
        }
#endif
        if (gw < MS) {
            const float* src = S_H + (size_t)gw * D; float* dst = out + O_YS + (size_t)gw * D;
            f32x4 v[4]; float sq = 0.f;
#pragma unroll
            for (int j = 0; j < 4; ++j) { v[j] = *((const f32x4*)src + lane + 64 * j); sq += (v[j].x * v[j].x + v[j].y * v[j].y) + (v[j].z * v[j].z + v[j].w * v[j].w); }
            sq = wave_sum(sq);
            const float rstd = 1.0f / sqrtf(sq * (1.0f / D) + RMS_EPS);
#pragma unroll
            for (int j = 0; j < 4; ++j) {
                f32x4 yv = v[j] * rstd * wf[j];
#if defined(PROBE_A0)
                yv = yv + probe_eps;
#endif
                *((f32x4*)dst + lane + 64 * j) = yv;
            }
        }
    }
#undef IN
#undef SEAM
#undef x_p
#undef x_s
#undef cache_k
#undef cache_v
#undef ptab
#undef s_conv
#undef s_ssm
#undef s_hg
#undef n_mix
#undef n_ffn
#undef n_fin
#undef w_ine
#undef sb_bias
#undef conv_w
#undef conv_b
#undef dt_bias
#undef a_log
#undef d_skip
#undef ssd_norm
#undef w_oute
#undef w_ino
#undef lb_raw
#undef hg_norm
#undef w_outo
#undef w_ff1
#undef w_ff2
#undef out
#undef WINE
#undef WOUTE
#undef WINO
#undef WOUTO
#undef W1T
#undef W2T
#undef HB
#undef H
#undef SSQ
#undef DTRAW
#undef SSM
#undef MIX
#undef QKV
#undef HID
#undef S_H
#undef S_IN
#undef S_HID
#undef S_YG
#undef S_OPART
#undef S_LPART
#undef S_O
}

constexpr int N_PHASES = 14;
#ifndef MK_SPLIT
#define MK_SPLIT 0
#endif
extern "C" void kernel_launch(void* const* d_in, const int* in_sizes, int n_in, void* d_out, int out_size, void* d_ws, size_t ws_size, hipStream_t stream) {
    static int grid = 0;
    if (grid == 0) {
        if (n_in != N_IN || (size_t)out_size != O_END || ws_size < WS_END) { fprintf(stderr, "kernel_launch: unexpected sizes n_in %d out %d ws %zu\n", n_in, out_size, ws_size); if (ws_size < WS_END) { grid = -1; return; } }
        int dev = 0, cus = 0, per_cu = 0;
        if (hipGetDevice(&dev) != hipSuccess || hipDeviceGetAttribute(&cus, hipDeviceAttributeMultiprocessorCount, dev) != hipSuccess) { grid = -1; return; }
        if (hipFuncSetAttribute((const void*)mk_fwd, hipFuncAttributeMaxDynamicSharedMemorySize, LDS_BYTES) != hipSuccess) { fprintf(stderr, "kernel_launch: hipFuncSetAttribute failed\n"); grid = -1; return; }
        if (hipOccupancyMaxActiveBlocksPerMultiprocessor(&per_cu, (const void*)mk_fwd, NTHR, LDS_BYTES) != hipSuccess || per_cu < 1) fprintf(stderr, "kernel_launch: occupancy query says %d\n", per_cu);
        (void)hipGetLastError();
        grid = cus;
        if (grid != 256) fprintf(stderr, "kernel_launch: %d CUs (built for 256)\n", grid);
    }
    if (grid < 0) return;
    (void)hipMemsetAsync((char*)d_ws + WS_CTL, 0, CTL_ZERO_BYTES, stream);
    Args a{};
    for (int i = 0; i < N_IN; ++i) a.in[i] = d_in[i];
    a.out = (float*)d_out; a.ws = (unsigned char*)d_ws;
#if MK_SPLIT
    for (int p = 0; p < N_PHASES; ++p) { a.ph_lo = p; a.ph_hi = p + 1; hipLaunchKernelGGL(mk_fwd, dim3(grid), dim3(NTHR), LDS_BYTES, stream, a); }
#else
    a.ph_lo = 0; a.ph_hi = N_PHASES; hipLaunchKernelGGL(mk_fwd, dim3(grid), dim3(NTHR), LDS_BYTES, stream, a);
#endif
}
```

```cpp
#include <hip/hip_runtime.h>
#include <cstdio>
#include <cstdint>
namespace pg8 {
#define PG8_LAS __attribute__((address_space(3)))
typedef unsigned short bf16_t;
typedef short bf16x8 __attribute__((ext_vector_type(8)));
typedef float f32x4 __attribute__((ext_vector_type(4)));
typedef unsigned u32x4 __attribute__((ext_vector_type(4)));
constexpr int BM = 256, BK = 64, HALF = 128, HTB = HALF * BK * 2  , STAGE_BYTES = 8 * HTB, NXCD = 8, WGM = 8;

__host__ __device__ __forceinline__ int lds_byte(int r, int c) { const int st = (r >> 4) * 2 + (c >> 5), rr = r & 15, cc = c & 31, ob = rr * 64 + cc * 2; return st * 1024 + (ob ^ (((ob >> 9) & 1) << 5)); }
__host__ __device__ __forceinline__ void stage_rc(int b, int& R, int& C) { const int st = b / 1024, sb = b % 1024, swz = sb ^ (((sb >> 9) & 1) << 5); R = (st >> 1) * 16 + swz / 64; C = (st & 1) * 32 + (swz % 64) / 2; }
__host__ __device__ __forceinline__ int perm32(int rho) { const int n = rho >> 4, i = rho & 15; return 8 * (i >> 2) + 4 * n + (i & 3); }

struct Unit { int pm, pn, idx; };
struct Gemm { const bf16_t* A; const bf16_t* Bt; int M, N, K; };

struct StaticOrder {
    int nM, nN, nwg, G, c;
    __host__ __device__ __forceinline__ void init(int M, int N, int G_, int c_) { nM = M / BM; nN = N / BM; nwg = nM * nN; G = G_; c = c_; }
    __host__ __device__ __forceinline__ bool next(int i, Unit& u) const {
        const long L = (long)i * G + c; if (L >= nwg) return false;
        int wgid = (int)L; { const int q = nwg / NXCD, r = nwg % NXCD, xcd = wgid % NXCD, off = wgid / NXCD; wgid = (xcd < r ? xcd * (q + 1) : r * (q + 1) + (xcd - r) * q) + off; }
        const int nig = WGM * nN, gid = wgid / nig, fm = gid * WGM, gsz = (nM - fm) < WGM ? (nM - fm) : WGM;
        u.pm = fm + ((wgid % nig) % gsz); u.pn = (wgid % nig) / gsz; u.idx = i; return true;
    }
    __device__ __forceinline__ void a_ready(const Unit&) const {}
    __device__ __forceinline__ void done(const Unit&) const {}
};

typedef float cvt_f32x2_t __attribute__((ext_vector_type(2))); typedef __bf16 cvt_bf16x2_t __attribute__((ext_vector_type(2)));
__device__ __forceinline__ unsigned cvt_pk_bf16(float lo, float hi) { const cvt_f32x2_t v = {lo, hi}; return __builtin_bit_cast(unsigned, __builtin_convertvector(v, cvt_bf16x2_t)); }
typedef unsigned u32x2 __attribute__((ext_vector_type(2)));
constexpr float RMS_EPS = 1e-6f;
constexpr float LOG2E = 1.4426950408889634f, QSCALE = 0.125f * 1.4426950408889634f;
__device__ __forceinline__ float sum4(f32x4 a) { return (a.x + a.y) + (a.z + a.w); }
template <int NP> __device__ __forceinline__ float rstd_from(const float* part, int row, float inv_n) {
    const f32x4* p = (const f32x4*)(part + (size_t)row * NP); float s = 0.f;
#pragma unroll
    for (int i = 0; i < NP / 4; ++i) s += sum4(p[i]);
    return 1.0f / sqrtf(s * inv_n + RMS_EPS);
}
template <int ACT, int MODE> struct EpiBf16S {
    static constexpr bool PERM = true, AFTER_DRAIN = false, RESID_LDS = false, RESID_REMAP = false; static constexpr int MIDK = 0;
    bf16_t* O; int ldc; const PG8_LAS float* rstab; float* kout; float* vout; float* convout;
    __device__ __forceinline__ void midk(f32x4 (&)[2][2][4][2], const Unit&, int, int, int, int) const {}
    __device__ __forceinline__ void operator()(const f32x4 (&acc)[2][2][4][2], const Unit& u, int wr, int wc, int fr, int fq) const {
        const int pn = u.pn;
#pragma unroll
        for (int ai = 0; ai < 2; ++ai)
#pragma unroll
            for (int m = 0; m < 4; ++m) {
                const int row = u.pm * BM + ai * HALF + wr * 64 + m * 16 + fr;
                float rs = rstab[u.idx * BM + ai * HALF + wr * 64 + m * 16 + fr];
                if (MODE == 1 && pn < 2) rs *= QSCALE;
#pragma unroll
                for (int bj = 0; bj < 2; ++bj) {
                    const int col0 = pn * BM + bj * HALF + wc * 32 + fq * 8;
                    f32x4 v0 = acc[ai][bj][m][0] * rs, v1 = acc[ai][bj][m][1] * rs;
                    if (ACT == 1) {
                        v0.x = fmaxf(v0.x, 0.f); v0.y = fmaxf(v0.y, 0.f); v0.z = fmaxf(v0.z, 0.f); v0.w = fmaxf(v0.w, 0.f);
                        v1.x = fmaxf(v1.x, 0.f); v1.y = fmaxf(v1.y, 0.f); v1.z = fmaxf(v1.z, 0.f); v1.w = fmaxf(v1.w, 0.f);
                        v0 = v0 * v0; v1 = v1 * v1;
                    }
                    u32x4 w; w.x = cvt_pk_bf16(v0[0], v0[1]); w.y = cvt_pk_bf16(v0[2], v0[3]); w.z = cvt_pk_bf16(v1[0], v1[1]); w.w = cvt_pk_bf16(v1[2], v1[3]);
                    *(u32x4*)(O + (size_t)row * ldc + col0) = w;
                    if (MODE == 1) {
                        if (pn >= 2 && pn < 6) {
                            float* dst = (pn < 4 ? kout + (size_t)row * 512 + (col0 - 512) : vout + (size_t)row * 512 + (col0 - 1024));
                            __builtin_nontemporal_store(v0, (f32x4*)dst); __builtin_nontemporal_store(v1, (f32x4*)(dst + 4));
                        }
                        if (pn >= 8) {
                            const int t = row & 2047;
                            if (t >= 2045) { float* dst = convout + ((size_t)(row >> 11) * 3 + (t - 2045)) * 1024 + (col0 - 2048); *(f32x4*)dst = v0; *(f32x4*)(dst + 4) = v1; }
                        }
                    }
                }
                asm volatile("" ::: "memory");
            }
    }
};
template <int RSN, int MIDK_T, bool FINAL = false, int RL = 0> struct EpiResid {
    static constexpr bool PERM = (RL != 0), AFTER_DRAIN = (RL != 0), RESID_LDS = (RL != 0), RESID_REMAP = (RL == 2); static constexpr int MIDK = MIDK_T;
    __device__ __forceinline__ const char* resid_ptr(const Unit& u) const { return (const char*)(hb + (size_t)(u.pm * BM) * 1024 + u.pn * BM); }
    __device__ __forceinline__ void fused(const f32x4 (&acc)[2][2][4][2], const Unit& u, int wr, int wc, int fr, int fq, PG8_LAS unsigned char* lds, int, int) const {
        const int pn = u.pn;
#pragma unroll
        for (int ai = 0; ai < 2; ++ai)
#pragma unroll
            for (int m = 0; m < 4; ++m) {
                const int rl = wr * 64 + m * 16 + fr;
                const int row = u.pm * BM + ai * HALF + rl;
                float rs = 1.0f;
                if (RSN > 0) rs = rs_tab[ai * HALF + rl];
                float sq = 0.f;
#pragma unroll
                for (int bj = 0; bj < 2; ++bj) {
                    const int c = wc * 32 + fq * 8;
                    const size_t off = (size_t)row * 1024 + pn * BM + bj * HALF + c;
                    const u32x4 hh = *(const PG8_LAS u32x4*)(lds + (bj * 4 + (c >> 6) * 2 + ai) * HTB + lds_byte(rl, c & 63));
                    const f32x4 a0 = acc[ai][bj][m][0] * rs, a1 = acc[ai][bj][m][1] * rs;
                    const float h0 = __uint_as_float(hh.x << 16) + a0.x, h1 = __uint_as_float(hh.x & 0xffff0000u) + a0.y;
                    const float h2 = __uint_as_float(hh.y << 16) + a0.z, h3 = __uint_as_float(hh.y & 0xffff0000u) + a0.w;
                    const float h4 = __uint_as_float(hh.z << 16) + a1.x, h5 = __uint_as_float(hh.z & 0xffff0000u) + a1.y;
                    const float h6 = __uint_as_float(hh.w << 16) + a1.z, h7 = __uint_as_float(hh.w & 0xffff0000u) + a1.w;
                    u32x4 w; w.x = cvt_pk_bf16(h0, h1); w.y = cvt_pk_bf16(h2, h3); w.z = cvt_pk_bf16(h4, h5); w.w = cvt_pk_bf16(h6, h7); *(u32x4*)(hb + off) = w;
                    sq += ((h0 * h0 + h1 * h1) + (h2 * h2 + h3 * h3)) + ((h4 * h4 + h5 * h5) + (h6 * h6 + h7 * h7));
                }
                sq += __shfl_xor(sq, 16); sq += __shfl_xor(sq, 32);
                if (fq == 0) ssq_out[(size_t)row * 16 + pn * 4 + wc] = sq;
            }
    }
    float* hnew; bf16_t* hb; float* ssq_out; const PG8_LAS float* rs_tab; const PG8_LAS float* mid_tab;
    __device__ __forceinline__ void midk(f32x4 (&acc)[2][2][4][2], const Unit& u, int wr, int wc, int fr, int fq) const {
#pragma unroll
        for (int ai = 0; ai < 2; ++ai)
#pragma unroll
            for (int m = 0; m < 4; ++m) {
                const float rs = mid_tab[ai * HALF + wr * 64 + m * 16 + fr];
#pragma unroll
                for (int bj = 0; bj < 2; ++bj)
#pragma unroll
                    for (int n = 0; n < 2; ++n) acc[ai][bj][m][n] = acc[ai][bj][m][n] * rs;
            }
    }
    __device__ __forceinline__ void operator()(const f32x4 (&acc)[2][2][4][2], const Unit& u, int wr, int wc, int fr, int fq) const {
        const int pn = u.pn;
#pragma unroll
        for (int ai = 0; ai < 2; ++ai) {
            u32x2 ho[4][2][2];
#pragma unroll
            for (int m = 0; m < 4; ++m)
#pragma unroll
                for (int bj = 0; bj < 2; ++bj)
#pragma unroll
                    for (int n = 0; n < 2; ++n)
                        ho[m][bj][n] = *(const u32x2*)(hb + (size_t)(u.pm * BM + ai * HALF + wr * 64 + m * 16 + fr) * 1024 + pn * BM + bj * HALF + wc * 32 + n * 16 + fq * 4);
#pragma unroll
            for (int m = 0; m < 4; ++m) {
                const int row = u.pm * BM + ai * HALF + wr * 64 + m * 16 + fr;
                float rs = 1.0f;
                if (RSN > 0) rs = rs_tab[ai * HALF + wr * 64 + m * 16 + fr];
                float sq = 0.f;
#pragma unroll
                for (int bj = 0; bj < 2; ++bj)
#pragma unroll
                    for (int n = 0; n < 2; ++n) {
                        const size_t off = (size_t)row * 1024 + pn * BM + bj * HALF + wc * 32 + n * 16 + fq * 4;
                        const u32x2 hh = ho[m][bj][n];
                        const f32x4 av = acc[ai][bj][m][n] * rs;
                        const float h0 = __uint_as_float(hh.x << 16) + av.x, h1 = __uint_as_float(hh.x & 0xffff0000u) + av.y;
                        const float h2 = __uint_as_float(hh.y << 16) + av.z, h3 = __uint_as_float(hh.y & 0xffff0000u) + av.w;
                        if (FINAL) *(f32x4*)(hnew + off) = (f32x4){h0, h1, h2, h3};
                        else { u32x2 w; w.x = cvt_pk_bf16(h0, h1); w.y = cvt_pk_bf16(h2, h3); *(u32x2*)(hb + off) = w; }
                        sq += (h0 * h0 + h1 * h1) + (h2 * h2 + h3 * h3);
                    }
                sq += __shfl_xor(sq, 16); sq += __shfl_xor(sq, 32);
                if (fq == 0) ssq_out[(size_t)row * 16 + pn * 4 + wc] = sq;
            }
            asm volatile("" ::: "memory");
        }
    }
};
struct NoPre { __device__ __forceinline__ void operator()() const {} };
template <class Epi, class Sched, bool ALIGN_EPI = false, bool SP2 = false, int AUXA = 0, class Pre = NoPre>
__device__ __forceinline__ void gemm_phase(PG8_LAS unsigned char* lds, const Gemm g, const Sched& S, const Epi& E, const Pre& pre = Pre()) {
    const int tid = threadIdx.x, wid = __builtin_amdgcn_readfirstlane(tid >> 6), lane = tid & 63, wr = wid >> 2, wc = wid & 3, fr = lane & 15, fq = lane >> 4;
    const int K = g.K, nt = K / BK;
    unsigned voffA[2], voffB[2];
#pragma unroll
    for (int i = 0; i < 2; ++i) { int R, C; stage_rc(tid * 16 + i * 8192, R, C); const int Rb = Epi::PERM ? ((R & ~31) + perm32(R & 31)) : R;
        voffA[i] = (unsigned)(R * K + C) * 2u; voffB[i] = (unsigned)(Rb * K + C) * 2u; }
    unsigned voffR[2];
#pragma unroll
    for (int i = 0; i < 2; ++i) { int R, C; stage_rc(tid * 16 + i * 8192, R, C); voffR[i] = (unsigned)(R * 1024 + C) * 2u; }
    const size_t hstepR = (size_t)HALF * 1024 * 2;
    const size_t kstep = (size_t)(BK * 2);
    const size_t hstep = (size_t)HALF * K * 2;
    const size_t tstep = 2 * hstep;
    const unsigned ldsw = (unsigned)wid * 1024u;
    const int aoff = lds_byte(wr * 64 + fr, fq * 8), boff = lds_byte(wc * 32 + fr, fq * 8);
#define PG8_SA(b, h) (((b) * 2 + (h)) * HTB)
#define PG8_SB(b, h) ((4 + (b) * 2 + (h)) * HTB)
#define PG8_STAGE(bufoff, gbase, voff) do { _Pragma("unroll") for (int _i = 0; _i < 2; ++_i) \
        __builtin_amdgcn_global_load_lds((const unsigned*)((const char*)(gbase) + (voff)[_i]), (PG8_LAS unsigned*)(lds + (bufoff) + ldsw + _i * 8192), 16, 0, (&(voff)[0] == &voffA[0]) ? AUXA : 0); } while (0)
#define PG8_LDA(dst, b, h) do { _Pragma("unroll") for (int m = 0; m < 4; ++m) _Pragma("unroll") for (int k = 0; k < 2; ++k) dst[m][k] = *(const PG8_LAS bf16x8*)(lds + PG8_SA(b, h) + aoff + m * 2048 + k * 1024); } while (0)
#define PG8_LDB(dst, b, h) do { _Pragma("unroll") for (int n = 0; n < 2; ++n) _Pragma("unroll") for (int k = 0; k < 2; ++k) dst[n][k] = *(const PG8_LAS bf16x8*)(lds + PG8_SB(b, h) + boff + n * 2048 + k * 1024); } while (0)
#define PG8_MMA(ai, bj, At, Bt) do { __builtin_amdgcn_s_setprio(1); _Pragma("unroll") for (int m = 0; m < 4; ++m) _Pragma("unroll") for (int n = 0; n < 2; ++n) _Pragma("unroll") for (int k = 0; k < 2; ++k) \
        acc[ai][bj][m][n] = __builtin_amdgcn_mfma_f32_16x16x32_bf16(Bt[n][k], At[m][k], acc[ai][bj][m][n], 0, 0, 0); __builtin_amdgcn_s_setprio(0); } while (0)
#define PG8_WAIT_V(n) asm volatile("s_waitcnt vmcnt(" #n ")" ::: "memory")
#define PG8_WAIT_L(n) asm volatile("s_waitcnt lgkmcnt(" #n ")" ::: "memory")
#define PG8_BAR __builtin_amdgcn_s_barrier()
#define PG8_SCHED __builtin_amdgcn_sched_barrier(0)
    Unit cur, nxt; int ui = 0;
    if (!S.next(0, cur)) return;
    f32x4 acc[2][2][4][2];
#pragma unroll
    for (int a = 0; a < 2; ++a)
#pragma unroll
        for (int b = 0; b < 2; ++b)
#pragma unroll
            for (int m = 0; m < 4; ++m)
#pragma unroll
                for (int n = 0; n < 2; ++n) acc[a][b][m][n] = (f32x4){0.f, 0.f, 0.f, 0.f};
    bf16x8 At[4][2], B0[2][2], B1[2][2];
    const char* cA = (const char*)g.A + (size_t)cur.pm * tstep; const char* cB = (const char*)g.Bt + (size_t)cur.pn * tstep;
    S.a_ready(cur);
    if constexpr (SP2) {
        PG8_STAGE(PG8_SB(0, 0), cB, voffB); PG8_STAGE(PG8_SB(0, 1), cB + hstep, voffB); PG8_STAGE(PG8_SA(0, 0), cA, voffA); PG8_STAGE(PG8_SA(0, 1), cA + hstep, voffA);
        pre();
        if (wr == 1) PG8_BAR;
        PG8_WAIT_V(2); PG8_BAR;
        PG8_STAGE(PG8_SB(1, 0), cB + kstep, voffB); PG8_STAGE(PG8_SA(1, 0), cA + kstep, voffA); PG8_STAGE(PG8_SB(1, 1), cB + hstep + kstep, voffB);
        PG8_WAIT_V(6); PG8_BAR;
    } else {
        PG8_STAGE(PG8_SB(0, 0), cB, voffB); PG8_STAGE(PG8_SA(0, 0), cA, voffA); PG8_STAGE(PG8_SB(0, 1), cB + hstep, voffB); PG8_STAGE(PG8_SA(0, 1), cA + hstep, voffA);
        if (wr == 1) PG8_BAR;
        PG8_WAIT_V(4); PG8_BAR;
        PG8_STAGE(PG8_SB(1, 0), cB + kstep, voffB); PG8_STAGE(PG8_SA(1, 0), cA + kstep, voffA); PG8_STAGE(PG8_SB(1, 1), cB + hstep + kstep, voffB);
        PG8_WAIT_V(6); PG8_BAR;
    }
    for (;;) {
        const bool has_next = S.next(ui + 1, nxt);
        const char* nA = has_next ? (const char*)g.A + (size_t)nxt.pm * tstep : cA; const char* nB = has_next ? (const char*)g.Bt + (size_t)nxt.pn * tstep : cB;
        if constexpr (Epi::RESID_LDS) { if (!has_next) { nA = E.resid_ptr(cur); nB = nA + 2 * kstep; } }
        for (int t = 0; t < nt; t += 2) {
            if constexpr (Epi::MIDK > 0) { if (t == Epi::MIDK) E.midk(acc, cur, wr, wc, fr, fq); }
            const bool last = (t == nt - 2);
            const char* a1 = cA + (size_t)(t + 1) * kstep;
            const char* a2 = last ? nA : cA + (size_t)(t + 2) * kstep; const char* b2 = last ? nB : cB + (size_t)(t + 2) * kstep;
            const char* a3 = a2 + kstep; const char* b3 = b2 + kstep;
            if (last && has_next) S.a_ready(nxt);
            unsigned tA[2] = {voffA[0], voffA[1]}, tB[2] = {voffB[0], voffB[1]}; size_t th = hstep;
            if constexpr (Epi::RESID_REMAP) { if (last && !has_next) { tA[0] = voffR[0]; tA[1] = voffR[1]; tB[0] = voffR[0]; tB[1] = voffR[1]; th = hstepR; } }
            if constexpr (SP2) {
            PG8_LDB(B0, 0, 0); PG8_LDB(B1, 0, 1); PG8_SCHED; PG8_LDA(At, 0, 0); PG8_STAGE(PG8_SA(1, 1), a1 + hstep, voffA);
            PG8_WAIT_V(8); PG8_WAIT_L(0); PG8_BAR; PG8_MMA(0, 0, At, B0); PG8_MMA(0, 1, At, B1); PG8_BAR; PG8_SCHED;
            PG8_LDA(At, 0, 1); PG8_STAGE(PG8_SB(0, 0), b2, tB); PG8_STAGE(PG8_SB(0, 1), b2 + th, tB); PG8_STAGE(PG8_SA(0, 0), a2, tA);
            PG8_WAIT_V(8); PG8_WAIT_L(0); PG8_BAR; PG8_MMA(1, 0, At, B0); PG8_MMA(1, 1, At, B1); PG8_BAR; PG8_SCHED;
            PG8_LDB(B0, 1, 0); PG8_LDB(B1, 1, 1); PG8_SCHED; PG8_LDA(At, 1, 0); PG8_STAGE(PG8_SA(0, 1), a2 + th, tA);
            PG8_WAIT_V(8); PG8_WAIT_L(0); PG8_BAR; PG8_MMA(0, 0, At, B0); PG8_MMA(0, 1, At, B1); PG8_BAR; PG8_SCHED;
            PG8_LDA(At, 1, 1); PG8_STAGE(PG8_SB(1, 0), b3, tB); PG8_STAGE(PG8_SB(1, 1), b3 + th, tB); PG8_STAGE(PG8_SA(1, 0), a3, tA);
            PG8_WAIT_V(8); PG8_WAIT_L(0); PG8_BAR; PG8_MMA(1, 0, At, B0); PG8_MMA(1, 1, At, B1); PG8_BAR; PG8_SCHED;
            } else {
            PG8_LDB(B0, 0, 0); PG8_SCHED; PG8_LDA(At, 0, 0); PG8_STAGE(PG8_SA(1, 1), a1 + hstep, voffA);
            PG8_WAIT_L(8); PG8_BAR; PG8_WAIT_L(0); PG8_MMA(0, 0, At, B0); PG8_BAR; PG8_SCHED;
            PG8_LDB(B1, 0, 1); PG8_STAGE(PG8_SB(0, 0), b2, voffB);
            PG8_BAR; PG8_WAIT_L(0); PG8_MMA(0, 1, At, B1); PG8_BAR;
            PG8_LDA(At, 0, 1); PG8_STAGE(PG8_SA(0, 0), a2, voffA);
            PG8_BAR; PG8_WAIT_L(0); PG8_MMA(1, 0, At, B0); PG8_BAR; PG8_SCHED;
            PG8_STAGE(PG8_SB(0, 1), b2 + hstep, voffB);
            PG8_WAIT_V(6); PG8_BAR; PG8_MMA(1, 1, At, B1); PG8_BAR;
            PG8_LDB(B0, 1, 0); PG8_SCHED; PG8_LDA(At, 1, 0); PG8_STAGE(PG8_SA(0, 1), a2 + hstep, voffA);
            PG8_WAIT_L(8); PG8_BAR; PG8_WAIT_L(0); PG8_MMA(0, 0, At, B0); PG8_BAR; PG8_SCHED;
            PG8_LDB(B1, 1, 1); PG8_STAGE(PG8_SB(1, 0), b3, voffB);
            PG8_BAR; PG8_WAIT_L(0); PG8_MMA(0, 1, At, B1); PG8_BAR;
            PG8_LDA(At, 1, 1); PG8_STAGE(PG8_SA(1, 0), a3, voffA);
            PG8_BAR; PG8_WAIT_L(0); PG8_MMA(1, 0, At, B0); PG8_BAR; PG8_SCHED;
            PG8_STAGE(PG8_SB(1, 1), b3 + hstep, voffB);
            PG8_WAIT_V(6); PG8_BAR; PG8_MMA(1, 1, At, B1); PG8_BAR;
            }
        }
        if constexpr (ALIGN_EPI) { if (wr == 0) PG8_BAR; }
        if constexpr (Epi::RESID_LDS) { if (!has_next) { if constexpr (Epi::RESID_REMAP) PG8_STAGE(PG8_SA(1, 1), nA + kstep + hstepR, voffR); else PG8_STAGE(PG8_SA(1, 1), nA + kstep + hstep, voffA); } }
        if constexpr (!Epi::AFTER_DRAIN) { E(acc, cur, wr, wc, fr, fq); S.done(cur); }
        if (!has_next) break;
#pragma unroll
        for (int a = 0; a < 2; ++a)
#pragma unroll
            for (int b = 0; b < 2; ++b)
#pragma unroll
                for (int m = 0; m < 4; ++m)
#pragma unroll
                    for (int n = 0; n < 2; ++n) acc[a][b][m][n] = (f32x4){0.f, 0.f, 0.f, 0.f};
        cur = nxt; cA = nA; cB = nB; ++ui;
        if constexpr (ALIGN_EPI) { if (wr == 1) PG8_BAR; }
    }
    PG8_WAIT_V(0);
    if constexpr (!ALIGN_EPI) { if (wr == 0) PG8_BAR; }
    PG8_BAR;
    if constexpr (Epi::AFTER_DRAIN) { E.fused(acc, cur, wr, wc, fr, fq, lds, wid, lane); S.done(cur); }
#undef PG8_SA
#undef PG8_SB
#undef PG8_STAGE
#undef PG8_LDA
#undef PG8_LDB
#undef PG8_MMA
#undef PG8_WAIT_V
#undef PG8_WAIT_L
#undef PG8_BAR
#undef PG8_SCHED
}
}

using pg8::RMS_EPS; using pg8::LOG2E; using pg8::u32x4;
constexpr int NWAVES = 8, NTHR = 512;
constexpr int NB = 8, T = 2048, D = 1024, FF = 4096, M = NB * T;
constexpr int MS = 32;
constexpr int PAST = 8192, PAGE = 128, NPAGES = 64;
constexpr int EVEN_IN = 3080, NE = 3072, NES = 3104;
constexpr int ODD_IN = 4096;
constexpr int N_PHYS = 2560;
constexpr int DRING = 6;
constexpr int NDP = 8;
enum { I_XP = 0, I_XS, I_CK, I_CV, I_PT, I_SCONV, I_SSSM, I_SHG, I_NMIX, I_NFFN, I_NFIN, I_WINE, I_SBB, I_CONVW, I_CONVB, I_DTB, I_ALOG, I_DSKIP, I_SSDN, I_WOUTE, I_WINO, I_LBRAW, I_HGN, I_WOUTO, I_W1, I_W2, N_IN };
constexpr size_t O_YP = 0, O_YS = O_YP + (size_t)M * D, O_KP = O_YS + (size_t)MS * D, O_VP = O_KP + (size_t)M * 512, O_KS = O_VP + (size_t)M * 512, O_VS = O_KS + (size_t)MS * 512,
                 O_CP = O_VS + (size_t)MS * 512, O_CS = O_CP + (size_t)NB * 3 * 1024, O_SP = O_CS + (size_t)MS * 3 * 1024, O_SS = O_SP + (size_t)NB * 8 * 64 * 128,
                 O_GP = O_SS + (size_t)MS * 8 * 64 * 128, O_GS = O_GP + (size_t)NB * 8 * 128 * 128, O_END = O_GS + (size_t)MS * 8 * 128 * 128;
constexpr size_t MiB = 1u << 20;
constexpr size_t WS_CTL = 0, CTL_ZERO_BYTES = 1 * MiB;
constexpr size_t WS_WINE = 2 * MiB;
constexpr size_t WS_WOUTE = 10 * MiB;
constexpr size_t WS_WINO = 12 * MiB;
constexpr size_t WS_WOUTO = 20 * MiB;
constexpr size_t WS_W1 = 22 * MiB;
constexpr size_t WS_W2 = 38 * MiB;
constexpr size_t WS_HB = 54 * MiB;
constexpr size_t WS_H = 86 * MiB;
constexpr size_t WS_SSQ = 150 * MiB;
constexpr size_t WS_DTRAW = 151 * MiB;
constexpr size_t WS_SSM = 152 * MiB;
constexpr size_t WS_MIX = 154 * MiB;
constexpr size_t WS_QKV = 186 * MiB;
constexpr size_t WS_HID = 282 * MiB;
constexpr size_t WS_SMP = 410 * MiB;
constexpr size_t SM_H = 0, SM_IN = SM_H + (size_t)MS * 1024 * 4, SM_HID = SM_IN + (size_t)MS * 4096 * 4, SM_YG = SM_HID + (size_t)MS * 4096 * 4, SM_OPART = SM_YG + (size_t)MS * 512 * 4,
                 SM_LPART = SM_OPART + (size_t)MS * NDP * 512 * 4, SM_O = SM_LPART + (size_t)MS * NDP * 8 * 4, SM_END = SM_O + (size_t)MS * 1024 * 4;
constexpr size_t WS_END = WS_SMP + 4 * MiB;
static_assert(SM_END <= 4 * MiB, "sample scratch");
constexpr int CW_TS = 1024, CW_TMO = 0, CW_QATT = 64, CW_QDEC = 128, CW_QSSD = 192, CW_CONV = 224, CW_BAR = 4096;

constexpr int RING_BYTES = 131072, MISC_OFF = RING_BYTES + 320, LDS_BYTES = 147456;

#define GAS __attribute__((address_space(1)))
#define LAS __attribute__((address_space(3)))
typedef unsigned short bf16;
typedef unsigned v4u __attribute__((ext_vector_type(4)));
typedef float f32x4 __attribute__((ext_vector_type(4)));
typedef short bf16x8 __attribute__((ext_vector_type(8)));
typedef GAS unsigned gu32;
typedef GAS unsigned long long gu64;
#define RLX_AGENT __ATOMIC_RELAXED, __HIP_MEMORY_SCOPE_AGENT
#define LDS_WAIT() asm volatile("s_waitcnt lgkmcnt(0)" ::: "memory")
#define VM_WAIT() asm volatile("s_waitcnt vmcnt(0)" ::: "memory")
__device__ __forceinline__ unsigned long long rt() { return __builtin_amdgcn_s_memrealtime(); }
__device__ __forceinline__ unsigned f2bf(float f) { unsigned u = __builtin_bit_cast(unsigned, f); return (u + 0x7fffu + ((u >> 16) & 1u)) >> 16; }
__device__ __forceinline__ unsigned pk2(float lo, float hi) { return pg8::cvt_pk_bf16(lo, hi); }

#define XB_TMO      128
#define XB_XCNT(j)  (256  + 64 * (j))
#define XB_XSUB(j)  (1280 + 64 * (j))
#define XB_XGEN(j)  (2304 + 64 * (j))
#define XB_TOP      3328
#define XB_TOPGEN   3392
#define XCD_BAR_WORDS 3456
#define XB_SPIN_CAP (1u << 18)

__device__ __forceinline__ unsigned xb_ld(unsigned* p)              { return __hip_atomic_load(p, __ATOMIC_RELAXED, __HIP_MEMORY_SCOPE_AGENT); }
__device__ __forceinline__ unsigned xb_add(unsigned* p, unsigned v) { return __hip_atomic_fetch_add(p, v, __ATOMIC_RELAXED, __HIP_MEMORY_SCOPE_AGENT); }
__device__ __forceinline__ unsigned xb_xcc_id() { return (unsigned)__builtin_amdgcn_s_getreg((3 << 11) | 20) & 0xFu; }
#define XB_SPIN(cond, bar) do { unsigned _sp = 0; while (cond) { __builtin_amdgcn_s_sleep(1); \
    if ((++_sp & 255u) == 0u) { if (xb_ld(&(bar)[XB_TMO])) break; if (_sp > XB_SPIN_CAP) { atomicAdd(&(bar)[XB_TMO], 1u); break; } } } } while (0)

struct XcdBarrier {
    unsigned* bar; unsigned x;
    volatile LAS unsigned* st;
};

__device__ __forceinline__ XcdBarrier xcd_barrier_post(unsigned* bar, volatile LAS unsigned* st) {
    XcdBarrier b; b.bar = bar; b.x = xb_xcc_id(); b.st = st;
    if (threadIdx.x == 0) (void)xb_add(&bar[XB_XCNT(b.x)], 1u);
    return b;
}
__device__ __forceinline__ void xcd_barrier_complete(unsigned* bar, unsigned x, unsigned& nloc, unsigned& nx) {
    const unsigned G = gridDim.x * gridDim.y * gridDim.z;
    unsigned sum, cnt, mine, sp = 0u;
    for (;;) {
        sum = 0u; cnt = 0u; mine = 0u;
#pragma unroll
        for (unsigned j = 0; j < 16; ++j) { const unsigned c = xb_ld(&bar[XB_XCNT(j)]); sum += c; cnt += (c > 0u) ? 1u : 0u; mine = (j == x) ? c : mine; }
        if (sum == G) break;
        __builtin_amdgcn_s_sleep(1);
        if ((++sp & 255u) == 0u) { if (xb_ld(&bar[XB_TMO])) break; if (sp > XB_SPIN_CAP) { atomicAdd(&bar[XB_TMO], 1u); break; } }
    }
    nloc = mine > 0u ? mine : 1u; nx = cnt > 0u ? cnt : 1u;
}

__device__ __forceinline__ void xcd_barrier(const XcdBarrier& b) {
    asm volatile("s_waitcnt vmcnt(0)" ::: "memory");
    __syncthreads();
    if (threadIdx.x == 0) {
        unsigned* bar = b.bar;
        __builtin_amdgcn_s_waitcnt(0);
        unsigned nloc = b.st[0], nx = b.st[1];
        if (nloc == 0u) { xcd_barrier_complete(bar, b.x, nloc, nx); b.st[0] = nloc; b.st[1] = nx; }
        const unsigned old = xb_add(&bar[XB_XSUB(b.x)], 1u);
        const unsigned gen = old / nloc;
        if (old + 1u == (gen + 1u) * nloc) {
            __builtin_amdgcn_fence(__ATOMIC_RELEASE, "agent");
            asm volatile("s_waitcnt vmcnt(0)" ::: "memory");
            const unsigned og = xb_add(&bar[XB_TOP], 1u);
            const unsigned tg = og / nx;
            if (og + 1u == (tg + 1u) * nx) xb_add(&bar[XB_TOPGEN], 1u);
            else XB_SPIN(xb_ld(&bar[XB_TOPGEN]) == tg, bar);
            __builtin_amdgcn_fence(__ATOMIC_ACQUIRE, "agent");
            xb_add(&bar[XB_XGEN(b.x)], 1u);
            asm volatile("s_waitcnt vmcnt(0)" ::: "memory");
        } else {
            XB_SPIN(xb_ld(&bar[XB_XGEN(b.x)]) == gen, bar);
            __builtin_amdgcn_fence(__ATOMIC_ACQUIRE, "agent");
            asm volatile("s_waitcnt vmcnt(0)" ::: "memory");
        }
    }
    __syncthreads();
}

typedef unsigned u32x2v __attribute__((ext_vector_type(2)));
typedef float f32x2v __attribute__((ext_vector_type(2)));
__device__ __forceinline__ float bf2f(unsigned short b) { return __uint_as_float(((unsigned)b) << 16); }
__device__ __forceinline__ float bflo(unsigned u) { return __uint_as_float(u << 16); }
__device__ __forceinline__ float bfhi(unsigned u) { return __uint_as_float(u & 0xffff0000u); }
__device__ __forceinline__ float silu_f(float x) { return x / (1.0f + __expf(-x)); }
__device__ __forceinline__ float silu_fast(float x) { return x * __builtin_amdgcn_rcpf(1.0f + __builtin_amdgcn_exp2f(-1.4426950408889634f * x)); }
__device__ __forceinline__ float sigmoid_f(float x) { return 1.0f / (1.0f + __expf(-x)); }
__device__ __forceinline__ float softplus_f(float x) { return fmaxf(x, 0.f) + log1pf(__expf(-fabsf(x))); }
__device__ __forceinline__ float wave_sum(float v) {
#pragma unroll
    for (int o = 1; o < 64; o <<= 1) v += __shfl_xor(v, o);
    return v;
}

struct Args { const void* in[N_IN]; float* out; unsigned char* ws; int ph_lo, ph_hi; };

__device__ __forceinline__ unsigned cvtpk0(float lo, float hi) { return pg8::cvt_pk_bf16(lo, hi); }
struct P0Desc { const float* W; bf16* WT; const float* scale; int K, N, Npad, kxor, sk0, item; };
__device__ __forceinline__ void p0_load(const P0Desc& d, float (&v)[32], int lane) {
    const int nblk = d.Npad / 32, kb = d.item / nblk, nb = d.item % nblk, k0 = 64 * kb, n = 32 * nb + (lane & 31);
#pragma unroll
    for (int i = 0; i < 32; ++i) {
        const int k = k0 + 2 * i + (lane >> 5);
        v[i] = (n < d.N) ? d.W[(size_t)k * d.N + n] : 0.f;
    }
}
__device__ __forceinline__ void p0_store(const P0Desc& d, const float (&v)[32], LAS float* scr, int lane) {
    const int nblk = d.Npad / 32, kb = d.item / nblk, nb = d.item % nblk, k0 = 64 * kb, n0 = 32 * nb;
#pragma unroll
    for (int i = 0; i < 32; ++i) scr[(2 * i + (lane >> 5)) * 33 + (lane & 31)] = v[i];
    LDS_WAIT(); asm volatile("" ::: "memory");
    const int c = lane & 7;
    f32x4 g0 = (f32x4){1.f, 1.f, 1.f, 1.f}, g1 = g0;
    if (d.scale && k0 + 8 * c >= d.sk0) { g0 = *(const f32x4*)(d.scale + (k0 + 8 * c - d.sk0)); g1 = *(const f32x4*)(d.scale + (k0 + 8 * c - d.sk0) + 4); }
#pragma unroll
    for (int j = 0; j < 4; ++j) {
        const int nn = (lane >> 3) + 8 * j; const LAS float* s = scr + (8 * c) * 33 + nn;
        v4u o; o.x = cvtpk0(s[0 * 33] * g0.x, s[1 * 33] * g0.y); o.y = cvtpk0(s[2 * 33] * g0.z, s[3 * 33] * g0.w); o.z = cvtpk0(s[4 * 33] * g1.x, s[5 * 33] * g1.y); o.w = cvtpk0(s[6 * 33] * g1.z, s[7 * 33] * g1.w);
        *(GAS v4u*)(d.WT + (size_t)(n0 + nn) * d.K + ((k0 + 8 * c) ^ d.kxor)) = o;
    }
    LDS_WAIT(); asm volatile("" ::: "memory");
}

typedef short v4i16_t __attribute__((ext_vector_type(4)));
struct P0W { const float* W; bf16* WT; const float* scale; int K, N, kxor, sk0, kb32, nb, late; };
constexpr int P0W_STR = 320;
__device__ __forceinline__ void p0w_load(const P0W& d, f32x4 (&v)[16], float& sv, int lane) {
    const int k0 = 32 * d.kb32; const size_t col = (size_t)128 * d.nb + 4 * (lane & 31);
    sv = 1.0f;
    if (d.scale) { const int k = k0 + (lane & 31); if (k >= d.sk0) sv = d.scale[k - d.sk0]; }
#pragma unroll
    for (int i = 0; i < 16; ++i) v[i] = __builtin_nontemporal_load((const f32x4*)(d.W + (size_t)(k0 + 2 * i + (lane >> 5)) * d.N + col));
}
__device__ __forceinline__ void p0w_store(const P0W& d, const f32x4 (&v)[16], float sv, unsigned char* scr, int lane) {
    const int par = lane >> 5;
#pragma unroll
    for (int i = 0; i < 16; ++i) {
        const float se = __int_as_float(__builtin_amdgcn_readlane(__float_as_int(sv), 2 * i)), so = __int_as_float(__builtin_amdgcn_readlane(__float_as_int(sv), 2 * i + 1));
        const float sc = par ? so : se;
        u32x2v w; w.x = cvtpk0(v[i].x * sc, v[i].y * sc); w.y = cvtpk0(v[i].z * sc, v[i].w * sc);
        *(u32x2v*)(scr + (2 * i + par) * P0W_STR + (lane & 31) * 8) = w;
    }
    LDS_WAIT(); asm volatile("" ::: "memory");
    const int g = lane >> 4, q = (lane & 15) >> 2, pp = lane & 3;
    const LAS unsigned char* s3 = (const LAS unsigned char*)scr;
#pragma unroll
    for (int it = 0; it < 8; ++it) {
        const int kc = it & 3, colblk = (it >> 2) * 64 + g * 16;
        const LAS unsigned char* a = s3 + (8 * kc + q) * P0W_STR + (colblk + 4 * pp) * 2;
        const v4i16_t r0 = __builtin_amdgcn_ds_read_tr16_b64_v4i16((LAS v4i16_t*)a);
        const v4i16_t r1 = __builtin_amdgcn_ds_read_tr16_b64_v4i16((LAS v4i16_t*)(a + 4 * P0W_STR));
        const int n = 128 * d.nb + colblk + (lane & 15), kd = (32 * d.kb32 + 8 * kc) ^ d.kxor;
        typedef short s16x8 __attribute__((ext_vector_type(8)));
        const s16x8 ov = (s16x8){r0[0], r0[1], r0[2], r0[3], r1[0], r1[1], r1[2], r1[3]};
        if (d.late) __builtin_nontemporal_store(ov, (s16x8*)(d.WT + (size_t)n * d.K + kd)); else *(GAS s16x8*)(d.WT + (size_t)n * d.K + kd) = ov;
    }
    LDS_WAIT(); asm volatile("" ::: "memory");
}

constexpr int SK_LDA = 1024 + 8;
constexpr int SK_A_BYTES = 32 * SK_LDA * 2;
constexpr int SK_RED_OFF = 67584;
constexpr int SK_AUX_OFF = SK_RED_OFF + 8 * 4096;
template <class Builder, class Epi>
__device__ __forceinline__ void skinny_unit(unsigned char* lds, const bf16* Wt, int K, int u, int kc, const Builder& B, const Epi& E) {
    const int tid = threadIdx.x, lane = tid & 63, wid = tid >> 6, r32 = lane & 31, hi = lane >> 5;
    typedef float f32x16 __attribute__((ext_vector_type(16)));
    f32x16 acc;
#pragma unroll
    for (int i = 0; i < 16; ++i) acc[i] = 0.f;
    bf16* Al = (bf16*)lds;
    const bf16* wrow = Wt + (size_t)(u * 32 + r32) * K + kc + wid * 128 + hi * 8;
    bf16x8 bfr[8];
#pragma unroll
    for (int s = 0; s < 8; ++s) bfr[s] = *(const bf16x8*)(wrow + s * 16);
    __syncthreads();
    B(Al, (float*)(lds + SK_AUX_OFF), kc);
    __syncthreads();
#pragma unroll
    for (int s = 0; s < 8; ++s) {
        const bf16x8 afr = *(const bf16x8*)(Al + r32 * SK_LDA + wid * 128 + s * 16 + hi * 8);
        acc = __builtin_amdgcn_mfma_f32_32x32x16_bf16(afr, bfr[s], acc, 0, 0, 0);
    }
    float* red = (float*)(lds + SK_RED_OFF);
#pragma unroll
    for (int i = 0; i < 16; ++i) { const int row = (i & 3) + 8 * (i >> 2) + 4 * hi; red[wid * 1024 + row * 32 + r32] = acc[i]; }
    __syncthreads();
#pragma unroll
    for (int e = 0; e < 2; ++e) {
        const int idx = tid + e * 512; float s = 0.f;
#pragma unroll
        for (int w = 0; w < 8; ++w) s += red[w * 1024 + idx];
        E(idx >> 5, u * 32 + (idx & 31), s);
    }
    __syncthreads();
}
struct BuildNorm {
    const float* X;
    __device__ __forceinline__ void operator()(bf16* Al, float* aux, int kc) const {
        const int tid = threadIdx.x, row = tid >> 4, c16 = tid & 15;
        f32x4 v[16]; float s = 0.f;
#pragma unroll
        for (int j = 0; j < 16; ++j) { v[j] = *(const f32x4*)(X + (size_t)row * 1024 + j * 64 + c16 * 4); s += (v[j].x * v[j].x + v[j].y * v[j].y) + (v[j].z * v[j].z + v[j].w * v[j].w); }
        s += __shfl_xor(s, 1); s += __shfl_xor(s, 2); s += __shfl_xor(s, 4); s += __shfl_xor(s, 8);
        const float rs = 1.0f / sqrtf(s * (1.0f / 1024.0f) + RMS_EPS);
#pragma unroll
        for (int j = 0; j < 16; ++j) { u32x2v w; w.x = pk2(v[j].x * rs, v[j].y * rs); w.y = pk2(v[j].z * rs, v[j].w * rs); *(u32x2v*)(Al + row * SK_LDA + j * 64 + c16 * 4) = w; }
    }
};
struct BuildPlain {
    const float* X; int ldx;
    __device__ __forceinline__ void operator()(bf16* Al, float* aux, int kc) const {
        const int tid = threadIdx.x, row = tid >> 4, c16 = tid & 15;
#pragma unroll
        for (int j = 0; j < 16; ++j) { const f32x4 v = *(const f32x4*)(X + (size_t)row * ldx + kc + j * 64 + c16 * 4); u32x2v w; w.x = pk2(v.x, v.y); w.y = pk2(v.z, v.w); *(u32x2v*)(Al + row * SK_LDA + j * 64 + c16 * 4) = w; }
    }
};
struct BuildMixEven {
    const float* YG;
    const float* OPART;
    const float* LPART;
    __device__ __forceinline__ void operator()(bf16* Al, float* aux, int kc) const {
        const int tid = threadIdx.x, row = tid >> 4, c16 = tid & 15;
        {
            f32x4 v[8]; float s = 0.f;
#pragma unroll
            for (int j = 0; j < 8; ++j) { v[j] = *(const f32x4*)(YG + (size_t)row * 512 + j * 64 + c16 * 4); s += (v[j].x * v[j].x + v[j].y * v[j].y) + (v[j].z * v[j].z + v[j].w * v[j].w); }
            s += __shfl_xor(s, 1); s += __shfl_xor(s, 2); s += __shfl_xor(s, 4); s += __shfl_xor(s, 8);
            const float rs = 1.0f / sqrtf(s * (1.0f / 512.0f) + RMS_EPS);
#pragma unroll
            for (int j = 0; j < 8; ++j) { u32x2v w; w.x = pk2(v[j].x * rs, v[j].y * rs); w.y = pk2(v[j].z * rs, v[j].w * rs); *(u32x2v*)(Al + row * SK_LDA + j * 64 + c16 * 4) = w; }
        }
        {
#pragma unroll 1
            for (int j = 0; j < 8; ++j) {
                f32x4 x[NDP]; float lp[NDP];
#pragma unroll
                for (int p = 0; p < NDP; ++p) { x[p] = *(const f32x4*)(OPART + ((size_t)row * NDP + p) * 512 + j * 64 + c16 * 4); lp[p] = LPART[((size_t)row * NDP + p) * 8 + j]; }
                f32x4 o = (f32x4){0.f, 0.f, 0.f, 0.f}; float run = 0.f;
#pragma unroll
                for (int p = NDP - 1; p >= 0; --p) { o = o + x[p] * __expf(run); run += lp[p]; }
                u32x2v w; w.x = pk2(o.x, o.y); w.y = pk2(o.z, o.w); *(u32x2v*)(Al + row * SK_LDA + 512 + j * 64 + c16 * 4) = w;
            }
        }
    }
};
struct BuildMixOdd {
    const float* O;
    const float* IN2;
    __device__ __forceinline__ void operator()(bf16* Al, float* aux, int kc) const {
        const int tid = threadIdx.x, row = tid >> 4, c16 = tid & 15;
        f32x4 v[16]; float s = 0.f;
#pragma unroll
        for (int j = 0; j < 16; ++j) { v[j] = *(const f32x4*)(O + (size_t)row * 1024 + j * 64 + c16 * 4); s += (v[j].x * v[j].x + v[j].y * v[j].y) + (v[j].z * v[j].z + v[j].w * v[j].w); }
        s += __shfl_xor(s, 1); s += __shfl_xor(s, 2); s += __shfl_xor(s, 4); s += __shfl_xor(s, 8);
        const float rs = 1.0f / sqrtf(s * (1.0f / 1024.0f) + RMS_EPS);
#pragma unroll
        for (int j = 0; j < 16; ++j) {
            const f32x4 g = *(const f32x4*)(IN2 + (size_t)row * 4096 + 3072 + j * 64 + c16 * 4);
            u32x2v w; w.x = pk2(v[j].x * rs * silu_f(g.x), v[j].y * rs * silu_f(g.y)); w.y = pk2(v[j].z * rs * silu_f(g.z), v[j].w * rs * silu_f(g.w));
            *(u32x2v*)(Al + row * SK_LDA + j * 64 + c16 * 4) = w;
        }
    }
};
struct SEpiInEven { float* IN; float* kout; float* vout;
    __device__ __forceinline__ void operator()(int row, int col, float v) const {
        IN[(size_t)row * NES + col] = v;
        if (col >= 512 && col < 1024) kout[row * 512 + col - 512] = v;
        if (col >= 1024 && col < 1536) vout[row * 512 + col - 1024] = v;
    } };
struct SEpiStore { float* O; int ldo; __device__ __forceinline__ void operator()(int row, int col, float v) const { O[(size_t)row * ldo + col] = v; } };
struct SEpiRelu2 { float* O; int ldo; __device__ __forceinline__ void operator()(int row, int col, float v) const { const float r = fmaxf(v, 0.f); O[(size_t)row * ldo + col] = r * r; } };
struct SEpiAtomic { float* h; __device__ __forceinline__ void operator()(int row, int col, float v) const { atomicAdd(h + row * 1024 + col, v); } };
struct SEpiResid { const float* hold; float* hnew; __device__ __forceinline__ void operator()(int row, int col, float v) const { hnew[row * 1024 + col] = hold[row * 1024 + col] + v; } };

template <int CTRL> __device__ __forceinline__ float dppmov(float v) { return __int_as_float(__builtin_amdgcn_mov_dpp(__float_as_int(v), CTRL, 0xF, 0xF, true)); }
__device__ __forceinline__ float red16(float z) { z += dppmov<0xB1>(z); z += dppmov<0x4E>(z); z += dppmov<0x141>(z); z += dppmov<0x140>(z); return z; }
__device__ __forceinline__ void decode_unit(unsigned char* lds, const float* IN  , const float* ck, const float* cv, const int* ptab, const float* sb_bias,
                                            float* OPART, float* LPART, int seq, int part) {
    const int tid = threadIdx.x, lane = tid & 63, wid = tid >> 6;
    const int hsub = lane >> 4, dq = (lane & 15) * 4;
    f32x4 q0 = *(const f32x4*)(IN + (size_t)seq * NES + hsub * 64 + dq), q1 = *(const f32x4*)(IN + (size_t)seq * NES + (4 + hsub) * 64 + dq);
    q0 = q0 * 0.125f; q1 = q1 * 0.125f;
    const float b0 = sb_bias[hsub], b1 = sb_bias[4 + hsub];
    const int phys = ptab[seq * NPAGES + part * 8 + wid];
    const float* kp = ck + (size_t)phys * PAGE * 512 + lane * 4;
    const float* vp = cv + (size_t)phys * PAGE * 512 + lane * 4;
    f32x4 o0 = (f32x4){0.f, 0.f, 0.f, 0.f}, o1 = o0; float a0 = 0.f, a1 = 0.f;
    f32x4 K0[DRING], K1[DRING], V0[DRING], V1[DRING];
#define DEC_LOAD(s_, tk_) do { const float* kq_ = kp + (size_t)(tk_) * 512; const float* vq_ = vp + (size_t)(tk_) * 512; \
        K0[s_] = __builtin_nontemporal_load((const f32x4*)(kq_)); K1[s_] = __builtin_nontemporal_load((const f32x4*)(kq_ + 256)); \
        V0[s_] = __builtin_nontemporal_load((const f32x4*)(vq_)); V1[s_] = __builtin_nontemporal_load((const f32x4*)(vq_ + 256)); } while (0)
#define DEC_PROC(s_) do { \
        float z0 = (K0[s_].x * q0.x + K0[s_].y * q0.y) + (K0[s_].z * q0.z + K0[s_].w * q0.w); \
        float z1 = (K1[s_].x * q1.x + K1[s_].y * q1.y) + (K1[s_].z * q1.z + K1[s_].w * q1.w); \
        z0 = red16(z0) + b0; z1 = red16(z1) + b1; \
        const float sp0 = __logf(1.0f + __expf(-fabsf(z0))), sp1 = __logf(1.0f + __expf(-fabsf(z1))); \
        const float w0 = __expf(fminf(z0, 0.f) - sp0 + a0), w1 = __expf(fminf(z1, 0.f) - sp1 + a1); \
        a0 += -fmaxf(z0, 0.f) - sp0; a1 += -fmaxf(z1, 0.f) - sp1; \
        o0 = o0 + V0[s_] * w0; o1 = o1 + V1[s_] * w1; } while (0)
    static_assert(DRING == 6 && PAGE == 128, "ring schedule: 6 slots, 128-token pages: 21 full turns (tokens 127..2), then tokens 1 and 0 are left in slots 0 and 1");
#pragma unroll
    for (int j = 0; j < DRING; ++j) DEC_LOAD(j, PAGE - 1 - j);
#pragma unroll 3
    for (int tk = PAGE - 1; tk >= 2; tk -= DRING) {
#pragma unroll
        for (int sl = 0; sl < DRING; ++sl) { DEC_PROC(sl); __builtin_amdgcn_sched_barrier(0); const int tn = tk - sl - DRING; DEC_LOAD(sl, tn < 0 ? 0 : tn); __builtin_amdgcn_sched_barrier(0); }
    }
    DEC_PROC(0); DEC_PROC(1);
#undef DEC_PROC
#undef DEC_LOAD
    float* Ow = (float*)lds;
    float* Lw = (float*)(lds + 8 * 512 * 4);
    __syncthreads();
    *(f32x4*)(Ow + wid * 512 + hsub * 64 + dq) = o0; *(f32x4*)(Ow + wid * 512 + (4 + hsub) * 64 + dq) = o1;
    if ((lane & 15) == 0) { Lw[wid * 8 + hsub] = a0; Lw[wid * 8 + 4 + hsub] = a1; }
    __syncthreads();
    {
        const int head = tid >> 6; float run = 0.f, o = 0.f;
        for (int w = 7; w >= 0; --w) { o += __expf(run) * Ow[w * 512 + tid]; run += Lw[w * 8 + head]; }
        OPART[((size_t)seq * NDP + part) * 512 + tid] = o;
        if ((tid & 63) == 0) LPART[((size_t)seq * NDP + part) * 8 + head] = run;
    }
    __syncthreads();
}
__device__ __forceinline__ void ssd_sample_unit(unsigned char* lds, const float* IN, const float* sconv, const float* sssm, const float* convw, const float* convb, const float* dtb, const float* alog,
                                                const float* dskip, float* conv_out, float* ssm_out, float* YG, int seq, int h) {
    const int tid = threadIdx.x; const int g = h >> 2;
    float* xc = (float*)lds; float* Bc = xc + 64; float* Cc = Bc + 128;
    __syncthreads();
    if (tid < 320) {
        const int c = tid < 64 ? h * 64 + tid : (tid < 192 ? 512 + g * 128 + (tid - 64) : 768 + g * 128 + (tid - 192));
        const float s0 = sconv[((size_t)seq * 3 + 0) * 1024 + c], s1 = sconv[((size_t)seq * 3 + 1) * 1024 + c], s2 = sconv[((size_t)seq * 3 + 2) * 1024 + c], xn = IN[(size_t)seq * NES + 2048 + c];
        const float cv = convb[c] + convw[c] * s0 + convw[1024 + c] * s1 + convw[2048 + c] * s2 + convw[3072 + c] * xn;
        xc[tid] = silu_f(cv);
    } else if (tid >= 384) {
        const int c = h * 128 + (tid - 384);
        conv_out[((size_t)seq * 3 + 0) * 1024 + c] = sconv[((size_t)seq * 3 + 1) * 1024 + c];
        conv_out[((size_t)seq * 3 + 1) * 1024 + c] = sconv[((size_t)seq * 3 + 2) * 1024 + c];
        conv_out[((size_t)seq * 3 + 2) * 1024 + c] = IN[(size_t)seq * NES + 2048 + c];
    }
    __syncthreads();
    const float dt = softplus_f(IN[(size_t)seq * NES + 3072 + h] + dtb[h]); const float a = -__expf(alog[h]); const float dA = __expf(dt * a);
    const int p = tid >> 3, ng = tid & 7;
    const float dtx = dt * xc[p];
    const size_t so = (((size_t)seq * 8 + h) * 64 + p) * 128 + ng * 16;
    float y = 0.f;
#pragma unroll
    for (int j = 0; j < 4; ++j) {
        f32x4 s = __builtin_nontemporal_load((const f32x4*)(sssm + so + j * 4));
        const f32x4 b = *(const f32x4*)(Bc + ng * 16 + j * 4), c = *(const f32x4*)(Cc + ng * 16 + j * 4);
        s = s * dA + b * dtx;
        __builtin_nontemporal_store(s, (f32x4*)(ssm_out + so + j * 4));
        y += (s.x * c.x + s.y * c.y) + (s.z * c.z + s.w * c.w);
    }
    y += __shfl_xor(y, 1); y += __shfl_xor(y, 2); y += __shfl_xor(y, 4);
    if (ng == 0) { const float z = IN[(size_t)seq * NES + 1536 + h * 64 + p]; YG[(size_t)seq * 512 + h * 64 + p] = (y + dskip[h] * xc[p]) * silu_f(z); }
    __syncthreads();
}
typedef float f32x16 __attribute__((ext_vector_type(16)));
constexpr int AT_KSTR = 144, AT_VSTR = 192, AT_VOFF = 64 * AT_KSTR, AT_SLOT = AT_VOFF + 64 * AT_VSTR;
__device__ __forceinline__ unsigned cvtpk(float lo, float hi) { return pg8::cvt_pk_bf16(lo, hi); }
__device__ __forceinline__ void attn_unit_mfma(unsigned char* lds, const bf16* QKV, const float* sb_bias, bf16* MIX, int b, int h, int qb) {
    const int tid = threadIdx.x, lane = tid & 63, wid = __builtin_amdgcn_readfirstlane(tid >> 6), r32 = lane & 31, hi = lane >> 5;
    const int q0 = qb * 256, tw0 = q0 + wid * 32;
    const bf16* base = QKV + (size_t)b * T * NE;
    const LAS unsigned char* L3 = (const LAS unsigned char*)lds;
    bf16x8 qf[4];
#pragma unroll
    for (int ks = 0; ks < 4; ++ks) qf[ks] = *(const bf16x8*)(base + (size_t)(tw0 + r32) * NE + h * 64 + 16 * ks + 8 * hi);
    bf16x8 tri[2];
#pragma unroll
    for (int ks = 0; ks < 2; ++ks)
#pragma unroll
        for (int j = 0; j < 8; ++j) { const int kap = 16 * ks + 8 * (j >> 2) + 4 * hi + (j & 3); tri[ks][j] = (kap >= r32) ? (short)0x3F80 : (short)0; }
    const float bias2 = sb_bias[h] * LOG2E;
    f32x16 o0, o1, biasv;
#pragma unroll
    for (int i = 0; i < 16; ++i) { o0[i] = 0.f; o1[i] = 0.f; biasv[i] = bias2; }
    float runoff = 0.f;
    const int srow = tid >> 3, sch = tid & 7;
    const int itop = qb * 4 + 3;
    v4u kreg = *(const v4u*)(base + (size_t)(64 * itop + srow) * NE + 512 + h * 64 + sch * 8);
    v4u vreg = *(const v4u*)(base + (size_t)(64 * itop + srow) * NE + 1024 + h * 64 + sch * 8);
    __syncthreads();
    *(v4u*)(lds + srow * AT_KSTR + sch * 16) = kreg; *(v4u*)(lds + AT_VOFF + srow * AT_VSTR + sch * 16) = vreg;
    __syncthreads();
    const int trq = (lane & 15) >> 2, trp = lane & 3, trg = (lane >> 4) & 1;
    const int troff = (4 * hi + trq) * AT_VSTR + (16 * trg + 4 * trp) * 2;
    int sl = 0;
    for (int i = itop; i >= 0; --i, sl ^= 1) {
        if (i > 0) {
            kreg = *(const v4u*)(base + (size_t)(64 * (i - 1) + srow) * NE + 512 + h * 64 + sch * 8);
            vreg = *(const v4u*)(base + (size_t)(64 * (i - 1) + srow) * NE + 1024 + h * 64 + sch * 8);
        }
        const int sbase = sl * AT_SLOT;
        if (64 * i + 64 <= tw0) {
            bf16x8 kfa[4], kfb[4];
#pragma unroll
            for (int ks = 0; ks < 4; ++ks) { kfa[ks] = *(const LAS bf16x8*)(L3 + sbase + (32 + r32) * AT_KSTR + (16 * ks + 8 * hi) * 2); kfb[ks] = *(const LAS bf16x8*)(L3 + sbase + r32 * AT_KSTR + (16 * ks + 8 * hi) * 2); }
            f32x16 za = biasv, zb = biasv;
#pragma unroll
            for (int ks = 0; ks < 4; ++ks) { za = __builtin_amdgcn_mfma_f32_32x32x16_bf16(kfa[ks], qf[ks], za, 0, 0, 0); zb = __builtin_amdgcn_mfma_f32_32x32x16_bf16(kfb[ks], qf[ks], zb, 0, 0, 0); }
            const LAS unsigned char* vba = L3 + sbase + AT_VOFF + 32 * AT_VSTR + troff; const LAS unsigned char* vbb = L3 + sbase + AT_VOFF + troff;
            v4i16_t vra[2][2][2], vrb[2][2][2];
#pragma unroll
            for (int mb = 0; mb < 2; ++mb)
#pragma unroll
                for (int ks = 0; ks < 2; ++ks) {
                    vra[mb][ks][0] = __builtin_amdgcn_ds_read_tr16_b64_v4i16((LAS v4i16_t*)(vba + (16 * ks) * AT_VSTR + 64 * mb)); vra[mb][ks][1] = __builtin_amdgcn_ds_read_tr16_b64_v4i16((LAS v4i16_t*)(vba + (16 * ks + 8) * AT_VSTR + 64 * mb));
                    vrb[mb][ks][0] = __builtin_amdgcn_ds_read_tr16_b64_v4i16((LAS v4i16_t*)(vbb + (16 * ks) * AT_VSTR + 64 * mb)); vrb[mb][ks][1] = __builtin_amdgcn_ds_read_tr16_b64_v4i16((LAS v4i16_t*)(vbb + (16 * ks + 8) * AT_VSTR + 64 * mb));
                }
            u32x4 la0, la1, lb0, lb1;
            {
                float La[16], Lb[16];
#pragma unroll
                for (int r = 0; r < 16; ++r) { La[r] = -__builtin_amdgcn_logf(1.0f + __builtin_amdgcn_exp2f(fminf(za[r], 126.0f))); Lb[r] = -__builtin_amdgcn_logf(1.0f + __builtin_amdgcn_exp2f(fminf(zb[r], 126.0f))); }
                la0.x = cvtpk(La[0], La[1]); la0.y = cvtpk(La[2], La[3]); la0.z = cvtpk(La[4], La[5]); la0.w = cvtpk(La[6], La[7]);
                la1.x = cvtpk(La[8], La[9]); la1.y = cvtpk(La[10], La[11]); la1.z = cvtpk(La[12], La[13]); la1.w = cvtpk(La[14], La[15]);
                lb0.x = cvtpk(Lb[0], Lb[1]); lb0.y = cvtpk(Lb[2], Lb[3]); lb0.z = cvtpk(Lb[4], Lb[5]); lb0.w = cvtpk(Lb[6], Lb[7]);
                lb1.x = cvtpk(Lb[8], Lb[9]); lb1.y = cvtpk(Lb[10], Lb[11]); lb1.z = cvtpk(Lb[12], Lb[13]); lb1.w = cvtpk(Lb[14], Lb[15]);
            }
            const float za0 = za[0], zb0 = zb[0];
            f32x16 ya = __builtin_amdgcn_mfma_f32_32x32x16_bf16(tri[0], __builtin_bit_cast(bf16x8, la0), za, 0, 0, 0);
            f32x16 yb = __builtin_amdgcn_mfma_f32_32x32x16_bf16(tri[0], __builtin_bit_cast(bf16x8, lb0), zb, 0, 0, 0);
            ya = __builtin_amdgcn_mfma_f32_32x32x16_bf16(tri[1], __builtin_bit_cast(bf16x8, la1), ya, 0, 0, 0);
            yb = __builtin_amdgcn_mfma_f32_32x32x16_bf16(tri[1], __builtin_bit_cast(bf16x8, lb1), yb, 0, 0, 0);
            const float tota = __shfl(ya[0] - za0, r32), totb = __shfl(yb[0] - zb0, r32);
            const float roa = runoff, rob = runoff + tota;
            runoff = rob + totb;
            u32x4 wa0, wa1, wb0, wb1;
            {
                float Wa[16], Wb[16];
#pragma unroll
                for (int r = 0; r < 16; ++r) { Wa[r] = __builtin_amdgcn_exp2f(ya[r] + roa); Wb[r] = __builtin_amdgcn_exp2f(yb[r] + rob); }
                wa0.x = cvtpk(Wa[0], Wa[1]); wa0.y = cvtpk(Wa[2], Wa[3]); wa0.z = cvtpk(Wa[4], Wa[5]); wa0.w = cvtpk(Wa[6], Wa[7]);
                wa1.x = cvtpk(Wa[8], Wa[9]); wa1.y = cvtpk(Wa[10], Wa[11]); wa1.z = cvtpk(Wa[12], Wa[13]); wa1.w = cvtpk(Wa[14], Wa[15]);
                wb0.x = cvtpk(Wb[0], Wb[1]); wb0.y = cvtpk(Wb[2], Wb[3]); wb0.z = cvtpk(Wb[4], Wb[5]); wb0.w = cvtpk(Wb[6], Wb[7]);
                wb1.x = cvtpk(Wb[8], Wb[9]); wb1.y = cvtpk(Wb[10], Wb[11]); wb1.z = cvtpk(Wb[12], Wb[13]); wb1.w = cvtpk(Wb[14], Wb[15]);
            }
#define AT_VF(V_, mb_, ks_) ((bf16x8){V_[mb_][ks_][0][0], V_[mb_][ks_][0][1], V_[mb_][ks_][0][2], V_[mb_][ks_][0][3], V_[mb_][ks_][1][0], V_[mb_][ks_][1][1], V_[mb_][ks_][1][2], V_[mb_][ks_][1][3]})
            o0 = __builtin_amdgcn_mfma_f32_32x32x16_bf16(AT_VF(vra, 0, 0), __builtin_bit_cast(bf16x8, wa0), o0, 0, 0, 0);
            o1 = __builtin_amdgcn_mfma_f32_32x32x16_bf16(AT_VF(vra, 1, 0), __builtin_bit_cast(bf16x8, wa0), o1, 0, 0, 0);
            o0 = __builtin_amdgcn_mfma_f32_32x32x16_bf16(AT_VF(vra, 0, 1), __builtin_bit_cast(bf16x8, wa1), o0, 0, 0, 0);
            o1 = __builtin_amdgcn_mfma_f32_32x32x16_bf16(AT_VF(vra, 1, 1), __builtin_bit_cast(bf16x8, wa1), o1, 0, 0, 0);
            o0 = __builtin_amdgcn_mfma_f32_32x32x16_bf16(AT_VF(vrb, 0, 0), __builtin_bit_cast(bf16x8, wb0), o0, 0, 0, 0);
            o1 = __builtin_amdgcn_mfma_f32_32x32x16_bf16(AT_VF(vrb, 1, 0), __builtin_bit_cast(bf16x8, wb0), o1, 0, 0, 0);
            o0 = __builtin_amdgcn_mfma_f32_32x32x16_bf16(AT_VF(vrb, 0, 1), __builtin_bit_cast(bf16x8, wb1), o0, 0, 0, 0);
            o1 = __builtin_amdgcn_mfma_f32_32x32x16_bf16(AT_VF(vrb, 1, 1), __builtin_bit_cast(bf16x8, wb1), o1, 0, 0, 0);
#undef AT_VF
        } else
#pragma unroll
        for (int sub = 1; sub >= 0; --sub) {
            const int kb = 64 * i + 32 * sub;
            if (kb <= tw0) {
                const bool diag = (kb == tw0);
                bf16x8 kf[4];
#pragma unroll
                for (int ks = 0; ks < 4; ++ks) kf[ks] = *(const LAS bf16x8*)(L3 + sbase + (sub * 32 + r32) * AT_KSTR + (16 * ks + 8 * hi) * 2);
                const LAS unsigned char* vb = L3 + sbase + AT_VOFF + sub * 32 * AT_VSTR + troff;
                v4i16_t vr[2][2][2];
#pragma unroll
                for (int mb = 0; mb < 2; ++mb)
#pragma unroll
                    for (int ks = 0; ks < 2; ++ks) {
                        vr[mb][ks][0] = __builtin_amdgcn_ds_read_tr16_b64_v4i16((LAS v4i16_t*)(vb + (16 * ks) * AT_VSTR + 64 * mb));
                        vr[mb][ks][1] = __builtin_amdgcn_ds_read_tr16_b64_v4i16((LAS v4i16_t*)(vb + (16 * ks + 8) * AT_VSTR + 64 * mb));
                    }
                asm volatile("" ::: "memory"); __builtin_amdgcn_sched_barrier(0);
                f32x16 z = biasv;
#pragma unroll
                for (int ks = 0; ks < 4; ++ks) z = __builtin_amdgcn_mfma_f32_32x32x16_bf16(kf[ks], qf[ks], z, 0, 0, 0);
                float Lv[16];
#pragma unroll
                for (int r = 0; r < 16; ++r) {
                    const float p2 = __builtin_amdgcn_exp2f(fminf(z[r], 126.0f));
                    float L = -__builtin_amdgcn_logf(1.0f + p2);
                    if (diag) { const int krow = (r & 3) + 8 * (r >> 2) + 4 * hi; if (!(krow < r32)) L = 0.f; }
                    Lv[r] = L;
                }
                u32x4 lp0, lp1;
                lp0.x = cvtpk(Lv[0], Lv[1]); lp0.y = cvtpk(Lv[2], Lv[3]); lp0.z = cvtpk(Lv[4], Lv[5]); lp0.w = cvtpk(Lv[6], Lv[7]);
                lp1.x = cvtpk(Lv[8], Lv[9]); lp1.y = cvtpk(Lv[10], Lv[11]); lp1.z = cvtpk(Lv[12], Lv[13]); lp1.w = cvtpk(Lv[14], Lv[15]);
                const float z0 = z[0];
                f32x16 y = __builtin_amdgcn_mfma_f32_32x32x16_bf16(tri[0], __builtin_bit_cast(bf16x8, lp0), z, 0, 0, 0);
                y = __builtin_amdgcn_mfma_f32_32x32x16_bf16(tri[1], __builtin_bit_cast(bf16x8, lp1), y, 0, 0, 0);
                const float tot = __shfl(y[0] - z0, r32);
                float Wv[16];
#pragma unroll
                for (int r = 0; r < 16; ++r) {
                    float w = __builtin_amdgcn_exp2f(y[r] + runoff);
                    if (diag) { const int krow = (r & 3) + 8 * (r >> 2) + 4 * hi; if (!(krow < r32)) w = 0.f; }
                    Wv[r] = w;
                }
                runoff += tot;
                u32x4 wp0, wp1;
                wp0.x = cvtpk(Wv[0], Wv[1]); wp0.y = cvtpk(Wv[2], Wv[3]); wp0.z = cvtpk(Wv[4], Wv[5]); wp0.w = cvtpk(Wv[6], Wv[7]);
                wp1.x = cvtpk(Wv[8], Wv[9]); wp1.y = cvtpk(Wv[10], Wv[11]); wp1.z = cvtpk(Wv[12], Wv[13]); wp1.w = cvtpk(Wv[14], Wv[15]);
                const bf16x8 wf0 = __builtin_bit_cast(bf16x8, wp0), wf1 = __builtin_bit_cast(bf16x8, wp1);
#pragma unroll
                for (int mb = 0; mb < 2; ++mb) {
#pragma unroll
                    for (int ks = 0; ks < 2; ++ks) {
                        const v4i16_t a0 = vr[mb][ks][0];
                        const v4i16_t a1 = vr[mb][ks][1];
                        const bf16x8 vf = (bf16x8){a0[0], a0[1], a0[2], a0[3], a1[0], a1[1], a1[2], a1[3]};
                        if (mb == 0) o0 = __builtin_amdgcn_mfma_f32_32x32x16_bf16(vf, ks == 0 ? wf0 : wf1, o0, 0, 0, 0);
                        else o1 = __builtin_amdgcn_mfma_f32_32x32x16_bf16(vf, ks == 0 ? wf0 : wf1, o1, 0, 0, 0);
                    }
                }
            }
        }
        if (i > 0) { *(v4u*)(lds + (sl ^ 1) * AT_SLOT + srow * AT_KSTR + sch * 16) = kreg; *(v4u*)(lds + (sl ^ 1) * AT_SLOT + AT_VOFF + srow * AT_VSTR + sch * 16) = vreg; }
        __syncthreads();
    }
    bf16* orow = MIX + ((size_t)b * T + tw0 + r32) * 1024 + 512 + h * 64;
#pragma unroll
    for (int g4 = 0; g4 < 4; ++g4) {
        u32x2v w0; w0.x = cvtpk(o0[4 * g4], o0[4 * g4 + 1]); w0.y = cvtpk(o0[4 * g4 + 2], o0[4 * g4 + 3]);
        u32x2v w1; w1.x = cvtpk(o1[4 * g4], o1[4 * g4 + 1]); w1.y = cvtpk(o1[4 * g4 + 2], o1[4 * g4 + 3]);
        *(u32x2v*)(orow + 8 * g4 + 4 * hi) = w0; *(u32x2v*)(orow + 32 + 8 * g4 + 4 * hi) = w1;
    }
}

__device__ __forceinline__ int off128(int row, int ch) { return 256 * row + 16 * (ch ^ (((row & 3) << 2) | ((row >> 2) & 3))); }
__device__ __forceinline__ bf16x8 ldsrow128(const LAS unsigned char* tile, int row, int ch) { return *(const LAS bf16x8*)(tile + off128(row, ch)); }
__device__ __forceinline__ bf16x8 trfrag128(const LAS unsigned char* tile, int r0a, int r0b, int colbase, int lane) {
    const int q = (lane & 15) >> 2, p = lane & 3, c0 = (colbase >> 3) + 2 * ((lane >> 4) & 1) + (p >> 1), hb = 8 * (p & 1);
    const v4i16_t a0 = __builtin_amdgcn_ds_read_tr16_b64_v4i16((LAS v4i16_t*)(tile + off128(r0a + q, c0) + hb));
    const v4i16_t a1 = __builtin_amdgcn_ds_read_tr16_b64_v4i16((LAS v4i16_t*)(tile + off128(r0b + q, c0) + hb));
    return (bf16x8){a0[0], a0[1], a0[2], a0[3], a1[0], a1[1], a1[2], a1[3]};
}
constexpr int X64_STR = 192;
__device__ __forceinline__ bf16x8 trfrag64(const LAS unsigned char* tile, int r0a, int r0b, int colbase, int lane) {
    const int q = (lane & 15) >> 2, p = lane & 3, cb = (colbase + 16 * ((lane >> 4) & 1) + 4 * p) * 2;
    const v4i16_t a0 = __builtin_amdgcn_ds_read_tr16_b64_v4i16((LAS v4i16_t*)(tile + (r0a + q) * X64_STR + cb));
    const v4i16_t a1 = __builtin_amdgcn_ds_read_tr16_b64_v4i16((LAS v4i16_t*)(tile + (r0b + q) * X64_STR + cb));
    return (bf16x8){a0[0], a0[1], a0[2], a0[3], a1[0], a1[1], a1[2], a1[3]};
}
__device__ __forceinline__ int krow16(int r, int hi) { return (r & 3) + 8 * (r >> 2) + 4 * hi; }

__device__ __forceinline__ void conv_prepass(const bf16* QKV, const float* convw, const float* convb, bf16* XC, int bid) {
    const int tid = threadIdx.x, c0 = 2 * tid;
    float w0[4], w1[4];
#pragma unroll
    for (int j = 0; j < 4; ++j) { w0[j] = convw[j * 1024 + c0]; w1[j] = convw[j * 1024 + c0 + 1]; }
    const float b0 = convb[c0], b1 = convb[c0 + 1];
    const int t0 = (bid & 31) * 64; const size_t rowb = (size_t)(bid >> 5) * T;
    const unsigned* src = (const unsigned*)(QKV + (rowb + t0) * NE + 2048 + c0);
    unsigned* dst = (unsigned*)(XC + (rowb + t0) * 1024 + c0);
    float xa[3], xb[3];
#pragma unroll
    for (int j = 0; j < 3; ++j) { unsigned u = 0u; if (t0 > 0) u = src[(long)(j - 3) * (NE / 2)]; xa[j] = bflo(u); xb[j] = bfhi(u); }
    for (int i0 = 0; i0 < 64; i0 += 16) {
        unsigned u[16];
#pragma unroll
        for (int i = 0; i < 16; ++i) u[i] = __builtin_nontemporal_load(src + (long)(i0 + i) * (NE / 2));
#pragma unroll
        for (int i = 0; i < 16; ++i) {
            const float a = bflo(u[i]), b = bfhi(u[i]);
            const float ca = b0 + w0[0] * xa[0] + w0[1] * xa[1] + w0[2] * xa[2] + w0[3] * a;
            const float cb = b1 + w1[0] * xb[0] + w1[1] * xb[1] + w1[2] * xb[2] + w1[3] * b;
            dst[(long)(i0 + i) * 512] = cvtpk(silu_fast(ca), silu_fast(cb));
            xa[0] = xa[1]; xa[1] = xa[2]; xa[2] = a; xb[0] = xb[1]; xb[1] = xb[2]; xb[2] = b;
        }
    }
}

template <int STR> __device__ __forceinline__ bf16x8 trfragS(const LAS unsigned char* tile, int r0a, int r0b, int colbase, int lane) {
    const int q = (lane & 15) >> 2, p = lane & 3, cb = (colbase + 16 * ((lane >> 4) & 1) + 4 * p) * 2;
    const v4i16_t a0 = __builtin_amdgcn_ds_read_tr16_b64_v4i16((LAS v4i16_t*)(tile + (r0a + q) * STR + cb));
    const v4i16_t a1 = __builtin_amdgcn_ds_read_tr16_b64_v4i16((LAS v4i16_t*)(tile + (r0b + q) * STR + cb));
    return (bf16x8){a0[0], a0[1], a0[2], a0[3], a1[0], a1[1], a1[2], a1[3]};
}
constexpr int SL_STR = 80;
constexpr int S2_XS = 0, S2_XW = S2_XS + 64 * SL_STR, S2_ZS = S2_XW + 64 * SL_STR, S2_BC = S2_ZS + 64 * SL_STR, S2_CC = S2_BC + 64 * 256, S2_BUF = S2_CC + 64 * 256;
constexpr int S2_HI = 2 * S2_BUF, S2_TAB = S2_HI + 2 * 32 * 256, S2_END = S2_TAB + 2 * 2048 * 4;
static_assert(S2_END <= 131072, "SSD LDS map");
__device__ __forceinline__ void ssd_unit2(unsigned char* lds, const bf16* XC, const bf16* QKV, const float* DTRAW, const float* dtb, const float* alog, const float* dskip,
                                          bf16* MIX, float* SSM, float* ssm_out, int b, int h, int pb) {
    const int tid = threadIdx.x, lane = tid & 63, wid = __builtin_amdgcn_readfirstlane(tid >> 6), r32 = lane & 31, hi = lane >> 5; const int g = h >> 2;
    const LAS unsigned char* L3 = (const LAS unsigned char*)lds;
    const float a2 = -__expf(alog[h]) * LOG2E, dtbias = dtb[h], dsk = dskip[h];
    const size_t rowb = (size_t)b * T;
    float* dtT = (float*)(lds + S2_TAB); float* cumT = dtT + 2048;
    f32x16 hacc;
#pragma unroll
    for (int i = 0; i < 16; ++i) hacc[i] = 0.f;
    const int srow = tid >> 3, sch = tid & 7;
    const int t2 = tid & 255, lrow = t2 >> 2, lch = t2 & 3; const bool ldx = tid < 256;
    __syncthreads();
    float dtr[4];
#pragma unroll
    for (int q = 0; q < 4; ++q) dtr[q] = DTRAW[(rowb + (wid + 8 * q) * 64 + lane) * 8 + h];
#pragma unroll
    for (int q = 0; q < 4; ++q) { const int cc = wid + 8 * q;
        const float dt = softplus_f(dtr[q] + dtbias); float cs = dt * a2;
#pragma unroll
        for (int o = 1; o < 64; o <<= 1) { const float t = __shfl_up(cs, o); if (lane >= o) cs += t; }
        dtT[cc * 64 + lane] = dt; cumT[cc * 64 + lane] = cs;
    }
    *(v4u*)(lds + S2_HI + tid * 16) = (v4u){0u, 0u, 0u, 0u};
    v4u rs_, rb0, rb1, rc0, rc1;
#define S2_LOAD(c_) do { const size_t rn_ = rowb + (size_t)(c_) * 64; \
        rs_ = ldx ? *(const v4u*)(XC + (rn_ + lrow) * 1024 + h * 64 + pb * 32 + lch * 8) : *(const v4u*)(QKV + (rn_ + lrow) * NE + 1536 + h * 64 + pb * 32 + lch * 8); \
        rb0 = *(const v4u*)(XC + (rn_ + srow) * 1024 + 512 + g * 128 + sch * 8); rb1 = *(const v4u*)(XC + (rn_ + srow) * 1024 + 512 + g * 128 + 64 + sch * 8); \
        rc0 = *(const v4u*)(XC + (rn_ + srow) * 1024 + 768 + g * 128 + sch * 8); rc1 = *(const v4u*)(XC + (rn_ + srow) * 1024 + 768 + g * 128 + 64 + sch * 8); } while (0)
#define S2_STORE(c_, buf_) do { unsigned char* B_ = lds + (buf_) * S2_BUF; \
        if (ldx) { const float wst = __builtin_amdgcn_exp2f(cumT[(c_) * 64 + 63] - cumT[(c_) * 64 + lrow]) * dtT[(c_) * 64 + lrow]; \
            *(v4u*)(B_ + S2_XS + lrow * SL_STR + lch * 16) = rs_; \
            v4u xw; xw.x = cvtpk(bflo(rs_.x) * wst, bfhi(rs_.x) * wst); xw.y = cvtpk(bflo(rs_.y) * wst, bfhi(rs_.y) * wst); xw.z = cvtpk(bflo(rs_.z) * wst, bfhi(rs_.z) * wst); xw.w = cvtpk(bflo(rs_.w) * wst, bfhi(rs_.w) * wst); \
            *(v4u*)(B_ + S2_XW + lrow * SL_STR + lch * 16) = xw; } \
        else *(v4u*)(B_ + S2_ZS + lrow * SL_STR + lch * 16) = rs_; \
        *(v4u*)(B_ + S2_BC + off128(srow, sch)) = rb0; *(v4u*)(B_ + S2_BC + off128(srow, 8 + sch)) = rb1; \
        *(v4u*)(B_ + S2_CC + off128(srow, sch)) = rc0; *(v4u*)(B_ + S2_CC + off128(srow, 8 + sch)) = rc1; } while (0)
    S2_LOAD(0);
    __syncthreads();
    S2_STORE(0, 0);
    __syncthreads();
    for (int c = 0; c < T / 64; ++c) {
        const int cur = c & 1; const size_t row0 = rowb + (size_t)c * 64;
        const LAS unsigned char* Bf = L3 + cur * S2_BUF;
        const LAS unsigned char* HIc = L3 + S2_HI + cur * 8192;
        if (c + 1 < T / 64) S2_LOAD(c + 1);
        if (wid < 2) {
            const int tbk = wid;
            bf16x8 cf[8], af[8];
#pragma unroll
            for (int ks = 0; ks < 8; ++ks) cf[ks] = ldsrow128(Bf + S2_CC, tbk * 32 + r32, 2 * ks + hi);
            const float cumt = cumT[c * 64 + tbk * 32 + r32];
            f32x16 y;
#pragma unroll
            for (int i = 0; i < 16; ++i) y[i] = 0.f;
#pragma unroll
            for (int ks = 0; ks < 8; ++ks) af[ks] = ldsrow128(HIc, r32, 2 * ks + hi);
            asm volatile("" ::: "memory"); __builtin_amdgcn_sched_barrier(0);
#pragma unroll
            for (int ks = 0; ks < 8; ++ks) y = __builtin_amdgcn_mfma_f32_32x32x16_bf16(af[ks], cf[ks], y, 0, 0, 0);
            { const float e = __builtin_amdgcn_exp2f(cumt);
#pragma unroll
              for (int i = 0; i < 16; ++i) y[i] *= e; }
#pragma unroll
            for (int sb = 0; sb < 2; ++sb) {
                if (sb <= tbk) {
                    f32x16 s;
#pragma unroll
                    for (int i = 0; i < 16; ++i) s[i] = 0.f;
#pragma unroll
                    for (int ks = 0; ks < 8; ++ks) af[ks] = ldsrow128(Bf + S2_BC, sb * 32 + r32, 2 * ks + hi);
                    const bf16x8 xt0 = trfragS<SL_STR>(Bf + S2_XS, sb * 32 + 4 * hi, sb * 32 + 8 + 4 * hi, 0, lane), xt1 = trfragS<SL_STR>(Bf + S2_XS, sb * 32 + 16 + 4 * hi, sb * 32 + 24 + 4 * hi, 0, lane);
                    asm volatile("" ::: "memory"); __builtin_amdgcn_sched_barrier(0);
#pragma unroll
                    for (int ks = 0; ks < 8; ++ks) s = __builtin_amdgcn_mfma_f32_32x32x16_bf16(af[ks], cf[ks], s, 0, 0, 0);
                    float pv[16];
#pragma unroll
                    for (int q4 = 0; q4 < 4; ++q4) {
                        const f32x4 cs = *(const f32x4*)(cumT + c * 64 + sb * 32 + 8 * q4 + 4 * hi), ds = *(const f32x4*)(dtT + c * 64 + sb * 32 + 8 * q4 + 4 * hi);
#pragma unroll
                        for (int e = 0; e < 4; ++e) {
                            const int r = 4 * q4 + e; const int kr = 8 * q4 + 4 * hi + e;
                            float v = s[r] * __builtin_amdgcn_exp2f(fminf(cumt - cs[e], 0.f)) * ds[e];
                            if (sb == tbk && kr > r32) v = 0.f;
                            pv[r] = v;
                        }
                    }
                    u32x4 p0, p1;
                    p0.x = cvtpk(pv[0], pv[1]); p0.y = cvtpk(pv[2], pv[3]); p0.z = cvtpk(pv[4], pv[5]); p0.w = cvtpk(pv[6], pv[7]);
                    p1.x = cvtpk(pv[8], pv[9]); p1.y = cvtpk(pv[10], pv[11]); p1.z = cvtpk(pv[12], pv[13]); p1.w = cvtpk(pv[14], pv[15]);
                    y = __builtin_amdgcn_mfma_f32_32x32x16_bf16(xt0, __builtin_bit_cast(bf16x8, p0), y, 0, 0, 0);
                    y = __builtin_amdgcn_mfma_f32_32x32x16_bf16(xt1, __builtin_bit_cast(bf16x8, p1), y, 0, 0, 0);
                }
            }
            const int tl = tbk * 32 + r32; const size_t row = row0 + tl; float sq = 0.f;
#pragma unroll
            for (int q4 = 0; q4 < 4; ++q4) {
                const int p0 = 8 * q4 + 4 * hi;
                const u32x2v xr = *(const LAS u32x2v*)(Bf + S2_XS + tl * SL_STR + p0 * 2);
                const u32x2v zr = *(const LAS u32x2v*)(Bf + S2_ZS + tl * SL_STR + p0 * 2);
                const float o0 = (y[4 * q4 + 0] + dsk * bflo(xr.x)) * silu_fast(bflo(zr.x)), o1 = (y[4 * q4 + 1] + dsk * bfhi(xr.x)) * silu_fast(bfhi(zr.x));
                const float o2 = (y[4 * q4 + 2] + dsk * bflo(xr.y)) * silu_fast(bflo(zr.y)), o3 = (y[4 * q4 + 3] + dsk * bfhi(xr.y)) * silu_fast(bfhi(zr.y));
                u32x2v w; w.x = cvtpk(o0, o1); w.y = cvtpk(o2, o3);
                *(u32x2v*)(MIX + row * 1024 + h * 64 + pb * 32 + p0) = w;
                sq += (o0 * o0 + o1 * o1) + (o2 * o2 + o3 * o3);
            }
            sq += __shfl_xor(sq, 32);
            if (hi == 0) SSM[row * 32 + h * 2 + pb] = sq;
        } else if (wid < 6) {
            const int nb = wid - 2;
            const float e = __builtin_amdgcn_exp2f(cumT[c * 64 + 63]);
#pragma unroll
            for (int i = 0; i < 16; ++i) hacc[i] *= e;
            bf16x8 xa[4], bb[4];
#pragma unroll
            for (int ks = 0; ks < 4; ++ks) { xa[ks] = trfragS<SL_STR>(Bf + S2_XW, 16 * ks + 8 * hi, 16 * ks + 8 * hi + 4, 0, lane); bb[ks] = trfrag128(Bf + S2_BC, 16 * ks + 8 * hi, 16 * ks + 8 * hi + 4, nb * 32, lane); }
            asm volatile("" ::: "memory"); __builtin_amdgcn_sched_barrier(0);
#pragma unroll
            for (int ks = 0; ks < 4; ++ks) hacc = __builtin_amdgcn_mfma_f32_32x32x16_bf16(xa[ks], bb[ks], hacc, 0, 0, 0);
            unsigned char* HIn = lds + S2_HI + (cur ^ 1) * 8192; const int n = nb * 32 + r32;
#pragma unroll
            for (int r = 0; r < 16; r += 2) { const unsigned pkv = cvtpk(hacc[r], hacc[r + 1]); const int p = krow16(r, hi);
                *(bf16*)(HIn + off128(p, n >> 3) + (n & 7) * 2) = (bf16)(pkv & 0xffffu); *(bf16*)(HIn + off128(p + 1, n >> 3) + (n & 7) * 2) = (bf16)(pkv >> 16); }
        }
        if (c + 1 < T / 64) S2_STORE(c + 1, cur ^ 1);
        __syncthreads();
    }
#undef S2_LOAD
#undef S2_STORE
    if (wid >= 2 && wid < 6) {
        const int n = (wid - 2) * 32 + r32;
#pragma unroll
        for (int r = 0; r < 16; ++r) { const int p = pb * 32 + krow16(r, hi); ssm_out[(((size_t)b * 8 + h) * 64 + p) * 128 + n] = hacc[r]; }
    }
    __syncthreads();
}

__device__ __forceinline__ void hgrn_prepass(const bf16* IN2, const float* lbraw, bf16* QP, bf16* KP, float* DL, int bid) {
    const int tid = threadIdx.x, c0 = 2 * tid;
    const float lb0 = sigmoid_f(lbraw[1024 + c0] - lbraw[c0]), lb1 = sigmoid_f(lbraw[1024 + c0 + 1] - lbraw[c0 + 1]);
    const size_t row0 = (size_t)bid * 64;
    const unsigned* qs = (const unsigned*)(IN2 + row0 * 4096 + c0); const unsigned* fs = (const unsigned*)(IN2 + row0 * 4096 + 1024 + c0);
    unsigned* qd = (unsigned*)(QP + row0 * 1024 + c0); unsigned* kd = (unsigned*)(KP + row0 * 1024 + c0);
    float r0 = 0.f, r1 = 0.f;
    for (int i0 = 0; i0 < 64; i0 += 16) {
        unsigned uq[16], uf[16];
#pragma unroll
        for (int i = 0; i < 16; ++i) { uq[i] = __builtin_nontemporal_load(qs + (long)(i0 + i) * 2048); uf[i] = __builtin_nontemporal_load(fs + (long)(i0 + i) * 2048); }
#pragma unroll
        for (int i = 0; i < 16; ++i) {
            const float f0 = lb0 + (1.0f - lb0) * sigmoid_f(bflo(uf[i])), f1 = lb1 + (1.0f - lb1) * sigmoid_f(bfhi(uf[i]));
            r0 += __builtin_amdgcn_logf(f0); r1 += __builtin_amdgcn_logf(f1);
            const float e0 = __builtin_amdgcn_exp2f(r0), e1 = __builtin_amdgcn_exp2f(r1);
            const float i0v = __builtin_amdgcn_exp2f(fminf(-r0, 120.f)), i1v = __builtin_amdgcn_exp2f(fminf(-r1, 120.f));
            qd[(long)(i0 + i) * 512] = pk2(bflo(uq[i]) * e0, bfhi(uq[i]) * e1);
            kd[(long)(i0 + i) * 512] = pk2((1.0f - f0) * i0v, (1.0f - f1) * i1v);
        }
    }
    *(f32x2v*)(DL + (size_t)bid * 1024 + c0) = (f32x2v){__builtin_amdgcn_exp2f(r0), __builtin_amdgcn_exp2f(r1)};
}
constexpr int H2_QP = 0, H2_KP = H2_QP + 64 * 256, H2_VS = H2_KP + 64 * 256, H2_GS = H2_VS + 64 * SL_STR, H2_DL = H2_GS + 64 * SL_STR, H2_BUF = H2_DL + 512;
constexpr int H2_ST = 2 * H2_BUF, H2_END = H2_ST + 2 * 32 * 256;
static_assert(H2_END <= 131072, "HGRN LDS map");
__device__ __forceinline__ void hgrn_body(unsigned char* lds, const LAS unsigned char* Bf, const LAS unsigned char* STc, int cur, size_t row0, int h, int vq, int wid, int lane, int r32, int hi,
                                          f32x16& sacc, bf16* MIX, float* SSM) {
        if (wid < 2) {
            const int tbk = wid;
            bf16x8 qf[8], af[4];
#pragma unroll
            for (int ks = 0; ks < 8; ++ks) qf[ks] = ldsrow128(Bf + H2_QP, tbk * 32 + r32, 2 * ks + hi);
            f32x16 o;
#pragma unroll
            for (int i = 0; i < 16; ++i) o[i] = 0.f;
#pragma unroll
            for (int kh = 0; kh < 2; ++kh) {
#pragma unroll
                for (int ks = 0; ks < 4; ++ks) af[ks] = ldsrow128(STc, r32, 2 * (4 * kh + ks) + hi);
                asm volatile("" ::: "memory"); __builtin_amdgcn_sched_barrier(0);
#pragma unroll
                for (int ks = 0; ks < 4; ++ks) o = __builtin_amdgcn_mfma_f32_32x32x16_bf16(af[ks], qf[4 * kh + ks], o, 0, 0, 0);
            }
#pragma unroll
            for (int sb = 0; sb < 2; ++sb) {
                if (sb <= tbk) {
                    f32x16 s;
#pragma unroll
                    for (int i = 0; i < 16; ++i) s[i] = 0.f;
#pragma unroll
                    for (int kh = 0; kh < 2; ++kh) {
#pragma unroll
                        for (int ks = 0; ks < 4; ++ks) af[ks] = ldsrow128(Bf + H2_KP, sb * 32 + r32, 2 * (4 * kh + ks) + hi);
                        asm volatile("" ::: "memory"); __builtin_amdgcn_sched_barrier(0);
#pragma unroll
                        for (int ks = 0; ks < 4; ++ks) s = __builtin_amdgcn_mfma_f32_32x32x16_bf16(af[ks], qf[4 * kh + ks], s, 0, 0, 0);
                    }
                    const bf16x8 vt0 = trfragS<SL_STR>(Bf + H2_VS, sb * 32 + 4 * hi, sb * 32 + 8 + 4 * hi, 0, lane), vt1 = trfragS<SL_STR>(Bf + H2_VS, sb * 32 + 16 + 4 * hi, sb * 32 + 24 + 4 * hi, 0, lane);
                    if (sb == tbk) {
#pragma unroll
                        for (int r = 0; r < 16; ++r) if (krow16(r, hi) > r32) s[r] = 0.f;
                    }
                    u32x4 p0, p1;
                    p0.x = cvtpk(s[0], s[1]); p0.y = cvtpk(s[2], s[3]); p0.z = cvtpk(s[4], s[5]); p0.w = cvtpk(s[6], s[7]);
                    p1.x = cvtpk(s[8], s[9]); p1.y = cvtpk(s[10], s[11]); p1.z = cvtpk(s[12], s[13]); p1.w = cvtpk(s[14], s[15]);
                    o = __builtin_amdgcn_mfma_f32_32x32x16_bf16(vt0, __builtin_bit_cast(bf16x8, p0), o, 0, 0, 0);
                    o = __builtin_amdgcn_mfma_f32_32x32x16_bf16(vt1, __builtin_bit_cast(bf16x8, p1), o, 0, 0, 0);
                }
            }
            const int tl = tbk * 32 + r32; const size_t row = row0 + tl; float sq = 0.f;
#pragma unroll
            for (int q4 = 0; q4 < 4; ++q4) {
                const int v0 = 8 * q4 + 4 * hi;
                const u32x2v gr = *(const LAS u32x2v*)(Bf + H2_GS + tl * SL_STR + v0 * 2);
                const float o0 = o[4 * q4], o1 = o[4 * q4 + 1], o2 = o[4 * q4 + 2], o3 = o[4 * q4 + 3];
                u32x2v w; w.x = cvtpk(o0 * silu_fast(bflo(gr.x)), o1 * silu_fast(bfhi(gr.x))); w.y = cvtpk(o2 * silu_fast(bflo(gr.y)), o3 * silu_fast(bfhi(gr.y)));
                *(u32x2v*)(MIX + row * 1024 + h * 128 + vq * 32 + v0) = w;
                sq += (o0 * o0 + o1 * o1) + (o2 * o2 + o3 * o3);
            }
            sq += __shfl_xor(sq, 32);
            if (hi == 0) SSM[row * 32 + h * 4 + vq] = sq;
        } else if (wid < 6) {
            const int kb = wid - 2;
            bf16x8 ka[4], vb4[4];
#pragma unroll
            for (int ks = 0; ks < 4; ++ks) { ka[ks] = trfrag128(Bf + H2_KP, 16 * ks + 8 * hi, 16 * ks + 8 * hi + 4, kb * 32, lane); vb4[ks] = trfragS<SL_STR>(Bf + H2_VS, 16 * ks + 8 * hi, 16 * ks + 8 * hi + 4, 0, lane); }
            asm volatile("" ::: "memory"); __builtin_amdgcn_sched_barrier(0);
#pragma unroll
            for (int ks = 0; ks < 4; ++ks) sacc = __builtin_amdgcn_mfma_f32_32x32x16_bf16(ka[ks], vb4[ks], sacc, 0, 0, 0);
            unsigned char* STn = lds + H2_ST + (cur ^ 1) * 8192;
#pragma unroll
            for (int q4 = 0; q4 < 4; ++q4) {
                const f32x4 d = *(const LAS f32x4*)(Bf + H2_DL + (kb * 32 + 8 * q4 + 4 * hi) * 4);
#pragma unroll
                for (int e = 0; e < 4; ++e) sacc[4 * q4 + e] *= d[e];
                u32x2v w; w.x = cvtpk(sacc[4 * q4], sacc[4 * q4 + 1]); w.y = cvtpk(sacc[4 * q4 + 2], sacc[4 * q4 + 3]);
                *(u32x2v*)(STn + off128(r32, 4 * kb + q4) + 8 * hi) = w;
            }
        }
}
__device__ __forceinline__ void hgrn_unit2(unsigned char* lds, const bf16* QP, const bf16* KP, const float* DL, const bf16* IN2, bf16* MIX, float* SSM, float* hg_out, int b, int h, int vq) {
    const int tid = threadIdx.x, lane = tid & 63, wid = __builtin_amdgcn_readfirstlane(tid >> 6), r32 = lane & 31, hi = lane >> 5;
    const LAS unsigned char* L3 = (const LAS unsigned char*)lds;
    const size_t rowb = (size_t)b * T;
    f32x16 sacc;
#pragma unroll
    for (int i = 0; i < 16; ++i) sacc[i] = 0.f;
    const bool loader = tid >= 256; const int u = tid & 255;
    const int qrow = u >> 4, qch = u & 15, vrow = u >> 2, vch = u & 3;
    __syncthreads();
    *(v4u*)(lds + H2_ST + tid * 16) = (v4u){0u, 0u, 0u, 0u};
    v4u rq[4], rk[4], rv, rg; float rdl = 0.f;
#define H2_LOAD(c_) do { if (loader) { const size_t rn_ = rowb + (size_t)(c_) * 64; \
        _Pragma("unroll") for (int j = 0; j < 4; ++j) { rq[j] = *(const v4u*)(QP + (rn_ + qrow + 16 * j) * 1024 + h * 128 + qch * 8); rk[j] = *(const v4u*)(KP + (rn_ + qrow + 16 * j) * 1024 + h * 128 + qch * 8); } \
        rv = *(const v4u*)(IN2 + (rn_ + vrow) * 4096 + 2048 + h * 128 + vq * 32 + vch * 8); rg = *(const v4u*)(IN2 + (rn_ + vrow) * 4096 + 3072 + h * 128 + vq * 32 + vch * 8); \
        if (u < 128) rdl = DL[((size_t)b * 32 + (c_)) * 1024 + h * 128 + u]; } } while (0)
#define H2_STORE(buf_) do { if (loader) { unsigned char* B_ = lds + (buf_) * H2_BUF; \
        _Pragma("unroll") for (int j = 0; j < 4; ++j) { *(v4u*)(B_ + H2_QP + off128(qrow + 16 * j, qch)) = rq[j]; *(v4u*)(B_ + H2_KP + off128(qrow + 16 * j, qch)) = rk[j]; } \
        *(v4u*)(B_ + H2_VS + vrow * SL_STR + vch * 16) = rv; *(v4u*)(B_ + H2_GS + vrow * SL_STR + vch * 16) = rg; \
        if (u < 128) *(float*)(B_ + H2_DL + u * 4) = rdl; } } while (0)
    H2_LOAD(0);
    H2_STORE(0);
    __syncthreads();
    for (int c = 0; c < T / 64; ++c) {
        const int cur = c & 1;
        if (c + 1 < T / 64) H2_LOAD(c + 1);
        hgrn_body(lds, L3 + cur * H2_BUF, L3 + H2_ST + cur * 8192, cur, rowb + (size_t)c * 64, h, vq, wid, lane, r32, hi, sacc, MIX, SSM);
        if (c + 1 < T / 64) H2_STORE(cur ^ 1);
        __syncthreads();
    }
#undef H2_LOAD
#undef H2_STORE
    if (wid >= 2 && wid < 6) {
        const int kb = wid - 2;
#pragma unroll
        for (int r = 0; r < 16; ++r) { const int k = kb * 32 + krow16(r, hi); hg_out[(((size_t)b * 8 + h) * 128 + k) * 128 + vq * 32 + r32] = sacc[r]; }
    }
    __syncthreads();
}

__device__ __forceinline__ void hgrn_sample_unit(unsigned char* lds, const float* IN2  , const float* shg, const float* lbraw, float* hg_out, float* SO, int seq, int h) {
    const int tid = threadIdx.x;
    float* fT = (float*)lds; float* qT = fT + 128; float* red = qT + 128;
    __syncthreads();
    if (tid < 128) {
        const float lb = sigmoid_f(lbraw[1024 + h * 128 + tid] - lbraw[h * 128 + tid]);
        fT[tid] = lb + (1.0f - lb) * sigmoid_f(IN2[(size_t)seq * 4096 + 1024 + h * 128 + tid]);
        qT[tid] = IN2[(size_t)seq * 4096 + h * 128 + tid];
    }
    __syncthreads();
    const int v = tid & 127, kq = tid >> 7;
    const float vt = IN2[(size_t)seq * 4096 + 2048 + h * 128 + v]; float o = 0.f;
    for (int k0 = 0; k0 < 32; k0 += 16) {
        float sv[16];
#pragma unroll
        for (int kk = 0; kk < 16; ++kk) sv[kk] = __builtin_nontemporal_load(shg + (((size_t)seq * 8 + h) * 128 + kq * 32 + k0 + kk) * 128 + v);
#pragma unroll
        for (int kk = 0; kk < 16; ++kk) {
            const int k = kq * 32 + k0 + kk; const size_t off = (((size_t)seq * 8 + h) * 128 + k) * 128 + v;
            const float f = fT[k]; const float s = f * sv[kk] + (1.0f - f) * vt;
            __builtin_nontemporal_store(s, hg_out + off); o += s * qT[k];
        }
    }
    red[kq * 128 + v] = o;
    __syncthreads();
    if (tid < 128) SO[(size_t)seq * 1024 + h * 128 + tid] = (red[tid] + red[128 + tid]) + (red[256 + tid] + red[384 + tid]);
    __syncthreads();
}

__global__ void __launch_bounds__(NTHR, 2) mk_fwd(Args args) {
    extern __shared__ __attribute__((aligned(16))) unsigned char lds[];
    const int tid = threadIdx.x, lane = tid & 63, wave = __builtin_amdgcn_readfirstlane(tid >> 6);
    const int G = gridDim.x, bid = blockIdx.x;
    LAS unsigned char* ldsl = (LAS unsigned char*)lds;
    volatile LAS unsigned* MISC = (volatile LAS unsigned*)(ldsl + MISC_OFF);
    unsigned char* ws = args.ws;
    gu32* ctl = (gu32*)(ws + WS_CTL);
    for (int u = tid; u < (LDS_BYTES - RING_BYTES) / 4; u += NTHR) ((LAS unsigned*)(ldsl + RING_BYTES))[u] = 0u;
    __syncthreads();
    const int lo = args.ph_lo, hi = args.ph_hi;
    const bool multi = (hi - lo) > 1;
    XcdBarrier bar; bar.bar = (unsigned*)(ctl + CW_BAR); bar.x = 0; bar.st = nullptr;
    if (multi) bar = xcd_barrier_post((unsigned*)(ctl + CW_BAR), MISC + 8);
#ifndef REP_MASK
#define REP_MASK 0
#endif
#if defined(PROBE_A0)
#define PROBE_STAMP(k) do { if (bid == 0 && tid == 0) ((unsigned long long*)(ctl + CW_TS))[k] = __builtin_amdgcn_s_memrealtime(); } while (0)
#define PROBE_STAMP1(k) do { if (bid == 1 && tid == 0) ((unsigned long long*)(ctl + CW_TS))[k] = __builtin_amdgcn_s_memrealtime(); } while (0)
#else
#define PROBE_STAMP(k) do { } while (0)
#define PROBE_STAMP1(k) do { } while (0)
#endif
#define NREP(k) ((((REP_MASK) >> (k)) & 1) ? 2 : 1)
#ifdef ONLY_PH
#define IN(k) ((k) == ONLY_PH && lo <= (k) && (k) < hi)
#else
#define IN(k) (lo <= (k) && (k) < hi)
#endif
#define SEAM(k) do { if (IN(k) && IN((k) + 1)) xcd_barrier(bar); } while (0)
#define x_p ((const float*)args.in[I_XP])
#define x_s ((const float*)args.in[I_XS])
#define cache_k ((const float*)args.in[I_CK])
#define cache_v ((const float*)args.in[I_CV])
#define ptab ((const int*)args.in[I_PT])
#define s_conv ((const float*)args.in[I_SCONV])
#define s_ssm ((const float*)args.in[I_SSSM])
#define s_hg ((const float*)args.in[I_SHG])
#define n_mix ((const float*)args.in[I_NMIX])
#define n_ffn ((const float*)args.in[I_NFFN])
#define n_fin ((const float*)args.in[I_NFIN])
#define w_ine ((const float*)args.in[I_WINE])
#define sb_bias ((const float*)args.in[I_SBB])
#define conv_w ((const float*)args.in[I_CONVW])
#define conv_b ((const float*)args.in[I_CONVB])
#define dt_bias ((const float*)args.in[I_DTB])
#define a_log ((const float*)args.in[I_ALOG])
#define d_skip ((const float*)args.in[I_DSKIP])
#define ssd_norm ((const float*)args.in[I_SSDN])
#define w_oute ((const float*)args.in[I_WOUTE])
#define w_ino ((const float*)args.in[I_WINO])
#define lb_raw ((const float*)args.in[I_LBRAW])
#define hg_norm ((const float*)args.in[I_HGN])
#define w_outo ((const float*)args.in[I_WOUTO])
#define w_ff1 ((const float*)args.in[I_W1])
#define w_ff2 ((const float*)args.in[I_W2])
#define out (args.out)
#define WINE ((bf16*)(ws + WS_WINE))
#define WOUTE ((bf16*)(ws + WS_WOUTE))
#define WINO ((bf16*)(ws + WS_WINO))
#define WOUTO ((bf16*)(ws + WS_WOUTO))
#define W1T ((bf16*)(ws + WS_W1))
#define W2T ((bf16*)(ws + WS_W2))
#define HB ((bf16*)(ws + WS_HB))
#define H ((float*)(ws + WS_H))
#define SSQ ((float*)(ws + WS_SSQ))
#define DTRAW ((float*)(ws + WS_DTRAW))
#define SSM ((float*)(ws + WS_SSM))
#define MIX ((bf16*)(ws + WS_MIX))
#define QKV ((bf16*)(ws + WS_QKV))
#define HID ((bf16*)(ws + WS_HID))
#define S_H ((float*)(ws + WS_SMP + SM_H))
#define S_IN ((float*)(ws + WS_SMP + SM_IN))
#define S_HID ((float*)(ws + WS_SMP + SM_HID))
#define S_YG ((float*)(ws + WS_SMP + SM_YG))
#define S_OPART ((float*)(ws + WS_SMP + SM_OPART))
#define S_LPART ((float*)(ws + WS_SMP + SM_LPART))
#define S_O ((float*)(ws + WS_SMP + SM_O))

    LAS float* rstab = (LAS float*)(ldsl + RING_BYTES + 2048);
    LAS float* midtab = (LAS float*)(ldsl + RING_BYTES + 1024);
#define RSTAB_FILL(S_, SRC_, NP_, INV_) do {   \
        pg8::Unit u_[4]; bool has_[4]; _Pragma("unroll") for (int i_ = 0; i_ < 4; ++i_) has_[i_] = (S_).next(i_, u_[i_]); \
        if (tid < 256) { f32x4 pp_[4][NP_ / 4]; \
            _Pragma("unroll") for (int i_ = 0; i_ < 4; ++i_) if (has_[i_]) { _Pragma("unroll") for (int q_ = 0; q_ < NP_ / 4; ++q_) pp_[i_][q_] = ((const f32x4*)((SRC_) + (size_t)(u_[i_].pm * 256 + tid) * NP_))[q_]; } \
            _Pragma("unroll") for (int i_ = 0; i_ < 4; ++i_) if (has_[i_]) { float sm_ = 0.f; _Pragma("unroll") for (int q_ = 0; q_ < NP_ / 4; ++q_) sm_ += pg8::sum4(pp_[i_][q_]); \
                rstab[i_ * 256 + tid] = 1.0f / sqrtf(sm_ * (INV_) + RMS_EPS); } } \
        } while (0)
    PROBE_STAMP(0);
    if (IN(0)) for (int rep = 0; rep < NREP(0); ++rep) {
        LAS float* scr = (LAS float*)(ldsl + wave * 16384);
        const int gw = bid * NWAVES + wave, NGW = G * NWAVES;
        constexpr int I_INE = (D / 64) * (NES / 32), I_SQ = (D / 64) * (D / 32), I_4K = (D / 64) * (FF / 32), I_DN = (FF / 64) * (D / 32);
        constexpr int NITEMS = I_INE + I_SQ + I_4K + I_SQ + 2 * I_4K + 2 * I_DN;
        {
            constexpr int F_INE = 16 * 24, F_SQ = 16 * 8, F_4K = 16 * 32, F_DN = 64 * 8;
            constexpr int NHALF = 2 * (F_INE + F_SQ + F_4K + F_SQ + 2 * F_4K + 2 * F_DN);
#define P0W_DESC(idx_) ({ int r_ = (idx_) >> 1; const int hf_ = (idx_) & 1; P0W d_; int nbk_; \
            if (r_ < F_INE) { d_ = P0W{w_ine, WINE, n_mix, D, EVEN_IN, 0, 0, 0, 0}; nbk_ = 24; } \
            else if ((r_ -= F_INE) < F_SQ) { d_ = P0W{w_oute, WOUTE, ssd_norm, D, D, 512, 512, 0, 0}; nbk_ = 8; } \
            else if ((r_ -= F_SQ) < F_4K) { d_ = P0W{w_ino, WINO, n_mix + 1024, D, ODD_IN, 0, 0, 0, 0}; nbk_ = 32; } \
            else if ((r_ -= F_4K) < F_SQ) { d_ = P0W{w_outo, WOUTO, hg_norm, D, D, 0, 0, 0, 0}; nbk_ = 8; } \
            else if ((r_ -= F_SQ) < F_4K) { d_ = P0W{w_ff1, W1T, n_ffn, D, FF, 0, 0, 0, 0}; nbk_ = 32; } \
            else if ((r_ -= F_4K) < F_4K) { d_ = P0W{w_ff1 + (size_t)D * FF, W1T + (size_t)FF * D, n_ffn + 1024, D, FF, 0, 0, 0, 0}; nbk_ = 32; } \
            else if ((r_ -= F_4K) < F_DN) { d_ = P0W{w_ff2, W2T, nullptr, FF, D, 0, 0, 0, 0}; nbk_ = 8; } \
            else { r_ -= F_DN; d_ = P0W{w_ff2 + (size_t)FF * D, W2T + (size_t)D * FF, nullptr, FF, D, 0, 0, 0, 0}; nbk_ = 8; } \
            d_.kb32 = 2 * (r_ / nbk_) + hf_; d_.nb = r_ % nbk_; d_.late = 0; d_; })
            unsigned char* wscr = lds + wave * (32 * P0W_STR);
            f32x4 va[16], vb[16]; float sa = 1.f, sb = 1.f;
            int it = gw;
            P0W da = P0W_DESC(it < NHALF ? it : 0), db = da;
            if (it < NHALF) p0w_load(da, va, sa, lane);
            for (; it < NHALF; it += 2 * NGW) {
                const bool hb_ = it + NGW < NHALF;
                if (hb_) { db = P0W_DESC(it + NGW); p0w_load(db, vb, sb, lane); }
                p0w_store(da, va, sa, wscr, lane);
                const bool ha_ = it + 2 * NGW < NHALF;
                if (ha_) { da = P0W_DESC(it + 2 * NGW); p0w_load(da, va, sa, lane); }
                if (hb_) p0w_store(db, vb, sb, wscr, lane);
            }
#undef P0W_DESC
            if (bid < 2) { __syncthreads();     float vn_[32]; const P0Desc dn{w_ine, WINE, n_mix, D, EVEN_IN, NES, 0, 0, gw * (NES / 32) + 96}; p0_load(dn, vn_, lane); p0_store(dn, vn_, scr, lane); }
        }
        __syncthreads();
        float* wd = (float*)lds;
        for (int idx = tid; idx < 8192; idx += NTHR) { const int k = idx >> 3, c = idx & 7; wd[idx] = w_ine[(size_t)k * EVEN_IN + 3072 + c] * n_mix[k]; }
        __syncthreads();
        f32x4 vn[4];
        if (gw < M) {
#pragma unroll
            for (int j = 0; j < 4; ++j) vn[j] = __builtin_nontemporal_load((const f32x4*)(x_p + (size_t)gw * D) + lane + 64 * j);
        }
        for (int m = gw; m < M; m += NGW) {
            f32x4 v[4]; float s = 0.f; float d8[8];
#pragma unroll
            for (int c = 0; c < 8; ++c) d8[c] = 0.f;
#pragma unroll
            for (int j = 0; j < 4; ++j) v[j] = vn[j];
            if (m + NGW < M) {
#pragma unroll
                for (int j = 0; j < 4; ++j) vn[j] = __builtin_nontemporal_load((const f32x4*)(x_p + (size_t)(m + NGW) * D) + lane + 64 * j);
            }
#pragma unroll
            for (int j = 0; j < 4; ++j) s += (v[j].x * v[j].x + v[j].y * v[j].y) + (v[j].z * v[j].z + v[j].w * v[j].w);
#pragma unroll
            for (int j = 0; j < 4; ++j)
#pragma unroll
                for (int e = 0; e < 4; ++e) {
                    const int k = 256 * j + 4 * lane + e; const f32x4 w0 = *(const f32x4*)(wd + k * 8), w1 = *(const f32x4*)(wd + k * 8 + 4); const float xv = v[j][e];
                    d8[0] += xv * w0.x; d8[1] += xv * w0.y; d8[2] += xv * w0.z; d8[3] += xv * w0.w; d8[4] += xv * w1.x; d8[5] += xv * w1.y; d8[6] += xv * w1.z; d8[7] += xv * w1.w;
                }
            s = wave_sum(s);
#pragma unroll
            for (int c = 0; c < 8; ++c) d8[c] = wave_sum(d8[c]);
            const float rstd = 1.0f / sqrtf(s * (1.0f / D) + RMS_EPS);
            GAS unsigned long long* o8 = (GAS unsigned long long*)(HB + (size_t)m * D) + lane;
#pragma unroll
            for (int j = 0; j < 4; ++j) o8[64 * j] = (unsigned long long)pk2(v[j].x, v[j].y) | ((unsigned long long)pk2(v[j].z, v[j].w) << 32);
            if (lane < 4) *(f32x4*)(SSQ + (size_t)m * 16 + lane * 4) = (f32x4){lane == 0 ? s : 0.f, 0.f, 0.f, 0.f};
            if (lane < 2) *(f32x4*)(DTRAW + (size_t)m * 8 + lane * 4) = lane == 0 ? (f32x4){d8[0] * rstd, d8[1] * rstd, d8[2] * rstd, d8[3] * rstd} : (f32x4){d8[4] * rstd, d8[5] * rstd, d8[6] * rstd, d8[7] * rstd};
        }
        __syncthreads();
        if (rep + 1 < NREP(0)) xcd_barrier(bar);
    }
    SEAM(0);
    PROBE_STAMP(1);
    if (IN(1)) for (int rep = 0; rep < NREP(1); ++rep) {
        pg8::Gemm g{HB, WINE, M, NE, D}; pg8::StaticOrder S; S.init(M, NE, G, bid);
        auto pre = [&]() { RSTAB_FILL(S, SSQ, 16, 1.0f / 1024.0f); };
        typedef pg8::EpiBf16S<0, 1> Epi; Epi E{QKV, NE, rstab, out + O_KP, out + O_VP, out + O_CP};
        if (bid < NES / 32) skinny_unit(lds, WINE, D, bid, 0, BuildNorm{x_s}, SEpiInEven{S_IN, out + O_KS, out + O_VS});
        pg8::gemm_phase<Epi, pg8::StaticOrder, true, true>(ldsl, g, S, E, pre);
        if (rep + 1 < NREP(1)) xcd_barrier(bar);
    }
    SEAM(1);
    PROBE_STAMP(2);
    if (IN(2)) for (int rep = 0; rep < NREP(2); ++rep) {
        conv_prepass(QKV, conv_w, conv_b, HID  , bid);
        asm volatile("s_waitcnt vmcnt(0)" ::: "memory");
        __syncthreads();
        if (tid == 0) { __builtin_amdgcn_fence(__ATOMIC_RELEASE, "agent"); asm volatile("s_waitcnt vmcnt(0)" ::: "memory"); __hip_atomic_fetch_add(ctl + CW_CONV + 256 * rep, 1u, __ATOMIC_RELAXED, __HIP_MEMORY_SCOPE_AGENT); }
        ssd_sample_unit(lds, S_IN, s_conv, s_ssm, conv_w, conv_b, dt_bias, a_log, d_skip, out + O_CS, out + O_SS, S_YG, bid >> 3, bid & 7);
#define PULL(cw_) ({ __syncthreads(); if (tid == 0) MISC[16] = __hip_atomic_fetch_add(ctl + (cw_) + 256 * rep, 1u, __ATOMIC_RELAXED, __HIP_MEMORY_SCOPE_AGENT); __syncthreads(); (int)MISC[16]; })
#define RUN_DEC() for (int item; (item = PULL(CW_QDEC)) < MS * NDP; ) decode_unit(lds, S_IN, cache_k, cache_v, ptab, sb_bias, S_OPART, S_LPART, item / NDP, item % NDP)
        if ((bid & 1) == 0) RUN_DEC();
        if (rep + 1 < NREP(2)) xcd_barrier(bar);
    }
    PROBE_STAMP(3);
    if (IN(3)) for (int rep = 0; rep < NREP(3); ++rep) {
        PROBE_STAMP1(20);
        if (bid & 1) {
            const int o_ = bid >> 1, gid_ = (o_ & 3) * 4 + (o_ >> 5), mem_ = (o_ >> 2) & 7;
            const int item = ((gid_ >> 1) << 4) | (((gid_ & 1) * 4 + (mem_ >> 1)) << 1) | (mem_ & 1);
            if (tid == 0) { unsigned sp_ = 0; while (__hip_atomic_load(ctl + CW_CONV + 256 * rep, __ATOMIC_RELAXED, __HIP_MEMORY_SCOPE_AGENT) < (unsigned)G && ++sp_ < (1u << 22)) __builtin_amdgcn_s_sleep(2);
                            __builtin_amdgcn_fence(__ATOMIC_ACQUIRE, "agent"); asm volatile("s_waitcnt vmcnt(0)" ::: "memory"); }
            __syncthreads();
            ssd_unit2(lds, HID  , QKV, DTRAW, dt_bias, a_log, d_skip, MIX, SSM, out + O_SP, item >> 4, (item >> 1) & 7, item & 1);
        }
        PROBE_STAMP1(21);
        for (int item; (item = PULL(CW_QATT)) < 512; ) { const int bh = item & 63; attn_unit_mfma(lds, QKV, sb_bias, MIX, bh >> 3, bh & 7, 7 - (item >> 6)); }
        PROBE_STAMP1(22);
        RUN_DEC();
        PROBE_STAMP1(23);
        __syncthreads();
        if (rep + 1 < NREP(3)) xcd_barrier(bar);
    }
#undef RUN_DEC
#undef PULL
    SEAM(3);
    PROBE_STAMP(4);
    if (IN(4)) for (int rep = 0; rep < NREP(4); ++rep) {
        pg8::Gemm g{MIX, WOUTE, M, D, D}; pg8::StaticOrder S; S.init(M, D, G, bid);
        auto pre = [&]() {
            pg8::Unit u0; if (S.next(0, u0) && tid < 256) {
                const f32x4* p = (const f32x4*)(SSM + (size_t)(u0.pm * 256 + tid) * 32);
                const float sm = (pg8::sum4(p[0]) + pg8::sum4(p[1])) + (pg8::sum4(p[2]) + pg8::sum4(p[3]));
                midtab[tid] = 1.0f / sqrtf(sm * (1.0f / 512.0f) + RMS_EPS);
            }
        };
        typedef pg8::EpiResid<0, 8, false, 2> Epi; Epi E{nullptr, HB, SSQ, nullptr, midtab};
        pg8::gemm_phase<Epi, pg8::StaticOrder, true, true>(ldsl, g, S, E, pre);
        if (bid < D / 32) skinny_unit(lds, WOUTE, D, bid, 0, BuildMixEven{S_YG, S_OPART, S_LPART}, SEpiResid{x_s, S_H});
        if (rep + 1 < NREP(4)) xcd_barrier(bar);
    }
    SEAM(4);
    PROBE_STAMP(5);
    if (IN(5)) for (int rep = 0; rep < NREP(5); ++rep) {
        pg8::Gemm g{HB, W1T, M, FF, D}; pg8::StaticOrder S; S.init(M, FF, G, bid);
        auto pre = [&]() { RSTAB_FILL(S, SSQ, 16, 1.0f / 1024.0f); };
        typedef pg8::EpiBf16S<1, 0> Epi; Epi E{HID, FF, rstab, nullptr, nullptr, nullptr};
        if (bid < FF / 32) skinny_unit(lds, W1T, D, bid, 0, BuildNorm{S_H}, SEpiRelu2{S_HID, FF});
        pg8::gemm_phase<Epi, pg8::StaticOrder, true, true>(ldsl, g, S, E, pre);
        if (rep + 1 < NREP(5)) xcd_barrier(bar);
    }
    SEAM(5);
    PROBE_STAMP(6);
    if (IN(6)) for (int rep = 0; rep < NREP(6); ++rep) {
        pg8::Gemm g{HID, W2T, M, D, FF}; pg8::StaticOrder S; S.init(M, D, G, bid);
        typedef pg8::EpiResid<0, 0, false, 2> Epi; Epi E{nullptr, HB, SSQ, nullptr, nullptr};
        if (bid < 4 * (D / 32)) skinny_unit(lds, W2T, FF, bid & 31, (bid >> 5) * 1024, BuildPlain{S_HID, FF}, SEpiAtomic{S_H});
        pg8::gemm_phase<Epi, pg8::StaticOrder, true, true>(ldsl, g, S, E);
        if (rep + 1 < NREP(6)) xcd_barrier(bar);
    }
    SEAM(6);
    PROBE_STAMP(7);
    if (IN(7)) for (int rep = 0; rep < NREP(7); ++rep) {
        pg8::Gemm g{HB, WINO, M, ODD_IN, D}; pg8::StaticOrder S; S.init(M, ODD_IN, G, bid);
        auto pre = [&]() { RSTAB_FILL(S, SSQ, 16, 1.0f / 1024.0f); };
        typedef pg8::EpiBf16S<0, 0> Epi; Epi E{HID, ODD_IN, rstab, nullptr, nullptr, nullptr};
        if (bid < ODD_IN / 32) skinny_unit(lds, WINO, D, bid, 0, BuildNorm{S_H}, SEpiStore{S_IN, ODD_IN});
        pg8::gemm_phase<Epi, pg8::StaticOrder, true, true>(ldsl, g, S, E, pre);
        if (rep + 1 < NREP(7)) xcd_barrier(bar);
    }
    SEAM(7);
    PROBE_STAMP(8);
    if (IN(8)) for (int rep = 0; rep < NREP(8); ++rep) {
        hgrn_prepass(HID, lb_raw, QKV  , QKV + (size_t)M * 1024  , (float*)(QKV + (size_t)2 * M * 1024)  , bid);
        hgrn_sample_unit(lds, S_IN, s_hg, lb_raw, out + O_GS, S_O, bid >> 3, bid & 7);
        if (rep + 1 < NREP(8)) xcd_barrier(bar);
    }
    SEAM(8);
    PROBE_STAMP(9);
    if (IN(9)) for (int rep = 0; rep < NREP(9); ++rep) {
        {
            const int bh = (bid & 7) | ((bid >> 5) << 3), vq = (bid >> 3) & 3;
            hgrn_unit2(lds, QKV, QKV + (size_t)M * 1024, (const float*)(QKV + (size_t)2 * M * 1024), HID, MIX, SSM, out + O_GP, bh >> 3, bh & 7, vq);
        }
        if (rep + 1 < NREP(9)) xcd_barrier(bar);
    }
    SEAM(9);
    PROBE_STAMP(10);
    if (IN(10)) for (int rep = 0; rep < NREP(10); ++rep) {
        pg8::Gemm g{MIX, WOUTO, M, D, D}; pg8::StaticOrder S; S.init(M, D, G, bid);
        auto pre = [&]() { RSTAB_FILL(S, SSM, 32, 1.0f / 1024.0f); };
        typedef pg8::EpiResid<32, 0, false, 2> Epi; Epi E{nullptr, HB, SSQ, rstab, nullptr};
        pg8::gemm_phase<Epi, pg8::StaticOrder, true, true>(ldsl, g, S, E, pre);
        if (bid < D / 32) skinny_unit(lds, WOUTO, D, bid, 0, BuildMixOdd{S_O, S_IN}, SEpiResid{S_H, S_H});
        if (rep + 1 < NREP(10)) xcd_barrier(bar);
    }
    SEAM(10);
    PROBE_STAMP(11);
    if (IN(11)) for (int rep = 0; rep < NREP(11); ++rep) {
        pg8::Gemm g{HB, W1T + (size_t)FF * D, M, FF, D}; pg8::StaticOrder S; S.init(M, FF, G, bid);
        auto pre = [&]() { RSTAB_FILL(S, SSQ, 16, 1.0f / 1024.0f); };
        typedef pg8::EpiBf16S<1, 0> Epi; Epi E{HID, FF, rstab, nullptr, nullptr, nullptr};
        if (bid < FF / 32) skinny_unit(lds, W1T + (size_t)FF * D, D, bid, 0, BuildNorm{S_H}, SEpiRelu2{S_HID, FF});
        pg8::gemm_phase<Epi, pg8::StaticOrder, true, true>(ldsl, g, S, E, pre);
        if (rep + 1 < NREP(11)) xcd_barrier(bar);
    }
    SEAM(11);
    PROBE_STAMP(12);
    if (IN(12)) for (int rep = 0; rep < NREP(12); ++rep) {
        pg8::Gemm g{HID, W2T + (size_t)D * FF, M, D, FF}; pg8::StaticOrder S; S.init(M, D, G, bid);
        typedef pg8::EpiResid<0, 0, false, 2> Epi; Epi E{nullptr, HB, SSQ, nullptr, nullptr};
        if (bid < 4 * (D / 32)) skinny_unit(lds, W2T + (size_t)D * FF, FF, bid & 31, (bid >> 5) * 1024, BuildPlain{S_HID, FF}, SEpiAtomic{S_H});
        pg8::gemm_phase<Epi, pg8::StaticOrder, true, true>(ldsl, g, S, E);
        if (rep + 1 < NREP(12)) xcd_barrier(bar);
    }
    SEAM(12);
    PROBE_STAMP(13);
    if (IN(13)) for (int rep = 0; rep < NREP(13); ++rep) {
        const int gw = bid * NWAVES + wave, NGW = G * NWAVES;
        f32x4 wf[4];
#pragma unroll
        for (int j = 0; j < 4; ++j) wf[j] = *((const f32x4*)n_fin + lane + 64 * j);
        u32x2v vnx[4]; f32x4 spn[4];
        if (gw < M) {
#pragma unroll
            for (int j = 0; j < 4; ++j) { vnx[j] = __builtin_nontemporal_load((const u32x2v*)(HB + (size_t)gw * D) + lane + 64 * j); spn[j] = ((const f32x4*)(SSQ + (size_t)gw * 16))[j]; }
        }
        for (int m = gw; m < M; m += NGW) {
            u32x2v v[4]; f32x4 sp[4];
#pragma unroll
            for (int j = 0; j < 4; ++j) { v[j] = vnx[j]; sp[j] = spn[j]; }
            if (m + NGW < M) {
#pragma unroll
                for (int j = 0; j < 4; ++j) { vnx[j] = __builtin_nontemporal_load((const u32x2v*)(HB + (size_t)(m + NGW) * D) + lane + 64 * j); spn[j] = ((const f32x4*)(SSQ + (size_t)(m + NGW) * 16))[j]; }
            }
            const float ssum = (pg8::sum4(sp[0]) + pg8::sum4(sp[1])) + (pg8::sum4(sp[2]) + pg8::sum4(sp[3]));
            const float rstd = 1.0f / sqrtf(ssum * (1.0f / D) + RMS_EPS);
            float* dst = out + O_YP + (size_t)m * D;
#pragma unroll
            for (int j = 0; j < 4; ++j) { const f32x4 x = (f32x4){bflo(v[j].x), bfhi(v[j].x), bflo(v[j].y), bfhi(v[j].y)}; __builtin_nontemporal_store(x * rstd * wf[j], (f32x4*)dst + lane + 64 * j); }
        }
#if defined(PROBE_A0)
        float probe_eps = 0.f;
        {
            const unsigned long long* ts = (const unsigned long long*)(ctl + CW_TS);
            const float usB = (float)(long long)(ts[PROBE_B1] - ts[PROBE_B0]) * 0.01f, usA = (float)(long long)(ts[PROBE_A1] - ts[PROBE_A0]) * 0.01f;
            probe_eps = sqrtf(1e-6f * usB);
            if (bid == 0 && tid == 0) out[O_KS] += 0.01f * usA;
        }
#endif
        if (gw < MS) {
            const float* src = S_H + (size_t)gw * D; float* dst = out + O_YS + (size_t)gw * D;
            f32x4 v[4]; float sq = 0.f;
#pragma unroll
            for (int j = 0; j < 4; ++j) { v[j] = *((const f32x4*)src + lane + 64 * j); sq += (v[j].x * v[j].x + v[j].y * v[j].y) + (v[j].z * v[j].z + v[j].w * v[j].w); }
            sq = wave_sum(sq);
            const float rstd = 1.0f / sqrtf(sq * (1.0f / D) + RMS_EPS);
#pragma unroll
            for (int j = 0; j < 4; ++j) {
                f32x4 yv = v[j] * rstd * wf[j];
#if defined(PROBE_A0)
                yv = yv + probe_eps;
#endif
                *((f32x4*)dst + lane + 64 * j) = yv;
            }
        }
    }
#undef IN
#undef SEAM
#undef x_p
#undef x_s
#undef cache_k
#undef cache_v
#undef ptab
#undef s_conv
#undef s_ssm
#undef s_hg
#undef n_mix
#undef n_ffn
#undef n_fin
#undef w_ine
#undef sb_bias
#undef conv_w
#undef conv_b
#undef dt_bias
#undef a_log
#undef d_skip
#undef ssd_norm
#undef w_oute
#undef w_ino
#undef lb_raw
#undef hg_norm
#undef w_outo
#undef w_ff1
#undef w_ff2
#undef out
#undef WINE
#undef WOUTE
#undef WINO
#undef WOUTO
#undef W1T
#undef W2T
#undef HB
#undef H
#undef SSQ
#undef DTRAW
#undef SSM
#undef MIX
#undef QKV
#undef HID
#undef S_H
#undef S_IN
#undef S_HID
#undef S_YG
#undef S_OPART
#undef S_LPART
#undef S_O
}

constexpr int N_PHASES = 14;
#ifndef MK_SPLIT
#define MK_SPLIT 0
#endif
extern "C" void kernel_launch(void* const* d_in, const int* in_sizes, int n_in, void* d_out, int out_size, void* d_ws, size_t ws_size, hipStream_t stream) {
    static int grid = 0;
    if (grid == 0) {
        if (n_in != N_IN || (size_t)out_size != O_END || ws_size < WS_END) { fprintf(stderr, "kernel_launch: unexpected sizes n_in %d out %d ws %zu\n", n_in, out_size, ws_size); if (ws_size < WS_END) { grid = -1; return; } }
        int dev = 0, cus = 0, per_cu = 0;
        if (hipGetDevice(&dev) != hipSuccess || hipDeviceGetAttribute(&cus, hipDeviceAttributeMultiprocessorCount, dev) != hipSuccess) { grid = -1; return; }
        if (hipFuncSetAttribute((const void*)mk_fwd, hipFuncAttributeMaxDynamicSharedMemorySize, LDS_BYTES) != hipSuccess) { fprintf(stderr, "kernel_launch: hipFuncSetAttribute failed\n"); grid = -1; return; }
        if (hipOccupancyMaxActiveBlocksPerMultiprocessor(&per_cu, (const void*)mk_fwd, NTHR, LDS_BYTES) != hipSuccess || per_cu < 1) fprintf(stderr, "kernel_launch: occupancy query says %d\n", per_cu);
        (void)hipGetLastError();
        grid = cus;
        if (grid != 256) fprintf(stderr, "kernel_launch: %d CUs (built for 256)\n", grid);
    }
    if (grid < 0) return;
    (void)hipMemsetAsync((char*)d_ws + WS_CTL, 0, CTL_ZERO_BYTES, stream);
    Args a{};
    for (int i = 0; i < N_IN; ++i) a.in[i] = d_in[i];
    a.out = (float*)d_out; a.ws = (unsigned char*)d_ws;
#if MK_SPLIT
    for (int p = 0; p < N_PHASES; ++p) { a.ph_lo = p; a.ph_hi = p + 1; hipLaunchKernelGGL(mk_fwd, dim3(grid), dim3(NTHR), LDS_BYTES, stream, a); }
#else
    a.ph_lo = 0; a.ph_hi = N_PHASES; hipLaunchKernelGGL(mk_fwd, dim3(grid), dim3(NTHR), LDS_BYTES, stream, a);
#endif
}
```

```cpp
#include <hip/hip_runtime.h>
#include <cstdio>
#include <cstdint>
namespace pg8 {
#define PG8_LAS __attribute__((address_space(3)))
typedef unsigned short bf16_t;
typedef short bf16x8 __attribute__((ext_vector_type(8)));
typedef float f32x4 __attribute__((ext_vector_type(4)));
typedef unsigned u32x4 __attribute__((ext_vector_type(4)));
constexpr int BM = 256, BK = 64, HALF = 128, HTB = HALF * BK * 2  , STAGE_BYTES = 8 * HTB, NXCD = 8, WGM = 8;

__host__ __device__ __forceinline__ int lds_byte(int r, int c) { const int st = (r >> 4) * 2 + (c >> 5), rr = r & 15, cc = c & 31, ob = rr * 64 + cc * 2; return st * 1024 + (ob ^ (((ob >> 9) & 1) << 5)); }
__host__ __device__ __forceinline__ void stage_rc(int b, int& R, int& C) { const int st = b / 1024, sb = b % 1024, swz = sb ^ (((sb >> 9) & 1) << 5); R = (st >> 1) * 16 + swz / 64; C = (st & 1) * 32 + (swz % 64) / 2; }
__host__ __device__ __forceinline__ int perm32(int rho) { const int n = rho >> 4, i = rho & 15; return 8 * (i >> 2) + 4 * n + (i & 3); }

struct Unit { int pm, pn, idx; };
struct Gemm { const bf16_t* A; const bf16_t* Bt; int M, N, K; };

struct StaticOrder {
    int nM, nN, nwg, G, c;
    __host__ __device__ __forceinline__ void init(int M, int N, int G_, int c_) { nM = M / BM; nN = N / BM; nwg = nM * nN; G = G_; c = c_; }
    __host__ __device__ __forceinline__ bool next(int i, Unit& u) const {
        const long L = (long)i * G + c; if (L >= nwg) return false;
        int wgid = (int)L; const int xcd0 = wgid % NXCD; { const int q = nwg / NXCD, r = nwg % NXCD, xcd = wgid % NXCD, off = wgid / NXCD; wgid = (xcd < r ? xcd * (q + 1) : r * (q + 1) + (xcd - r) * q) + off; }
        const int nig = WGM * nN, gid = wgid / nig, fm = gid * WGM, gsz = (nM - fm) < WGM ? (nM - fm) : WGM;
        u.pm = fm + ((wgid % nig) % gsz); u.pn = ((wgid % nig) / gsz + ((xcd0 >> 1) & 1) * (nN / 2)) % nN; u.idx = i; return true;
    }
    __device__ __forceinline__ void a_ready(const Unit&) const {}
    __device__ __forceinline__ void done(const Unit&) const {}
};

typedef float cvt_f32x2_t __attribute__((ext_vector_type(2))); typedef __bf16 cvt_bf16x2_t __attribute__((ext_vector_type(2)));
__device__ __forceinline__ unsigned cvt_pk_bf16(float lo, float hi) { const cvt_f32x2_t v = {lo, hi}; return __builtin_bit_cast(unsigned, __builtin_convertvector(v, cvt_bf16x2_t)); }
typedef unsigned u32x2 __attribute__((ext_vector_type(2)));
constexpr float RMS_EPS = 1e-6f;
constexpr float LOG2E = 1.4426950408889634f, QSCALE = 0.125f * 1.4426950408889634f;
__device__ __forceinline__ float sum4(f32x4 a) { return (a.x + a.y) + (a.z + a.w); }
template <int NP> __device__ __forceinline__ float rstd_from(const float* part, int row, float inv_n) {
    const f32x4* p = (const f32x4*)(part + (size_t)row * NP); float s = 0.f;
#pragma unroll
    for (int i = 0; i < NP / 4; ++i) s += sum4(p[i]);
    return 1.0f / sqrtf(s * inv_n + RMS_EPS);
}
template <int ACT, int MODE> struct EpiBf16S {
    static constexpr bool PERM = true, AFTER_DRAIN = false, RESID_LDS = false, RESID_REMAP = false; static constexpr int MIDK = 0;
    bf16_t* O; int ldc; const PG8_LAS float* rstab; float* kout; float* vout; float* convout;
    __device__ __forceinline__ void midk(f32x4 (&)[2][2][4][2], const Unit&, int, int, int, int) const {}
    __device__ __forceinline__ void operator()(const f32x4 (&acc)[2][2][4][2], const Unit& u, int wr, int wc, int fr, int fq) const {
        const int pn = u.pn;
#pragma unroll
        for (int ai = 0; ai < 2; ++ai)
#pragma unroll
            for (int m = 0; m < 4; ++m) {
                const int row = u.pm * BM + ai * HALF + wr * 64 + m * 16 + fr;
                float rs = rstab[u.idx * BM + ai * HALF + wr * 64 + m * 16 + fr];
                if (MODE == 1 && pn < 2) rs *= QSCALE;
#pragma unroll
                for (int bj = 0; bj < 2; ++bj) {
                    const int col0 = pn * BM + bj * HALF + wc * 32 + fq * 8;
                    f32x4 v0 = acc[ai][bj][m][0] * rs, v1 = acc[ai][bj][m][1] * rs;
                    if (ACT == 1) {
                        v0.x = fmaxf(v0.x, 0.f); v0.y = fmaxf(v0.y, 0.f); v0.z = fmaxf(v0.z, 0.f); v0.w = fmaxf(v0.w, 0.f);
                        v1.x = fmaxf(v1.x, 0.f); v1.y = fmaxf(v1.y, 0.f); v1.z = fmaxf(v1.z, 0.f); v1.w = fmaxf(v1.w, 0.f);
                        v0 = v0 * v0; v1 = v1 * v1;
                    }
                    u32x4 w; w.x = cvt_pk_bf16(v0[0], v0[1]); w.y = cvt_pk_bf16(v0[2], v0[3]); w.z = cvt_pk_bf16(v1[0], v1[1]); w.w = cvt_pk_bf16(v1[2], v1[3]);
                    *(u32x4*)(O + (size_t)row * ldc + col0) = w;
                    if (MODE == 1) {
                        if (pn >= 2 && pn < 6) {
                            float* dst = (pn < 4 ? kout + (size_t)row * 512 + (col0 - 512) : vout + (size_t)row * 512 + (col0 - 1024));
                            __builtin_nontemporal_store(v0, (f32x4*)dst); __builtin_nontemporal_store(v1, (f32x4*)(dst + 4));
                        }
                        if (pn >= 8) {
                            const int t = row & 2047;
                            if (t >= 2045) { float* dst = convout + ((size_t)(row >> 11) * 3 + (t - 2045)) * 1024 + (col0 - 2048); *(f32x4*)dst = v0; *(f32x4*)(dst + 4) = v1; }
                        }
                    }
                }
                asm volatile("" ::: "memory");
            }
    }
};
template <int RSN, int MIDK_T, bool FINAL = false, int RL = 0> struct EpiResid {
    static constexpr bool PERM = (RL != 0), AFTER_DRAIN = (RL != 0), RESID_LDS = (RL != 0), RESID_REMAP = (RL == 2); static constexpr int MIDK = MIDK_T;
    __device__ __forceinline__ const char* resid_ptr(const Unit& u) const { return (const char*)(hb + (size_t)(u.pm * BM) * 1024 + u.pn * BM); }
    __device__ __forceinline__ void fused(const f32x4 (&acc)[2][2][4][2], const Unit& u, int wr, int wc, int fr, int fq, PG8_LAS unsigned char* lds, int, int) const {
        const int pn = u.pn;
#pragma unroll
        for (int ai = 0; ai < 2; ++ai)
#pragma unroll
            for (int m = 0; m < 4; ++m) {
                const int rl = wr * 64 + m * 16 + fr;
                const int row = u.pm * BM + ai * HALF + rl;
                float rs = 1.0f;
                if (RSN > 0) rs = rs_tab[ai * HALF + rl];
                float sq = 0.f;
#pragma unroll
                for (int bj = 0; bj < 2; ++bj) {
                    const int c = wc * 32 + fq * 8;
                    const size_t off = (size_t)row * 1024 + pn * BM + bj * HALF + c;
                    const u32x4 hh = *(const PG8_LAS u32x4*)(lds + (bj * 4 + (c >> 6) * 2 + ai) * HTB + lds_byte(rl, c & 63));
                    const f32x4 a0 = acc[ai][bj][m][0] * rs, a1 = acc[ai][bj][m][1] * rs;
                    const float h0 = __uint_as_float(hh.x << 16) + a0.x, h1 = __uint_as_float(hh.x & 0xffff0000u) + a0.y;
                    const float h2 = __uint_as_float(hh.y << 16) + a0.z, h3 = __uint_as_float(hh.y & 0xffff0000u) + a0.w;
                    const float h4 = __uint_as_float(hh.z << 16) + a1.x, h5 = __uint_as_float(hh.z & 0xffff0000u) + a1.y;
                    const float h6 = __uint_as_float(hh.w << 16) + a1.z, h7 = __uint_as_float(hh.w & 0xffff0000u) + a1.w;
                    u32x4 w; w.x = cvt_pk_bf16(h0, h1); w.y = cvt_pk_bf16(h2, h3); w.z = cvt_pk_bf16(h4, h5); w.w = cvt_pk_bf16(h6, h7); *(u32x4*)(hb + off) = w;
                    sq += ((h0 * h0 + h1 * h1) + (h2 * h2 + h3 * h3)) + ((h4 * h4 + h5 * h5) + (h6 * h6 + h7 * h7));
                }
                sq += __shfl_xor(sq, 16); sq += __shfl_xor(sq, 32);
                if (fq == 0) ssq_out[(size_t)row * 16 + pn * 4 + wc] = sq;
            }
    }
    float* hnew; bf16_t* hb; float* ssq_out; const PG8_LAS float* rs_tab; const PG8_LAS float* mid_tab;
    __device__ __forceinline__ void midk(f32x4 (&acc)[2][2][4][2], const Unit& u, int wr, int wc, int fr, int fq) const {
#pragma unroll
        for (int ai = 0; ai < 2; ++ai)
#pragma unroll
            for (int m = 0; m < 4; ++m) {
                const float rs = mid_tab[ai * HALF + wr * 64 + m * 16 + fr];
#pragma unroll
                for (int bj = 0; bj < 2; ++bj)
#pragma unroll
                    for (int n = 0; n < 2; ++n) acc[ai][bj][m][n] = acc[ai][bj][m][n] * rs;
            }
    }
    __device__ __forceinline__ void operator()(const f32x4 (&acc)[2][2][4][2], const Unit& u, int wr, int wc, int fr, int fq) const {
        const int pn = u.pn;
#pragma unroll
        for (int ai = 0; ai < 2; ++ai) {
            u32x2 ho[4][2][2];
#pragma unroll
            for (int m = 0; m < 4; ++m)
#pragma unroll
                for (int bj = 0; bj < 2; ++bj)
#pragma unroll
                    for (int n = 0; n < 2; ++n)
                        ho[m][bj][n] = *(const u32x2*)(hb + (size_t)(u.pm * BM + ai * HALF + wr * 64 + m * 16 + fr) * 1024 + pn * BM + bj * HALF + wc * 32 + n * 16 + fq * 4);
#pragma unroll
            for (int m = 0; m < 4; ++m) {
                const int row = u.pm * BM + ai * HALF + wr * 64 + m * 16 + fr;
                float rs = 1.0f;
                if (RSN > 0) rs = rs_tab[ai * HALF + wr * 64 + m * 16 + fr];
                float sq = 0.f;
#pragma unroll
                for (int bj = 0; bj < 2; ++bj)
#pragma unroll
                    for (int n = 0; n < 2; ++n) {
                        const size_t off = (size_t)row * 1024 + pn * BM + bj * HALF + wc * 32 + n * 16 + fq * 4;
                        const u32x2 hh = ho[m][bj][n];
                        const f32x4 av = acc[ai][bj][m][n] * rs;
                        const float h0 = __uint_as_float(hh.x << 16) + av.x, h1 = __uint_as_float(hh.x & 0xffff0000u) + av.y;
                        const float h2 = __uint_as_float(hh.y << 16) + av.z, h3 = __uint_as_float(hh.y & 0xffff0000u) + av.w;
                        if (FINAL) *(f32x4*)(hnew + off) = (f32x4){h0, h1, h2, h3};
                        else { u32x2 w; w.x = cvt_pk_bf16(h0, h1); w.y = cvt_pk_bf16(h2, h3); *(u32x2*)(hb + off) = w; }
                        sq += (h0 * h0 + h1 * h1) + (h2 * h2 + h3 * h3);
                    }
                sq += __shfl_xor(sq, 16); sq += __shfl_xor(sq, 32);
                if (fq == 0) ssq_out[(size_t)row * 16 + pn * 4 + wc] = sq;
            }
            asm volatile("" ::: "memory");
        }
    }
};
struct NoPre { __device__ __forceinline__ void operator()() const {} };
template <class Epi, class Sched, bool ALIGN_EPI = false, bool SP2 = false, int AUXA = 0, class Pre = NoPre>
__device__ __forceinline__ void gemm_phase(PG8_LAS unsigned char* lds, const Gemm g, const Sched& S, const Epi& E, const Pre& pre = Pre()) {
    const int tid = threadIdx.x, wid = __builtin_amdgcn_readfirstlane(tid >> 6), lane = tid & 63, wr = wid >> 2, wc = wid & 3, fr = lane & 15, fq = lane >> 4;
    const int K = g.K, nt = K / BK;
    unsigned voffA[2], voffB[2];
#pragma unroll
    for (int i = 0; i < 2; ++i) { int R, C; stage_rc(tid * 16 + i * 8192, R, C); const int Rb = Epi::PERM ? ((R & ~31) + perm32(R & 31)) : R;
        voffA[i] = (unsigned)(R * K + C) * 2u; voffB[i] = (unsigned)(Rb * K + C) * 2u; }
    unsigned voffR[2];
#pragma unroll
    for (int i = 0; i < 2; ++i) { int R, C; stage_rc(tid * 16 + i * 8192, R, C); voffR[i] = (unsigned)(R * 1024 + C) * 2u; }
    const size_t hstepR = (size_t)HALF * 1024 * 2;
    const size_t kstep = (size_t)(BK * 2);
    const size_t hstep = (size_t)HALF * K * 2;
    const size_t tstep = 2 * hstep;
    const unsigned ldsw = (unsigned)wid * 1024u;
    const int aoff = lds_byte(wr * 64 + fr, fq * 8), boff = lds_byte(wc * 32 + fr, fq * 8);
#define PG8_SA(b, h) (((b) * 2 + (h)) * HTB)
#define PG8_SB(b, h) ((4 + (b) * 2 + (h)) * HTB)
#define PG8_STAGE(bufoff, gbase, voff) do { _Pragma("unroll") for (int _i = 0; _i < 2; ++_i) \
        __builtin_amdgcn_global_load_lds((const unsigned*)((const char*)(gbase) + (voff)[_i]), (PG8_LAS unsigned*)(lds + (bufoff) + ldsw + _i * 8192), 16, 0, (&(voff)[0] == &voffA[0]) ? AUXA : 0); } while (0)
#define PG8_LDA(dst, b, h) do { _Pragma("unroll") for (int m = 0; m < 4; ++m) _Pragma("unroll") for (int k = 0; k < 2; ++k) dst[m][k] = *(const PG8_LAS bf16x8*)(lds + PG8_SA(b, h) + aoff + m * 2048 + k * 1024); } while (0)
#define PG8_LDB(dst, b, h) do { _Pragma("unroll") for (int n = 0; n < 2; ++n) _Pragma("unroll") for (int k = 0; k < 2; ++k) dst[n][k] = *(const PG8_LAS bf16x8*)(lds + PG8_SB(b, h) + boff + n * 2048 + k * 1024); } while (0)
#define PG8_MMA(ai, bj, At, Bt) do { __builtin_amdgcn_s_setprio(1); _Pragma("unroll") for (int m = 0; m < 4; ++m) _Pragma("unroll") for (int n = 0; n < 2; ++n) _Pragma("unroll") for (int k = 0; k < 2; ++k) \
        acc[ai][bj][m][n] = __builtin_amdgcn_mfma_f32_16x16x32_bf16(Bt[n][k], At[m][k], acc[ai][bj][m][n], 0, 0, 0); __builtin_amdgcn_s_setprio(0); } while (0)
#define PG8_WAIT_V(n) asm volatile("s_waitcnt vmcnt(" #n ")" ::: "memory")
#define PG8_WAIT_L(n) asm volatile("s_waitcnt lgkmcnt(" #n ")" ::: "memory")
#define PG8_BAR __builtin_amdgcn_s_barrier()
#define PG8_SCHED __builtin_amdgcn_sched_barrier(0)
    Unit cur, nxt; int ui = 0;
    if (!S.next(0, cur)) return;
    f32x4 acc[2][2][4][2];
#pragma unroll
    for (int a = 0; a < 2; ++a)
#pragma unroll
        for (int b = 0; b < 2; ++b)
#pragma unroll
            for (int m = 0; m < 4; ++m)
#pragma unroll
                for (int n = 0; n < 2; ++n) acc[a][b][m][n] = (f32x4){0.f, 0.f, 0.f, 0.f};
    bf16x8 At[4][2], B0[2][2], B1[2][2];
    const char* cA = (const char*)g.A + (size_t)cur.pm * tstep; const char* cB = (const char*)g.Bt + (size_t)cur.pn * tstep;
    S.a_ready(cur);
    if constexpr (SP2) {
        PG8_STAGE(PG8_SB(0, 0), cB, voffB); PG8_STAGE(PG8_SB(0, 1), cB + hstep, voffB); PG8_STAGE(PG8_SA(0, 0), cA, voffA); PG8_STAGE(PG8_SA(0, 1), cA + hstep, voffA);
        pre();
        if (wr == 1) PG8_BAR;
        PG8_WAIT_V(2); PG8_BAR;
        PG8_STAGE(PG8_SB(1, 0), cB + kstep, voffB); PG8_STAGE(PG8_SA(1, 0), cA + kstep, voffA); PG8_STAGE(PG8_SB(1, 1), cB + hstep + kstep, voffB);
        PG8_WAIT_V(6); PG8_BAR;
    } else {
        PG8_STAGE(PG8_SB(0, 0), cB, voffB); PG8_STAGE(PG8_SA(0, 0), cA, voffA); PG8_STAGE(PG8_SB(0, 1), cB + hstep, voffB); PG8_STAGE(PG8_SA(0, 1), cA + hstep, voffA);
        if (wr == 1) PG8_BAR;
        PG8_WAIT_V(4); PG8_BAR;
        PG8_STAGE(PG8_SB(1, 0), cB + kstep, voffB); PG8_STAGE(PG8_SA(1, 0), cA + kstep, voffA); PG8_STAGE(PG8_SB(1, 1), cB + hstep + kstep, voffB);
        PG8_WAIT_V(6); PG8_BAR;
    }
    for (;;) {
        const bool has_next = S.next(ui + 1, nxt);
        const char* nA = has_next ? (const char*)g.A + (size_t)nxt.pm * tstep : cA; const char* nB = has_next ? (const char*)g.Bt + (size_t)nxt.pn * tstep : cB;
        if constexpr (Epi::RESID_LDS) { if (!has_next) { nA = E.resid_ptr(cur); nB = nA + 2 * kstep; } }
        for (int t = 0; t < nt; t += 2) {
            if constexpr (Epi::MIDK > 0) { if (t == Epi::MIDK) E.midk(acc, cur, wr, wc, fr, fq); }
            const bool last = (t == nt - 2);
            const char* a1 = cA + (size_t)(t + 1) * kstep;
            const char* a2 = last ? nA : cA + (size_t)(t + 2) * kstep; const char* b2 = last ? nB : cB + (size_t)(t + 2) * kstep;
            const char* a3 = a2 + kstep; const char* b3 = b2 + kstep;
            if (last && has_next) S.a_ready(nxt);
            unsigned tA[2] = {voffA[0], voffA[1]}, tB[2] = {voffB[0], voffB[1]}; size_t th = hstep;
            if constexpr (Epi::RESID_REMAP) { if (last && !has_next) { tA[0] = voffR[0]; tA[1] = voffR[1]; tB[0] = voffR[0]; tB[1] = voffR[1]; th = hstepR; } }
            if constexpr (SP2) {
            PG8_LDB(B0, 0, 0); PG8_LDB(B1, 0, 1); PG8_SCHED; PG8_LDA(At, 0, 0); PG8_STAGE(PG8_SA(1, 1), a1 + hstep, voffA);
            PG8_WAIT_V(8); PG8_WAIT_L(0); PG8_BAR; PG8_MMA(0, 0, At, B0); PG8_MMA(0, 1, At, B1); PG8_BAR; PG8_SCHED;
            PG8_LDA(At, 0, 1); PG8_STAGE(PG8_SB(0, 0), b2, tB); PG8_STAGE(PG8_SB(0, 1), b2 + th, tB); PG8_STAGE(PG8_SA(0, 0), a2, tA);
            PG8_WAIT_V(8); PG8_WAIT_L(0); PG8_BAR; PG8_MMA(1, 0, At, B0); PG8_MMA(1, 1, At, B1); PG8_BAR; PG8_SCHED;
            PG8_LDB(B0, 1, 0); PG8_LDB(B1, 1, 1); PG8_SCHED; PG8_LDA(At, 1, 0); PG8_STAGE(PG8_SA(0, 1), a2 + th, tA);
            PG8_WAIT_V(8); PG8_WAIT_L(0); PG8_BAR; PG8_MMA(0, 0, At, B0); PG8_MMA(0, 1, At, B1); PG8_BAR; PG8_SCHED;
            PG8_LDA(At, 1, 1); PG8_STAGE(PG8_SB(1, 0), b3, tB); PG8_STAGE(PG8_SB(1, 1), b3 + th, tB); PG8_STAGE(PG8_SA(1, 0), a3, tA);
            PG8_WAIT_V(8); PG8_WAIT_L(0); PG8_BAR; PG8_MMA(1, 0, At, B0); PG8_MMA(1, 1, At, B1); PG8_BAR; PG8_SCHED;
            } else {
            PG8_LDB(B0, 0, 0); PG8_SCHED; PG8_LDA(At, 0, 0); PG8_STAGE(PG8_SA(1, 1), a1 + hstep, voffA);
            PG8_WAIT_L(8); PG8_BAR; PG8_WAIT_L(0); PG8_MMA(0, 0, At, B0); PG8_BAR; PG8_SCHED;
            PG8_LDB(B1, 0, 1); PG8_STAGE(PG8_SB(0, 0), b2, voffB);
            PG8_BAR; PG8_WAIT_L(0); PG8_MMA(0, 1, At, B1); PG8_BAR;
            PG8_LDA(At, 0, 1); PG8_STAGE(PG8_SA(0, 0), a2, voffA);
            PG8_BAR; PG8_WAIT_L(0); PG8_MMA(1, 0, At, B0); PG8_BAR; PG8_SCHED;
            PG8_STAGE(PG8_SB(0, 1), b2 + hstep, voffB);
            PG8_WAIT_V(6); PG8_BAR; PG8_MMA(1, 1, At, B1); PG8_BAR;
            PG8_LDB(B0, 1, 0); PG8_SCHED; PG8_LDA(At, 1, 0); PG8_STAGE(PG8_SA(0, 1), a2 + hstep, voffA);
            PG8_WAIT_L(8); PG8_BAR; PG8_WAIT_L(0); PG8_MMA(0, 0, At, B0); PG8_BAR; PG8_SCHED;
            PG8_LDB(B1, 1, 1); PG8_STAGE(PG8_SB(1, 0), b3, voffB);
            PG8_BAR; PG8_WAIT_L(0); PG8_MMA(0, 1, At, B1); PG8_BAR;
            PG8_LDA(At, 1, 1); PG8_STAGE(PG8_SA(1, 0), a3, voffA);
            PG8_BAR; PG8_WAIT_L(0); PG8_MMA(1, 0, At, B0); PG8_BAR; PG8_SCHED;
            PG8_STAGE(PG8_SB(1, 1), b3 + hstep, voffB);
            PG8_WAIT_V(6); PG8_BAR; PG8_MMA(1, 1, At, B1); PG8_BAR;
            }
        }
        if constexpr (ALIGN_EPI) { if (wr == 0) PG8_BAR; }
        if constexpr (Epi::RESID_LDS) { if (!has_next) { if constexpr (Epi::RESID_REMAP) PG8_STAGE(PG8_SA(1, 1), nA + kstep + hstepR, voffR); else PG8_STAGE(PG8_SA(1, 1), nA + kstep + hstep, voffA); } }
        if constexpr (!Epi::AFTER_DRAIN) { E(acc, cur, wr, wc, fr, fq); S.done(cur); }
        if (!has_next) break;
#pragma unroll
        for (int a = 0; a < 2; ++a)
#pragma unroll
            for (int b = 0; b < 2; ++b)
#pragma unroll
                for (int m = 0; m < 4; ++m)
#pragma unroll
                    for (int n = 0; n < 2; ++n) acc[a][b][m][n] = (f32x4){0.f, 0.f, 0.f, 0.f};
        cur = nxt; cA = nA; cB = nB; ++ui;
        if constexpr (ALIGN_EPI) { if (wr == 1) PG8_BAR; }
    }
    PG8_WAIT_V(0);
    if constexpr (!ALIGN_EPI) { if (wr == 0) PG8_BAR; }
    PG8_BAR;
    if constexpr (Epi::AFTER_DRAIN) { E.fused(acc, cur, wr, wc, fr, fq, lds, wid, lane); S.done(cur); }
#undef PG8_SA
#undef PG8_SB
#undef PG8_STAGE
#undef PG8_LDA
#undef PG8_LDB
#undef PG8_MMA
#undef PG8_WAIT_V
#undef PG8_WAIT_L
#undef PG8_BAR
#undef PG8_SCHED
}
}

using pg8::RMS_EPS; using pg8::LOG2E; using pg8::u32x4;
constexpr int NWAVES = 8, NTHR = 512;
constexpr int NB = 8, T = 2048, D = 1024, FF = 4096, M = NB * T;
constexpr int MS = 32;
constexpr int PAST = 8192, PAGE = 128, NPAGES = 64;
constexpr int EVEN_IN = 3080, NE = 3072, NES = 3104;
constexpr int ODD_IN = 4096;
constexpr int N_PHYS = 2560;
constexpr int DRING = 6;
constexpr int NDP = 8;
enum { I_XP = 0, I_XS, I_CK, I_CV, I_PT, I_SCONV, I_SSSM, I_SHG, I_NMIX, I_NFFN, I_NFIN, I_WINE, I_SBB, I_CONVW, I_CONVB, I_DTB, I_ALOG, I_DSKIP, I_SSDN, I_WOUTE, I_WINO, I_LBRAW, I_HGN, I_WOUTO, I_W1, I_W2, N_IN };
constexpr size_t O_YP = 0, O_YS = O_YP + (size_t)M * D, O_KP = O_YS + (size_t)MS * D, O_VP = O_KP + (size_t)M * 512, O_KS = O_VP + (size_t)M * 512, O_VS = O_KS + (size_t)MS * 512,
                 O_CP = O_VS + (size_t)MS * 512, O_CS = O_CP + (size_t)NB * 3 * 1024, O_SP = O_CS + (size_t)MS * 3 * 1024, O_SS = O_SP + (size_t)NB * 8 * 64 * 128,
                 O_GP = O_SS + (size_t)MS * 8 * 64 * 128, O_GS = O_GP + (size_t)NB * 8 * 128 * 128, O_END = O_GS + (size_t)MS * 8 * 128 * 128;
constexpr size_t MiB = 1u << 20;
constexpr size_t WS_CTL = 0, CTL_ZERO_BYTES = 1 * MiB;
constexpr size_t WS_WINE = 2 * MiB;
constexpr size_t WS_WOUTE = 10 * MiB;
constexpr size_t WS_WINO = 12 * MiB;
constexpr size_t WS_WOUTO = 20 * MiB;
constexpr size_t WS_W1 = 22 * MiB;
constexpr size_t WS_W2 = 38 * MiB;
constexpr size_t WS_HB = 54 * MiB;
constexpr size_t WS_H = 86 * MiB;
constexpr size_t WS_SSQ = 150 * MiB;
constexpr size_t WS_DTRAW = 151 * MiB;
constexpr size_t WS_SSM = 152 * MiB;
constexpr size_t WS_MIX = 154 * MiB;
constexpr size_t WS_QKV = 186 * MiB;
constexpr size_t WS_HID = 282 * MiB;
constexpr size_t WS_SMP = 410 * MiB;
constexpr size_t SM_H = 0, SM_IN = SM_H + (size_t)MS * 1024 * 4, SM_HID = SM_IN + (size_t)MS * 4096 * 4, SM_YG = SM_HID + (size_t)MS * 4096 * 4, SM_OPART = SM_YG + (size_t)MS * 512 * 4,
                 SM_LPART = SM_OPART + (size_t)MS * NDP * 512 * 4, SM_O = SM_LPART + (size_t)MS * NDP * 8 * 4, SM_END = SM_O + (size_t)MS * 1024 * 4;
constexpr size_t WS_END = WS_SMP + 4 * MiB;
static_assert(SM_END <= 4 * MiB, "sample scratch");
constexpr int CW_TS = 1024, CW_TMO = 0, CW_QATT = 64, CW_QDEC = 128, CW_QSSD = 192, CW_CONV = 224, CW_BAR = 4096;

constexpr int RING_BYTES = 131072, MISC_OFF = RING_BYTES + 320, LDS_BYTES = 147456;

#define GAS __attribute__((address_space(1)))
#define LAS __attribute__((address_space(3)))
typedef unsigned short bf16;
typedef unsigned v4u __attribute__((ext_vector_type(4)));
typedef float f32x4 __attribute__((ext_vector_type(4)));
typedef short bf16x8 __attribute__((ext_vector_type(8)));
typedef GAS unsigned gu32;
typedef GAS unsigned long long gu64;
#define RLX_AGENT __ATOMIC_RELAXED, __HIP_MEMORY_SCOPE_AGENT
#define LDS_WAIT() asm volatile("s_waitcnt lgkmcnt(0)" ::: "memory")
#define VM_WAIT() asm volatile("s_waitcnt vmcnt(0)" ::: "memory")
__device__ __forceinline__ unsigned long long rt() { return __builtin_amdgcn_s_memrealtime(); }
__device__ __forceinline__ unsigned f2bf(float f) { unsigned u = __builtin_bit_cast(unsigned, f); return (u + 0x7fffu + ((u >> 16) & 1u)) >> 16; }
__device__ __forceinline__ unsigned pk2(float lo, float hi) { return pg8::cvt_pk_bf16(lo, hi); }

#define XB_TMO      128
#define XB_XCNT(j)  (256  + 64 * (j))
#define XB_XSUB(j)  (1280 + 64 * (j))
#define XB_XGEN(j)  (2304 + 64 * (j))
#define XB_TOP      3328
#define XB_TOPGEN   3392
#define XCD_BAR_WORDS 3456
#define XB_SPIN_CAP (1u << 18)

__device__ __forceinline__ unsigned xb_ld(unsigned* p)              { return __hip_atomic_load(p, __ATOMIC_RELAXED, __HIP_MEMORY_SCOPE_AGENT); }
__device__ __forceinline__ unsigned xb_add(unsigned* p, unsigned v) { return __hip_atomic_fetch_add(p, v, __ATOMIC_RELAXED, __HIP_MEMORY_SCOPE_AGENT); }
__device__ __forceinline__ unsigned xb_xcc_id() { return (unsigned)__builtin_amdgcn_s_getreg((3 << 11) | 20) & 0xFu; }
#define XB_SPIN(cond, bar) do { unsigned _sp = 0; while (cond) { __builtin_amdgcn_s_sleep(1); \
    if ((++_sp & 255u) == 0u) { if (xb_ld(&(bar)[XB_TMO])) break; if (_sp > XB_SPIN_CAP) { atomicAdd(&(bar)[XB_TMO], 1u); break; } } } } while (0)

struct XcdBarrier {
    unsigned* bar; unsigned x;
    volatile LAS unsigned* st;
};

__device__ __forceinline__ XcdBarrier xcd_barrier_post(unsigned* bar, volatile LAS unsigned* st) {
    XcdBarrier b; b.bar = bar; b.x = xb_xcc_id(); b.st = st;
    if (threadIdx.x == 0) (void)xb_add(&bar[XB_XCNT(b.x)], 1u);
    return b;
}
__device__ __forceinline__ void xcd_barrier_complete(unsigned* bar, unsigned x, unsigned& nloc, unsigned& nx) {
    const unsigned G = gridDim.x * gridDim.y * gridDim.z;
    unsigned sum, cnt, mine, sp = 0u;
    for (;;) {
        sum = 0u; cnt = 0u; mine = 0u;
#pragma unroll
        for (unsigned j = 0; j < 16; ++j) { const unsigned c = xb_ld(&bar[XB_XCNT(j)]); sum += c; cnt += (c > 0u) ? 1u : 0u; mine = (j == x) ? c : mine; }
        if (sum == G) break;
        __builtin_amdgcn_s_sleep(1);
        if ((++sp & 255u) == 0u) { if (xb_ld(&bar[XB_TMO])) break; if (sp > XB_SPIN_CAP) { atomicAdd(&bar[XB_TMO], 1u); break; } }
    }
    nloc = mine > 0u ? mine : 1u; nx = cnt > 0u ? cnt : 1u;
}

__device__ __forceinline__ void xcd_barrier(const XcdBarrier& b) {
    asm volatile("s_waitcnt vmcnt(0)" ::: "memory");
    __syncthreads();
    if (threadIdx.x == 0) {
        unsigned* bar = b.bar;
        __builtin_amdgcn_s_waitcnt(0);
        unsigned nloc = b.st[0], nx = b.st[1];
        if (nloc == 0u) { xcd_barrier_complete(bar, b.x, nloc, nx); b.st[0] = nloc; b.st[1] = nx; }
        const unsigned old = xb_add(&bar[XB_XSUB(b.x)], 1u);
        const unsigned gen = old / nloc;
        if (old + 1u == (gen + 1u) * nloc) {
            __builtin_amdgcn_fence(__ATOMIC_RELEASE, "agent");
            asm volatile("s_waitcnt vmcnt(0)" ::: "memory");
            const unsigned og = xb_add(&bar[XB_TOP], 1u);
            const unsigned tg = og / nx;
            if (og + 1u == (tg + 1u) * nx) xb_add(&bar[XB_TOPGEN], 1u);
            else XB_SPIN(xb_ld(&bar[XB_TOPGEN]) == tg, bar);
            __builtin_amdgcn_fence(__ATOMIC_ACQUIRE, "agent");
            xb_add(&bar[XB_XGEN(b.x)], 1u);
            asm volatile("s_waitcnt vmcnt(0)" ::: "memory");
        } else {
            XB_SPIN(xb_ld(&bar[XB_XGEN(b.x)]) == gen, bar);
            __builtin_amdgcn_fence(__ATOMIC_ACQUIRE, "agent");
            asm volatile("s_waitcnt vmcnt(0)" ::: "memory");
        }
    }
    __syncthreads();
}

typedef unsigned u32x2v __attribute__((ext_vector_type(2)));
typedef float f32x2v __attribute__((ext_vector_type(2)));
__device__ __forceinline__ float bf2f(unsigned short b) { return __uint_as_float(((unsigned)b) << 16); }
__device__ __forceinline__ float bflo(unsigned u) { return __uint_as_float(u << 16); }
__device__ __forceinline__ float bfhi(unsigned u) { return __uint_as_float(u & 0xffff0000u); }
__device__ __forceinline__ float silu_f(float x) { return x / (1.0f + __expf(-x)); }
__device__ __forceinline__ float silu_fast(float x) { return x * __builtin_amdgcn_rcpf(1.0f + __builtin_amdgcn_exp2f(-1.4426950408889634f * x)); }
__device__ __forceinline__ float sigmoid_f(float x) { return 1.0f / (1.0f + __expf(-x)); }
__device__ __forceinline__ float softplus_f(float x) { return fmaxf(x, 0.f) + log1pf(__expf(-fabsf(x))); }
__device__ __forceinline__ float wave_sum(float v) {
#pragma unroll
    for (int o = 1; o < 64; o <<= 1) v += __shfl_xor(v, o);
    return v;
}

struct Args { const void* in[N_IN]; float* out; unsigned char* ws; int ph_lo, ph_hi; };

__device__ __forceinline__ unsigned cvtpk0(float lo, float hi) { return pg8::cvt_pk_bf16(lo, hi); }
struct P0Desc { const float* W; bf16* WT; const float* scale; int K, N, Npad, kxor, sk0, item; };
__device__ __forceinline__ void p0_load(const P0Desc& d, float (&v)[32], int lane) {
    const int nblk = d.Npad / 32, kb = d.item / nblk, nb = d.item % nblk, k0 = 64 * kb, n = 32 * nb + (lane & 31);
#pragma unroll
    for (int i = 0; i < 32; ++i) {
        const int k = k0 + 2 * i + (lane >> 5);
        v[i] = (n < d.N) ? d.W[(size_t)k * d.N + n] : 0.f;
    }
}
__device__ __forceinline__ void p0_store(const P0Desc& d, const float (&v)[32], LAS float* scr, int lane) {
    const int nblk = d.Npad / 32, kb = d.item / nblk, nb = d.item % nblk, k0 = 64 * kb, n0 = 32 * nb;
#pragma unroll
    for (int i = 0; i < 32; ++i) scr[(2 * i + (lane >> 5)) * 33 + (lane & 31)] = v[i];
    LDS_WAIT(); asm volatile("" ::: "memory");
    const int c = lane & 7;
    f32x4 g0 = (f32x4){1.f, 1.f, 1.f, 1.f}, g1 = g0;
    if (d.scale && k0 + 8 * c >= d.sk0) { g0 = *(const f32x4*)(d.scale + (k0 + 8 * c - d.sk0)); g1 = *(const f32x4*)(d.scale + (k0 + 8 * c - d.sk0) + 4); }
#pragma unroll
    for (int j = 0; j < 4; ++j) {
        const int nn = (lane >> 3) + 8 * j; const LAS float* s = scr + (8 * c) * 33 + nn;
        v4u o; o.x = cvtpk0(s[0 * 33] * g0.x, s[1 * 33] * g0.y); o.y = cvtpk0(s[2 * 33] * g0.z, s[3 * 33] * g0.w); o.z = cvtpk0(s[4 * 33] * g1.x, s[5 * 33] * g1.y); o.w = cvtpk0(s[6 * 33] * g1.z, s[7 * 33] * g1.w);
        *(GAS v4u*)(d.WT + (size_t)(n0 + nn) * d.K + ((k0 + 8 * c) ^ d.kxor)) = o;
    }
    LDS_WAIT(); asm volatile("" ::: "memory");
}

typedef short v4i16_t __attribute__((ext_vector_type(4)));
struct P0W { const float* W; bf16* WT; const float* scale; int K, N, kxor, sk0, kb32, nb, late; };
constexpr int P0W_STR = 320;
__device__ __forceinline__ void p0w_load(const P0W& d, f32x4 (&v)[16], float& sv, int lane) {
    const int k0 = 32 * d.kb32; const size_t col = (size_t)128 * d.nb + 4 * (lane & 31);
    sv = 1.0f;
    if (d.scale) { const int k = k0 + (lane & 31); if (k >= d.sk0) sv = d.scale[k - d.sk0]; }
#pragma unroll
    for (int i = 0; i < 16; ++i) v[i] = __builtin_nontemporal_load((const f32x4*)(d.W + (size_t)(k0 + 2 * i + (lane >> 5)) * d.N + col));
}
__device__ __forceinline__ void p0w_store(const P0W& d, const f32x4 (&v)[16], float sv, unsigned char* scr, int lane) {
    const int par = lane >> 5;
#pragma unroll
    for (int i = 0; i < 16; ++i) {
        const float se = __int_as_float(__builtin_amdgcn_readlane(__float_as_int(sv), 2 * i)), so = __int_as_float(__builtin_amdgcn_readlane(__float_as_int(sv), 2 * i + 1));
        const float sc = par ? so : se;
        u32x2v w; w.x = cvtpk0(v[i].x * sc, v[i].y * sc); w.y = cvtpk0(v[i].z * sc, v[i].w * sc);
        *(u32x2v*)(scr + (2 * i + par) * P0W_STR + (lane & 31) * 8) = w;
    }
    LDS_WAIT(); asm volatile("" ::: "memory");
    const int g = lane >> 4, q = (lane & 15) >> 2, pp = lane & 3;
    const LAS unsigned char* s3 = (const LAS unsigned char*)scr;
#pragma unroll
    for (int it = 0; it < 8; ++it) {
        const int kc = it & 3, colblk = (it >> 2) * 64 + g * 16;
        const LAS unsigned char* a = s3 + (8 * kc + q) * P0W_STR + (colblk + 4 * pp) * 2;
        const v4i16_t r0 = __builtin_amdgcn_ds_read_tr16_b64_v4i16((LAS v4i16_t*)a);
        const v4i16_t r1 = __builtin_amdgcn_ds_read_tr16_b64_v4i16((LAS v4i16_t*)(a + 4 * P0W_STR));
        const int n = 128 * d.nb + colblk + (lane & 15), kd = (32 * d.kb32 + 8 * kc) ^ d.kxor;
        typedef short s16x8 __attribute__((ext_vector_type(8)));
        const s16x8 ov = (s16x8){r0[0], r0[1], r0[2], r0[3], r1[0], r1[1], r1[2], r1[3]};
        if (d.late) __builtin_nontemporal_store(ov, (s16x8*)(d.WT + (size_t)n * d.K + kd)); else *(GAS s16x8*)(d.WT + (size_t)n * d.K + kd) = ov;
    }
    LDS_WAIT(); asm volatile("" ::: "memory");
}

constexpr int SK_LDA = 1024 + 8;
constexpr int SK_A_BYTES = 32 * SK_LDA * 2;
constexpr int SK_RED_OFF = 67584;
constexpr int SK_AUX_OFF = SK_RED_OFF + 8 * 4096;
template <class Builder, class Epi>
__device__ __forceinline__ void skinny_unit(unsigned char* lds, const bf16* Wt, int K, int u, int kc, const Builder& B, const Epi& E) {
    const int tid = threadIdx.x, lane = tid & 63, wid = tid >> 6, r32 = lane & 31, hi = lane >> 5;
    typedef float f32x16 __attribute__((ext_vector_type(16)));
    f32x16 acc;
#pragma unroll
    for (int i = 0; i < 16; ++i) acc[i] = 0.f;
    bf16* Al = (bf16*)lds;
    const bf16* wrow = Wt + (size_t)(u * 32 + r32) * K + kc + wid * 128 + hi * 8;
    bf16x8 bfr[8];
#pragma unroll
    for (int s = 0; s < 8; ++s) bfr[s] = *(const bf16x8*)(wrow + s * 16);
    __syncthreads();
    B(Al, (float*)(lds + SK_AUX_OFF), kc);
    __syncthreads();
#pragma unroll
    for (int s = 0; s < 8; ++s) {
        const bf16x8 afr = *(const bf16x8*)(Al + r32 * SK_LDA + wid * 128 + s * 16 + hi * 8);
        acc = __builtin_amdgcn_mfma_f32_32x32x16_bf16(afr, bfr[s], acc, 0, 0, 0);
    }
    float* red = (float*)(lds + SK_RED_OFF);
#pragma unroll
    for (int i = 0; i < 16; ++i) { const int row = (i & 3) + 8 * (i >> 2) + 4 * hi; red[wid * 1024 + row * 32 + r32] = acc[i]; }
    __syncthreads();
#pragma unroll
    for (int e = 0; e < 2; ++e) {
        const int idx = tid + e * 512; float s = 0.f;
#pragma unroll
        for (int w = 0; w < 8; ++w) s += red[w * 1024 + idx];
        E(idx >> 5, u * 32 + (idx & 31), s);
    }
    __syncthreads();
}
struct BuildNorm {
    const float* X;
    __device__ __forceinline__ void operator()(bf16* Al, float* aux, int kc) const {
        const int tid = threadIdx.x, row = tid >> 4, c16 = tid & 15;
        f32x4 v[16]; float s = 0.f;
#pragma unroll
        for (int j = 0; j < 16; ++j) { v[j] = *(const f32x4*)(X + (size_t)row * 1024 + j * 64 + c16 * 4); s += (v[j].x * v[j].x + v[j].y * v[j].y) + (v[j].z * v[j].z + v[j].w * v[j].w); }
        s += __shfl_xor(s, 1); s += __shfl_xor(s, 2); s += __shfl_xor(s, 4); s += __shfl_xor(s, 8);
        const float rs = 1.0f / sqrtf(s * (1.0f / 1024.0f) + RMS_EPS);
#pragma unroll
        for (int j = 0; j < 16; ++j) { u32x2v w; w.x = pk2(v[j].x * rs, v[j].y * rs); w.y = pk2(v[j].z * rs, v[j].w * rs); *(u32x2v*)(Al + row * SK_LDA + j * 64 + c16 * 4) = w; }
    }
};
struct BuildPlain {
    const float* X; int ldx;
    __device__ __forceinline__ void operator()(bf16* Al, float* aux, int kc) const {
        const int tid = threadIdx.x, row = tid >> 4, c16 = tid & 15;
#pragma unroll
        for (int j = 0; j < 16; ++j) { const f32x4 v = *(const f32x4*)(X + (size_t)row * ldx + kc + j * 64 + c16 * 4); u32x2v w; w.x = pk2(v.x, v.y); w.y = pk2(v.z, v.w); *(u32x2v*)(Al + row * SK_LDA + j * 64 + c16 * 4) = w; }
    }
};
struct BuildMixEven {
    const float* YG;
    const float* OPART;
    const float* LPART;
    __device__ __forceinline__ void operator()(bf16* Al, float* aux, int kc) const {
        const int tid = threadIdx.x, row = tid >> 4, c16 = tid & 15;
        {
            f32x4 v[8]; float s = 0.f;
#pragma unroll
            for (int j = 0; j < 8; ++j) { v[j] = *(const f32x4*)(YG + (size_t)row * 512 + j * 64 + c16 * 4); s += (v[j].x * v[j].x + v[j].y * v[j].y) + (v[j].z * v[j].z + v[j].w * v[j].w); }
            s += __shfl_xor(s, 1); s += __shfl_xor(s, 2); s += __shfl_xor(s, 4); s += __shfl_xor(s, 8);
            const float rs = 1.0f / sqrtf(s * (1.0f / 512.0f) + RMS_EPS);
#pragma unroll
            for (int j = 0; j < 8; ++j) { u32x2v w; w.x = pk2(v[j].x * rs, v[j].y * rs); w.y = pk2(v[j].z * rs, v[j].w * rs); *(u32x2v*)(Al + row * SK_LDA + j * 64 + c16 * 4) = w; }
        }
        {
#pragma unroll 1
            for (int j = 0; j < 8; ++j) {
                f32x4 x[NDP]; float lp[NDP];
#pragma unroll
                for (int p = 0; p < NDP; ++p) { x[p] = *(const f32x4*)(OPART + ((size_t)row * NDP + p) * 512 + j * 64 + c16 * 4); lp[p] = LPART[((size_t)row * NDP + p) * 8 + j]; }
                f32x4 o = (f32x4){0.f, 0.f, 0.f, 0.f}; float run = 0.f;
#pragma unroll
                for (int p = NDP - 1; p >= 0; --p) { o = o + x[p] * __expf(run); run += lp[p]; }
                u32x2v w; w.x = pk2(o.x, o.y); w.y = pk2(o.z, o.w); *(u32x2v*)(Al + row * SK_LDA + 512 + j * 64 + c16 * 4) = w;
            }
        }
    }
};
struct BuildMixOdd {
    const float* O;
    const float* IN2;
    __device__ __forceinline__ void operator()(bf16* Al, float* aux, int kc) const {
        const int tid = threadIdx.x, row = tid >> 4, c16 = tid & 15;
        f32x4 v[16]; float s = 0.f;
#pragma unroll
        for (int j = 0; j < 16; ++j) { v[j] = *(const f32x4*)(O + (size_t)row * 1024 + j * 64 + c16 * 4); s += (v[j].x * v[j].x + v[j].y * v[j].y) + (v[j].z * v[j].z + v[j].w * v[j].w); }
        s += __shfl_xor(s, 1); s += __shfl_xor(s, 2); s += __shfl_xor(s, 4); s += __shfl_xor(s, 8);
        const float rs = 1.0f / sqrtf(s * (1.0f / 1024.0f) + RMS_EPS);
#pragma unroll
        for (int j = 0; j < 16; ++j) {
            const f32x4 g = *(const f32x4*)(IN2 + (size_t)row * 4096 + 3072 + j * 64 + c16 * 4);
            u32x2v w; w.x = pk2(v[j].x * rs * silu_f(g.x), v[j].y * rs * silu_f(g.y)); w.y = pk2(v[j].z * rs * silu_f(g.z), v[j].w * rs * silu_f(g.w));
            *(u32x2v*)(Al + row * SK_LDA + j * 64 + c16 * 4) = w;
        }
    }
};
struct SEpiInEven { float* IN; float* kout; float* vout;
    __device__ __forceinline__ void operator()(int row, int col, float v) const {
        IN[(size_t)row * NES + col] = v;
        if (col >= 512 && col < 1024) kout[row * 512 + col - 512] = v;
        if (col >= 1024 && col < 1536) vout[row * 512 + col - 1024] = v;
    } };
struct SEpiStore { float* O; int ldo; __device__ __forceinline__ void operator()(int row, int col, float v) const { O[(size_t)row * ldo + col] = v; } };
struct SEpiRelu2 { float* O; int ldo; __device__ __forceinline__ void operator()(int row, int col, float v) const { const float r = fmaxf(v, 0.f); O[(size_t)row * ldo + col] = r * r; } };
struct SEpiAtomic { float* h; __device__ __forceinline__ void operator()(int row, int col, float v) const { atomicAdd(h + row * 1024 + col, v); } };
struct SEpiResid { const float* hold; float* hnew; __device__ __forceinline__ void operator()(int row, int col, float v) const { hnew[row * 1024 + col] = hold[row * 1024 + col] + v; } };

template <int CTRL> __device__ __forceinline__ float dppmov(float v) { return __int_as_float(__builtin_amdgcn_mov_dpp(__float_as_int(v), CTRL, 0xF, 0xF, true)); }
__device__ __forceinline__ float red16(float z) { z += dppmov<0xB1>(z); z += dppmov<0x4E>(z); z += dppmov<0x141>(z); z += dppmov<0x140>(z); return z; }
__device__ __forceinline__ void decode_unit(unsigned char* lds, const float* IN  , const float* ck, const float* cv, const int* ptab, const float* sb_bias,
                                            float* OPART, float* LPART, int seq, int part) {
    const int tid = threadIdx.x, lane = tid & 63, wid = tid >> 6;
    const int hsub = lane >> 4, dq = (lane & 15) * 4;
    f32x4 q0 = *(const f32x4*)(IN + (size_t)seq * NES + hsub * 64 + dq), q1 = *(const f32x4*)(IN + (size_t)seq * NES + (4 + hsub) * 64 + dq);
    q0 = q0 * 0.125f; q1 = q1 * 0.125f;
    const float b0 = sb_bias[hsub], b1 = sb_bias[4 + hsub];
    const int phys = ptab[seq * NPAGES + part * 8 + wid];
    const float* kp = ck + (size_t)phys * PAGE * 512 + lane * 4;
    const float* vp = cv + (size_t)phys * PAGE * 512 + lane * 4;
    f32x4 o0 = (f32x4){0.f, 0.f, 0.f, 0.f}, o1 = o0; float a0 = 0.f, a1 = 0.f;
    f32x4 K0[DRING], K1[DRING], V0[DRING], V1[DRING];
#define DEC_LOAD(s_, tk_) do { const float* kq_ = kp + (size_t)(tk_) * 512; const float* vq_ = vp + (size_t)(tk_) * 512; \
        K0[s_] = __builtin_nontemporal_load((const f32x4*)(kq_)); K1[s_] = __builtin_nontemporal_load((const f32x4*)(kq_ + 256)); \
        V0[s_] = __builtin_nontemporal_load((const f32x4*)(vq_)); V1[s_] = __builtin_nontemporal_load((const f32x4*)(vq_ + 256)); } while (0)
#define DEC_PROC(s_) do { \
        float z0 = (K0[s_].x * q0.x + K0[s_].y * q0.y) + (K0[s_].z * q0.z + K0[s_].w * q0.w); \
        float z1 = (K1[s_].x * q1.x + K1[s_].y * q1.y) + (K1[s_].z * q1.z + K1[s_].w * q1.w); \
        z0 = red16(z0) + b0; z1 = red16(z1) + b1; \
        const float sp0 = __logf(1.0f + __expf(-fabsf(z0))), sp1 = __logf(1.0f + __expf(-fabsf(z1))); \
        const float w0 = __expf(fminf(z0, 0.f) - sp0 + a0), w1 = __expf(fminf(z1, 0.f) - sp1 + a1); \
        a0 += -fmaxf(z0, 0.f) - sp0; a1 += -fmaxf(z1, 0.f) - sp1; \
        o0 = o0 + V0[s_] * w0; o1 = o1 + V1[s_] * w1; } while (0)
    static_assert(DRING == 6 && PAGE == 128, "ring schedule: 6 slots, 128-token pages: 21 full turns (tokens 127..2), then tokens 1 and 0 are left in slots 0 and 1");
#pragma unroll
    for (int j = 0; j < DRING; ++j) DEC_LOAD(j, PAGE - 1 - j);
#pragma unroll 3
    for (int tk = PAGE - 1; tk >= 2; tk -= DRING) {
#pragma unroll
        for (int sl = 0; sl < DRING; ++sl) { DEC_PROC(sl); __builtin_amdgcn_sched_barrier(0); const int tn = tk - sl - DRING; DEC_LOAD(sl, tn < 0 ? 0 : tn); __builtin_amdgcn_sched_barrier(0); }
    }
    DEC_PROC(0); DEC_PROC(1);
#undef DEC_PROC
#undef DEC_LOAD
    float* Ow = (float*)lds;
    float* Lw = (float*)(lds + 8 * 512 * 4);
    __syncthreads();
    *(f32x4*)(Ow + wid * 512 + hsub * 64 + dq) = o0; *(f32x4*)(Ow + wid * 512 + (4 + hsub) * 64 + dq) = o1;
    if ((lane & 15) == 0) { Lw[wid * 8 + hsub] = a0; Lw[wid * 8 + 4 + hsub] = a1; }
    __syncthreads();
    {
        const int head = tid >> 6; float run = 0.f, o = 0.f;
        for (int w = 7; w >= 0; --w) { o += __expf(run) * Ow[w * 512 + tid]; run += Lw[w * 8 + head]; }
        OPART[((size_t)seq * NDP + part) * 512 + tid] = o;
        if ((tid & 63) == 0) LPART[((size_t)seq * NDP + part) * 8 + head] = run;
    }
    __syncthreads();
}
__device__ __forceinline__ void ssd_sample_unit(unsigned char* lds, const float* IN, const float* sconv, const float* sssm, const float* convw, const float* convb, const float* dtb, const float* alog,
                                                const float* dskip, float* conv_out, float* ssm_out, float* YG, int seq, int h) {
    const int tid = threadIdx.x; const int g = h >> 2;
    float* xc = (float*)lds; float* Bc = xc + 64; float* Cc = Bc + 128;
    __syncthreads();
    if (tid < 320) {
        const int c = tid < 64 ? h * 64 + tid : (tid < 192 ? 512 + g * 128 + (tid - 64) : 768 + g * 128 + (tid - 192));
        const float s0 = sconv[((size_t)seq * 3 + 0) * 1024 + c], s1 = sconv[((size_t)seq * 3 + 1) * 1024 + c], s2 = sconv[((size_t)seq * 3 + 2) * 1024 + c], xn = IN[(size_t)seq * NES + 2048 + c];
        const float cv = convb[c] + convw[c] * s0 + convw[1024 + c] * s1 + convw[2048 + c] * s2 + convw[3072 + c] * xn;
        xc[tid] = silu_f(cv);
    } else if (tid >= 384) {
        const int c = h * 128 + (tid - 384);
        conv_out[((size_t)seq * 3 + 0) * 1024 + c] = sconv[((size_t)seq * 3 + 1) * 1024 + c];
        conv_out[((size_t)seq * 3 + 1) * 1024 + c] = sconv[((size_t)seq * 3 + 2) * 1024 + c];
        conv_out[((size_t)seq * 3 + 2) * 1024 + c] = IN[(size_t)seq * NES + 2048 + c];
    }
    __syncthreads();
    const float dt = softplus_f(IN[(size_t)seq * NES + 3072 + h] + dtb[h]); const float a = -__expf(alog[h]); const float dA = __expf(dt * a);
    const int p = tid >> 3, ng = tid & 7;
    const float dtx = dt * xc[p];
    const size_t so = (((size_t)seq * 8 + h) * 64 + p) * 128 + ng * 16;
    float y = 0.f;
#pragma unroll
    for (int j = 0; j < 4; ++j) {
        f32x4 s = __builtin_nontemporal_load((const f32x4*)(sssm + so + j * 4));
        const f32x4 b = *(const f32x4*)(Bc + ng * 16 + j * 4), c = *(const f32x4*)(Cc + ng * 16 + j * 4);
        s = s * dA + b * dtx;
        __builtin_nontemporal_store(s, (f32x4*)(ssm_out + so + j * 4));
        y += (s.x * c.x + s.y * c.y) + (s.z * c.z + s.w * c.w);
    }
    y += __shfl_xor(y, 1); y += __shfl_xor(y, 2); y += __shfl_xor(y, 4);
    if (ng == 0) { const float z = IN[(size_t)seq * NES + 1536 + h * 64 + p]; YG[(size_t)seq * 512 + h * 64 + p] = (y + dskip[h] * xc[p]) * silu_f(z); }
    __syncthreads();
}
typedef float f32x16 __attribute__((ext_vector_type(16)));
constexpr int AT_KSTR = 144, AT_VSTR = 192, AT_VOFF = 64 * AT_KSTR, AT_SLOT = AT_VOFF + 64 * AT_VSTR;
__device__ __forceinline__ unsigned cvtpk(float lo, float hi) { return pg8::cvt_pk_bf16(lo, hi); }
__device__ __forceinline__ void attn_unit_mfma(unsigned char* lds, const bf16* QKV, const float* sb_bias, bf16* MIX, int b, int h, int qb) {
    const int tid = threadIdx.x, lane = tid & 63, wid = __builtin_amdgcn_readfirstlane(tid >> 6), r32 = lane & 31, hi = lane >> 5;
    const int q0 = qb * 256, tw0 = q0 + wid * 32;
    const bf16* base = QKV + (size_t)b * T * NE;
    const LAS unsigned char* L3 = (const LAS unsigned char*)lds;
    bf16x8 qf[4];
#pragma unroll
    for (int ks = 0; ks < 4; ++ks) qf[ks] = *(const bf16x8*)(base + (size_t)(tw0 + r32) * NE + h * 64 + 16 * ks + 8 * hi);
    bf16x8 tri[2];
#pragma unroll
    for (int ks = 0; ks < 2; ++ks)
#pragma unroll
        for (int j = 0; j < 8; ++j) { const int kap = 16 * ks + 8 * (j >> 2) + 4 * hi + (j & 3); tri[ks][j] = (kap >= r32) ? (short)0x3F80 : (short)0; }
    const float bias2 = sb_bias[h] * LOG2E;
    f32x16 o0, o1, biasv;
#pragma unroll
    for (int i = 0; i < 16; ++i) { o0[i] = 0.f; o1[i] = 0.f; biasv[i] = bias2; }
    float runoff = 0.f;
    const int srow = tid >> 3, sch = tid & 7;
    const int itop = qb * 4 + 3;
    v4u kreg = *(const v4u*)(base + (size_t)(64 * itop + srow) * NE + 512 + h * 64 + sch * 8);
    v4u vreg = *(const v4u*)(base + (size_t)(64 * itop + srow) * NE + 1024 + h * 64 + sch * 8);
    __syncthreads();
    *(v4u*)(lds + srow * AT_KSTR + sch * 16) = kreg; *(v4u*)(lds + AT_VOFF + srow * AT_VSTR + sch * 16) = vreg;
    __syncthreads();
    const int trq = (lane & 15) >> 2, trp = lane & 3, trg = (lane >> 4) & 1;
    const int troff = (4 * hi + trq) * AT_VSTR + (16 * trg + 4 * trp) * 2;
    int sl = 0;
    for (int i = itop; i >= 0; --i, sl ^= 1) {
        if (i > 0) {
            kreg = *(const v4u*)(base + (size_t)(64 * (i - 1) + srow) * NE + 512 + h * 64 + sch * 8);
            vreg = *(const v4u*)(base + (size_t)(64 * (i - 1) + srow) * NE + 1024 + h * 64 + sch * 8);
        }
        const int sbase = sl * AT_SLOT;
        if (64 * i + 64 <= tw0) {
            bf16x8 kfa[4], kfb[4];
#pragma unroll
            for (int ks = 0; ks < 4; ++ks) { kfa[ks] = *(const LAS bf16x8*)(L3 + sbase + (32 + r32) * AT_KSTR + (16 * ks + 8 * hi) * 2); kfb[ks] = *(const LAS bf16x8*)(L3 + sbase + r32 * AT_KSTR + (16 * ks + 8 * hi) * 2); }
            f32x16 za = biasv, zb = biasv;
#pragma unroll
            for (int ks = 0; ks < 4; ++ks) { za = __builtin_amdgcn_mfma_f32_32x32x16_bf16(kfa[ks], qf[ks], za, 0, 0, 0); zb = __builtin_amdgcn_mfma_f32_32x32x16_bf16(kfb[ks], qf[ks], zb, 0, 0, 0); }
            const LAS unsigned char* vba = L3 + sbase + AT_VOFF + 32 * AT_VSTR + troff; const LAS unsigned char* vbb = L3 + sbase + AT_VOFF + troff;
            v4i16_t vra[2][2][2], vrb[2][2][2];
#pragma unroll
            for (int mb = 0; mb < 2; ++mb)
#pragma unroll
                for (int ks = 0; ks < 2; ++ks) {
                    vra[mb][ks][0] = __builtin_amdgcn_ds_read_tr16_b64_v4i16((LAS v4i16_t*)(vba + (16 * ks) * AT_VSTR + 64 * mb)); vra[mb][ks][1] = __builtin_amdgcn_ds_read_tr16_b64_v4i16((LAS v4i16_t*)(vba + (16 * ks + 8) * AT_VSTR + 64 * mb));
                    vrb[mb][ks][0] = __builtin_amdgcn_ds_read_tr16_b64_v4i16((LAS v4i16_t*)(vbb + (16 * ks) * AT_VSTR + 64 * mb)); vrb[mb][ks][1] = __builtin_amdgcn_ds_read_tr16_b64_v4i16((LAS v4i16_t*)(vbb + (16 * ks + 8) * AT_VSTR + 64 * mb));
                }
            u32x4 la0, la1, lb0, lb1;
            {
                float La[16], Lb[16];
#pragma unroll
                for (int r = 0; r < 16; ++r) { La[r] = -__builtin_amdgcn_logf(1.0f + __builtin_amdgcn_exp2f(fminf(za[r], 126.0f))); Lb[r] = -__builtin_amdgcn_logf(1.0f + __builtin_amdgcn_exp2f(fminf(zb[r], 126.0f))); }
                la0.x = cvtpk(La[0], La[1]); la0.y = cvtpk(La[2], La[3]); la0.z = cvtpk(La[4], La[5]); la0.w = cvtpk(La[6], La[7]);
                la1.x = cvtpk(La[8], La[9]); la1.y = cvtpk(La[10], La[11]); la1.z = cvtpk(La[12], La[13]); la1.w = cvtpk(La[14], La[15]);
                lb0.x = cvtpk(Lb[0], Lb[1]); lb0.y = cvtpk(Lb[2], Lb[3]); lb0.z = cvtpk(Lb[4], Lb[5]); lb0.w = cvtpk(Lb[6], Lb[7]);
                lb1.x = cvtpk(Lb[8], Lb[9]); lb1.y = cvtpk(Lb[10], Lb[11]); lb1.z = cvtpk(Lb[12], Lb[13]); lb1.w = cvtpk(Lb[14], Lb[15]);
            }
            const float za0 = za[0], zb0 = zb[0];
            f32x16 ya = __builtin_amdgcn_mfma_f32_32x32x16_bf16(tri[0], __builtin_bit_cast(bf16x8, la0), za, 0, 0, 0);
            f32x16 yb = __builtin_amdgcn_mfma_f32_32x32x16_bf16(tri[0], __builtin_bit_cast(bf16x8, lb0), zb, 0, 0, 0);
            ya = __builtin_amdgcn_mfma_f32_32x32x16_bf16(tri[1], __builtin_bit_cast(bf16x8, la1), ya, 0, 0, 0);
            yb = __builtin_amdgcn_mfma_f32_32x32x16_bf16(tri[1], __builtin_bit_cast(bf16x8, lb1), yb, 0, 0, 0);
            const float tota = __shfl(ya[0] - za0, r32), totb = __shfl(yb[0] - zb0, r32);
            const float roa = runoff, rob = runoff + tota;
            runoff = rob + totb;
            u32x4 wa0, wa1, wb0, wb1;
            {
                float Wa[16], Wb[16];
#pragma unroll
                for (int r = 0; r < 16; ++r) { Wa[r] = __builtin_amdgcn_exp2f(ya[r] + roa); Wb[r] = __builtin_amdgcn_exp2f(yb[r] + rob); }
                wa0.x = cvtpk(Wa[0], Wa[1]); wa0.y = cvtpk(Wa[2], Wa[3]); wa0.z = cvtpk(Wa[4], Wa[5]); wa0.w = cvtpk(Wa[6], Wa[7]);
                wa1.x = cvtpk(Wa[8], Wa[9]); wa1.y = cvtpk(Wa[10], Wa[11]); wa1.z = cvtpk(Wa[12], Wa[13]); wa1.w = cvtpk(Wa[14], Wa[15]);
                wb0.x = cvtpk(Wb[0], Wb[1]); wb0.y = cvtpk(Wb[2], Wb[3]); wb0.z = cvtpk(Wb[4], Wb[5]); wb0.w = cvtpk(Wb[6], Wb[7]);
                wb1.x = cvtpk(Wb[8], Wb[9]); wb1.y = cvtpk(Wb[10], Wb[11]); wb1.z = cvtpk(Wb[12], Wb[13]); wb1.w = cvtpk(Wb[14], Wb[15]);
            }
#define AT_VF(V_, mb_, ks_) ((bf16x8){V_[mb_][ks_][0][0], V_[mb_][ks_][0][1], V_[mb_][ks_][0][2], V_[mb_][ks_][0][3], V_[mb_][ks_][1][0], V_[mb_][ks_][1][1], V_[mb_][ks_][1][2], V_[mb_][ks_][1][3]})
            o0 = __builtin_amdgcn_mfma_f32_32x32x16_bf16(AT_VF(vra, 0, 0), __builtin_bit_cast(bf16x8, wa0), o0, 0, 0, 0);
            o1 = __builtin_amdgcn_mfma_f32_32x32x16_bf16(AT_VF(vra, 1, 0), __builtin_bit_cast(bf16x8, wa0), o1, 0, 0, 0);
            o0 = __builtin_amdgcn_mfma_f32_32x32x16_bf16(AT_VF(vra, 0, 1), __builtin_bit_cast(bf16x8, wa1), o0, 0, 0, 0);
            o1 = __builtin_amdgcn_mfma_f32_32x32x16_bf16(AT_VF(vra, 1, 1), __builtin_bit_cast(bf16x8, wa1), o1, 0, 0, 0);
            o0 = __builtin_amdgcn_mfma_f32_32x32x16_bf16(AT_VF(vrb, 0, 0), __builtin_bit_cast(bf16x8, wb0), o0, 0, 0, 0);
            o1 = __builtin_amdgcn_mfma_f32_32x32x16_bf16(AT_VF(vrb, 1, 0), __builtin_bit_cast(bf16x8, wb0), o1, 0, 0, 0);
            o0 = __builtin_amdgcn_mfma_f32_32x32x16_bf16(AT_VF(vrb, 0, 1), __builtin_bit_cast(bf16x8, wb1), o0, 0, 0, 0);
            o1 = __builtin_amdgcn_mfma_f32_32x32x16_bf16(AT_VF(vrb, 1, 1), __builtin_bit_cast(bf16x8, wb1), o1, 0, 0, 0);
#undef AT_VF
        } else
#pragma unroll
        for (int sub = 1; sub >= 0; --sub) {
            const int kb = 64 * i + 32 * sub;
            if (kb <= tw0) {
                const bool diag = (kb == tw0);
                bf16x8 kf[4];
#pragma unroll
                for (int ks = 0; ks < 4; ++ks) kf[ks] = *(const LAS bf16x8*)(L3 + sbase + (sub * 32 + r32) * AT_KSTR + (16 * ks + 8 * hi) * 2);
                const LAS unsigned char* vb = L3 + sbase + AT_VOFF + sub * 32 * AT_VSTR + troff;
                v4i16_t vr[2][2][2];
#pragma unroll
                for (int mb = 0; mb < 2; ++mb)
#pragma unroll
                    for (int ks = 0; ks < 2; ++ks) {
                        vr[mb][ks][0] = __builtin_amdgcn_ds_read_tr16_b64_v4i16((LAS v4i16_t*)(vb + (16 * ks) * AT_VSTR + 64 * mb));
                        vr[mb][ks][1] = __builtin_amdgcn_ds_read_tr16_b64_v4i16((LAS v4i16_t*)(vb + (16 * ks + 8) * AT_VSTR + 64 * mb));
                    }
                asm volatile("" ::: "memory"); __builtin_amdgcn_sched_barrier(0);
                f32x16 z = biasv;
#pragma unroll
                for (int ks = 0; ks < 4; ++ks) z = __builtin_amdgcn_mfma_f32_32x32x16_bf16(kf[ks], qf[ks], z, 0, 0, 0);
                float Lv[16];
#pragma unroll
                for (int r = 0; r < 16; ++r) {
                    const float p2 = __builtin_amdgcn_exp2f(fminf(z[r], 126.0f));
                    float L = -__builtin_amdgcn_logf(1.0f + p2);
                    if (diag) { const int krow = (r & 3) + 8 * (r >> 2) + 4 * hi; if (!(krow < r32)) L = 0.f; }
                    Lv[r] = L;
                }
                u32x4 lp0, lp1;
                lp0.x = cvtpk(Lv[0], Lv[1]); lp0.y = cvtpk(Lv[2], Lv[3]); lp0.z = cvtpk(Lv[4], Lv[5]); lp0.w = cvtpk(Lv[6], Lv[7]);
                lp1.x = cvtpk(Lv[8], Lv[9]); lp1.y = cvtpk(Lv[10], Lv[11]); lp1.z = cvtpk(Lv[12], Lv[13]); lp1.w = cvtpk(Lv[14], Lv[15]);
                const float z0 = z[0];
                f32x16 y = __builtin_amdgcn_mfma_f32_32x32x16_bf16(tri[0], __builtin_bit_cast(bf16x8, lp0), z, 0, 0, 0);
                y = __builtin_amdgcn_mfma_f32_32x32x16_bf16(tri[1], __builtin_bit_cast(bf16x8, lp1), y, 0, 0, 0);
                const float tot = __shfl(y[0] - z0, r32);
                float Wv[16];
#pragma unroll
                for (int r = 0; r < 16; ++r) {
                    float w = __builtin_amdgcn_exp2f(y[r] + runoff);
                    if (diag) { const int krow = (r & 3) + 8 * (r >> 2) + 4 * hi; if (!(krow < r32)) w = 0.f; }
                    Wv[r] = w;
                }
                runoff += tot;
                u32x4 wp0, wp1;
                wp0.x = cvtpk(Wv[0], Wv[1]); wp0.y = cvtpk(Wv[2], Wv[3]); wp0.z = cvtpk(Wv[4], Wv[5]); wp0.w = cvtpk(Wv[6], Wv[7]);
                wp1.x = cvtpk(Wv[8], Wv[9]); wp1.y = cvtpk(Wv[10], Wv[11]); wp1.z = cvtpk(Wv[12], Wv[13]); wp1.w = cvtpk(Wv[14], Wv[15]);
                const bf16x8 wf0 = __builtin_bit_cast(bf16x8, wp0), wf1 = __builtin_bit_cast(bf16x8, wp1);
#pragma unroll
                for (int mb = 0; mb < 2; ++mb) {
#pragma unroll
                    for (int ks = 0; ks < 2; ++ks) {
                        const v4i16_t a0 = vr[mb][ks][0];
                        const v4i16_t a1 = vr[mb][ks][1];
                        const bf16x8 vf = (bf16x8){a0[0], a0[1], a0[2], a0[3], a1[0], a1[1], a1[2], a1[3]};
                        if (mb == 0) o0 = __builtin_amdgcn_mfma_f32_32x32x16_bf16(vf, ks == 0 ? wf0 : wf1, o0, 0, 0, 0);
                        else o1 = __builtin_amdgcn_mfma_f32_32x32x16_bf16(vf, ks == 0 ? wf0 : wf1, o1, 0, 0, 0);
                    }
                }
            }
        }
        if (i > 0) { *(v4u*)(lds + (sl ^ 1) * AT_SLOT + srow * AT_KSTR + sch * 16) = kreg; *(v4u*)(lds + (sl ^ 1) * AT_SLOT + AT_VOFF + srow * AT_VSTR + sch * 16) = vreg; }
        __syncthreads();
    }
    bf16* orow = MIX + ((size_t)b * T + tw0 + r32) * 1024 + 512 + h * 64;
#pragma unroll
    for (int g4 = 0; g4 < 4; ++g4) {
        u32x2v w0; w0.x = cvtpk(o0[4 * g4], o0[4 * g4 + 1]); w0.y = cvtpk(o0[4 * g4 + 2], o0[4 * g4 + 3]);
        u32x2v w1; w1.x = cvtpk(o1[4 * g4], o1[4 * g4 + 1]); w1.y = cvtpk(o1[4 * g4 + 2], o1[4 * g4 + 3]);
        *(u32x2v*)(orow + 8 * g4 + 4 * hi) = w0; *(u32x2v*)(orow + 32 + 8 * g4 + 4 * hi) = w1;
    }
}

__device__ __forceinline__ int off128(int row, int ch) { return 256 * row + 16 * (ch ^ (((row & 3) << 2) | ((row >> 2) & 3))); }
__device__ __forceinline__ bf16x8 ldsrow128(const LAS unsigned char* tile, int row, int ch) { return *(const LAS bf16x8*)(tile + off128(row, ch)); }
__device__ __forceinline__ bf16x8 trfrag128(const LAS unsigned char* tile, int r0a, int r0b, int colbase, int lane) {
    const int q = (lane & 15) >> 2, p = lane & 3, c0 = (colbase >> 3) + 2 * ((lane >> 4) & 1) + (p >> 1), hb = 8 * (p & 1);
    const v4i16_t a0 = __builtin_amdgcn_ds_read_tr16_b64_v4i16((LAS v4i16_t*)(tile + off128(r0a + q, c0) + hb));
    const v4i16_t a1 = __builtin_amdgcn_ds_read_tr16_b64_v4i16((LAS v4i16_t*)(tile + off128(r0b + q, c0) + hb));
    return (bf16x8){a0[0], a0[1], a0[2], a0[3], a1[0], a1[1], a1[2], a1[3]};
}
constexpr int X64_STR = 192;
__device__ __forceinline__ bf16x8 trfrag64(const LAS unsigned char* tile, int r0a, int r0b, int colbase, int lane) {
    const int q = (lane & 15) >> 2, p = lane & 3, cb = (colbase + 16 * ((lane >> 4) & 1) + 4 * p) * 2;
    const v4i16_t a0 = __builtin_amdgcn_ds_read_tr16_b64_v4i16((LAS v4i16_t*)(tile + (r0a + q) * X64_STR + cb));
    const v4i16_t a1 = __builtin_amdgcn_ds_read_tr16_b64_v4i16((LAS v4i16_t*)(tile + (r0b + q) * X64_STR + cb));
    return (bf16x8){a0[0], a0[1], a0[2], a0[3], a1[0], a1[1], a1[2], a1[3]};
}
__device__ __forceinline__ int krow16(int r, int hi) { return (r & 3) + 8 * (r >> 2) + 4 * hi; }

__device__ __forceinline__ void conv_prepass(const bf16* QKV, const float* convw, const float* convb, bf16* XC, int bid) {
    const int tid = threadIdx.x, c0 = 2 * tid;
    float w0[4], w1[4];
#pragma unroll
    for (int j = 0; j < 4; ++j) { w0[j] = convw[j * 1024 + c0]; w1[j] = convw[j * 1024 + c0 + 1]; }
    const float b0 = convb[c0], b1 = convb[c0 + 1];
    const int t0 = (bid & 31) * 64; const size_t rowb = (size_t)(bid >> 5) * T;
    const unsigned* src = (const unsigned*)(QKV + (rowb + t0) * NE + 2048 + c0);
    unsigned* dst = (unsigned*)(XC + (rowb + t0) * 1024 + c0);
    float xa[3], xb[3];
#pragma unroll
    for (int j = 0; j < 3; ++j) { unsigned u = 0u; if (t0 > 0) u = src[(long)(j - 3) * (NE / 2)]; xa[j] = bflo(u); xb[j] = bfhi(u); }
    for (int i0 = 0; i0 < 64; i0 += 16) {
        unsigned u[16];
#pragma unroll
        for (int i = 0; i < 16; ++i) u[i] = __builtin_nontemporal_load(src + (long)(i0 + i) * (NE / 2));
#pragma unroll
        for (int i = 0; i < 16; ++i) {
            const float a = bflo(u[i]), b = bfhi(u[i]);
            const float ca = b0 + w0[0] * xa[0] + w0[1] * xa[1] + w0[2] * xa[2] + w0[3] * a;
            const float cb = b1 + w1[0] * xb[0] + w1[1] * xb[1] + w1[2] * xb[2] + w1[3] * b;
            dst[(long)(i0 + i) * 512] = cvtpk(silu_fast(ca), silu_fast(cb));
            xa[0] = xa[1]; xa[1] = xa[2]; xa[2] = a; xb[0] = xb[1]; xb[1] = xb[2]; xb[2] = b;
        }
    }
}

template <int STR> __device__ __forceinline__ bf16x8 trfragS(const LAS unsigned char* tile, int r0a, int r0b, int colbase, int lane) {
    const int q = (lane & 15) >> 2, p = lane & 3, cb = (colbase + 16 * ((lane >> 4) & 1) + 4 * p) * 2;
    const v4i16_t a0 = __builtin_amdgcn_ds_read_tr16_b64_v4i16((LAS v4i16_t*)(tile + (r0a + q) * STR + cb));
    const v4i16_t a1 = __builtin_amdgcn_ds_read_tr16_b64_v4i16((LAS v4i16_t*)(tile + (r0b + q) * STR + cb));
    return (bf16x8){a0[0], a0[1], a0[2], a0[3], a1[0], a1[1], a1[2], a1[3]};
}
constexpr int SL_STR = 80;
constexpr int S2_XS = 0, S2_XW = S2_XS + 64 * SL_STR, S2_ZS = S2_XW + 64 * SL_STR, S2_BC = S2_ZS + 64 * SL_STR, S2_CC = S2_BC + 64 * 256, S2_BUF = S2_CC + 64 * 256;
constexpr int S2_HI = 2 * S2_BUF, S2_TAB = S2_HI + 2 * 32 * 256, S2_END = S2_TAB + 2 * 2048 * 4;
static_assert(S2_END <= 131072, "SSD LDS map");
__device__ __forceinline__ void ssd_unit2(unsigned char* lds, const bf16* XC, const bf16* QKV, const float* DTRAW, const float* dtb, const float* alog, const float* dskip,
                                          bf16* MIX, float* SSM, float* ssm_out, int b, int h, int pb) {
    const int tid = threadIdx.x, lane = tid & 63, wid = __builtin_amdgcn_readfirstlane(tid >> 6), r32 = lane & 31, hi = lane >> 5; const int g = h >> 2;
    const LAS unsigned char* L3 = (const LAS unsigned char*)lds;
    const float a2 = -__expf(alog[h]) * LOG2E, dtbias = dtb[h], dsk = dskip[h];
    const size_t rowb = (size_t)b * T;
    float* dtT = (float*)(lds + S2_TAB); float* cumT = dtT + 2048;
    f32x16 hacc;
#pragma unroll
    for (int i = 0; i < 16; ++i) hacc[i] = 0.f;
    const int srow = tid >> 3, sch = tid & 7;
    const int t2 = tid & 255, lrow = t2 >> 2, lch = t2 & 3; const bool ldx = tid < 256;
    __syncthreads();
    float dtr[4];
#pragma unroll
    for (int q = 0; q < 4; ++q) dtr[q] = DTRAW[(rowb + (wid + 8 * q) * 64 + lane) * 8 + h];
#pragma unroll
    for (int q = 0; q < 4; ++q) { const int cc = wid + 8 * q;
        const float dt = softplus_f(dtr[q] + dtbias); float cs = dt * a2;
#pragma unroll
        for (int o = 1; o < 64; o <<= 1) { const float t = __shfl_up(cs, o); if (lane >= o) cs += t; }
        dtT[cc * 64 + lane] = dt; cumT[cc * 64 + lane] = cs;
    }
    *(v4u*)(lds + S2_HI + tid * 16) = (v4u){0u, 0u, 0u, 0u};
    v4u rs_, rb0, rb1, rc0, rc1;
#define S2_LOAD(c_) do { const size_t rn_ = rowb + (size_t)(c_) * 64; \
        rs_ = ldx ? *(const v4u*)(XC + (rn_ + lrow) * 1024 + h * 64 + pb * 32 + lch * 8) : *(const v4u*)(QKV + (rn_ + lrow) * NE + 1536 + h * 64 + pb * 32 + lch * 8); \
        rb0 = *(const v4u*)(XC + (rn_ + srow) * 1024 + 512 + g * 128 + sch * 8); rb1 = *(const v4u*)(XC + (rn_ + srow) * 1024 + 512 + g * 128 + 64 + sch * 8); \
        rc0 = *(const v4u*)(XC + (rn_ + srow) * 1024 + 768 + g * 128 + sch * 8); rc1 = *(const v4u*)(XC + (rn_ + srow) * 1024 + 768 + g * 128 + 64 + sch * 8); } while (0)
#define S2_STORE(c_, buf_) do { unsigned char* B_ = lds + (buf_) * S2_BUF; \
        if (ldx) { const float wst = __builtin_amdgcn_exp2f(cumT[(c_) * 64 + 63] - cumT[(c_) * 64 + lrow]) * dtT[(c_) * 64 + lrow]; \
            *(v4u*)(B_ + S2_XS + lrow * SL_STR + lch * 16) = rs_; \
            v4u xw; xw.x = cvtpk(bflo(rs_.x) * wst, bfhi(rs_.x) * wst); xw.y = cvtpk(bflo(rs_.y) * wst, bfhi(rs_.y) * wst); xw.z = cvtpk(bflo(rs_.z) * wst, bfhi(rs_.z) * wst); xw.w = cvtpk(bflo(rs_.w) * wst, bfhi(rs_.w) * wst); \
            *(v4u*)(B_ + S2_XW + lrow * SL_STR + lch * 16) = xw; } \
        else *(v4u*)(B_ + S2_ZS + lrow * SL_STR + lch * 16) = rs_; \
        *(v4u*)(B_ + S2_BC + off128(srow, sch)) = rb0; *(v4u*)(B_ + S2_BC + off128(srow, 8 + sch)) = rb1; \
        *(v4u*)(B_ + S2_CC + off128(srow, sch)) = rc0; *(v4u*)(B_ + S2_CC + off128(srow, 8 + sch)) = rc1; } while (0)
    S2_LOAD(0);
    __syncthreads();
    S2_STORE(0, 0);
    __syncthreads();
    for (int c = 0; c < T / 64; ++c) {
        const int cur = c & 1; const size_t row0 = rowb + (size_t)c * 64;
        const LAS unsigned char* Bf = L3 + cur * S2_BUF;
        const LAS unsigned char* HIc = L3 + S2_HI + cur * 8192;
        if (c + 1 < T / 64) S2_LOAD(c + 1);
        if (wid < 2) {
            const int tbk = wid;
            bf16x8 cf[8], af[8];
#pragma unroll
            for (int ks = 0; ks < 8; ++ks) cf[ks] = ldsrow128(Bf + S2_CC, tbk * 32 + r32, 2 * ks + hi);
            const float cumt = cumT[c * 64 + tbk * 32 + r32];
            f32x16 y;
#pragma unroll
            for (int i = 0; i < 16; ++i) y[i] = 0.f;
#pragma unroll
            for (int ks = 0; ks < 8; ++ks) af[ks] = ldsrow128(HIc, r32, 2 * ks + hi);
            asm volatile("" ::: "memory"); __builtin_amdgcn_sched_barrier(0);
#pragma unroll
            for (int ks = 0; ks < 8; ++ks) y = __builtin_amdgcn_mfma_f32_32x32x16_bf16(af[ks], cf[ks], y, 0, 0, 0);
            { const float e = __builtin_amdgcn_exp2f(cumt);
#pragma unroll
              for (int i = 0; i < 16; ++i) y[i] *= e; }
#pragma unroll
            for (int sb = 0; sb < 2; ++sb) {
                if (sb <= tbk) {
                    f32x16 s;
#pragma unroll
                    for (int i = 0; i < 16; ++i) s[i] = 0.f;
#pragma unroll
                    for (int ks = 0; ks < 8; ++ks) af[ks] = ldsrow128(Bf + S2_BC, sb * 32 + r32, 2 * ks + hi);
                    const bf16x8 xt0 = trfragS<SL_STR>(Bf + S2_XS, sb * 32 + 4 * hi, sb * 32 + 8 + 4 * hi, 0, lane), xt1 = trfragS<SL_STR>(Bf + S2_XS, sb * 32 + 16 + 4 * hi, sb * 32 + 24 + 4 * hi, 0, lane);
                    asm volatile("" ::: "memory"); __builtin_amdgcn_sched_barrier(0);
#pragma unroll
                    for (int ks = 0; ks < 8; ++ks) s = __builtin_amdgcn_mfma_f32_32x32x16_bf16(af[ks], cf[ks], s, 0, 0, 0);
                    float pv[16];
#pragma unroll
                    for (int q4 = 0; q4 < 4; ++q4) {
                        const f32x4 cs = *(const f32x4*)(cumT + c * 64 + sb * 32 + 8 * q4 + 4 * hi), ds = *(const f32x4*)(dtT + c * 64 + sb * 32 + 8 * q4 + 4 * hi);
#pragma unroll
                        for (int e = 0; e < 4; ++e) {
                            const int r = 4 * q4 + e; const int kr = 8 * q4 + 4 * hi + e;
                            float v = s[r] * __builtin_amdgcn_exp2f(fminf(cumt - cs[e], 0.f)) * ds[e];
                            if (sb == tbk && kr > r32) v = 0.f;
                            pv[r] = v;
                        }
                    }
                    u32x4 p0, p1;
                    p0.x = cvtpk(pv[0], pv[1]); p0.y = cvtpk(pv[2], pv[3]); p0.z = cvtpk(pv[4], pv[5]); p0.w = cvtpk(pv[6], pv[7]);
                    p1.x = cvtpk(pv[8], pv[9]); p1.y = cvtpk(pv[10], pv[11]); p1.z = cvtpk(pv[12], pv[13]); p1.w = cvtpk(pv[14], pv[15]);
                    y = __builtin_amdgcn_mfma_f32_32x32x16_bf16(xt0, __builtin_bit_cast(bf16x8, p0), y, 0, 0, 0);
                    y = __builtin_amdgcn_mfma_f32_32x32x16_bf16(xt1, __builtin_bit_cast(bf16x8, p1), y, 0, 0, 0);
                }
            }
            const int tl = tbk * 32 + r32; const size_t row = row0 + tl; float sq = 0.f;
#pragma unroll
            for (int q4 = 0; q4 < 4; ++q4) {
                const int p0 = 8 * q4 + 4 * hi;
                const u32x2v xr = *(const LAS u32x2v*)(Bf + S2_XS + tl * SL_STR + p0 * 2);
                const u32x2v zr = *(const LAS u32x2v*)(Bf + S2_ZS + tl * SL_STR + p0 * 2);
                const float o0 = (y[4 * q4 + 0] + dsk * bflo(xr.x)) * silu_fast(bflo(zr.x)), o1 = (y[4 * q4 + 1] + dsk * bfhi(xr.x)) * silu_fast(bfhi(zr.x));
                const float o2 = (y[4 * q4 + 2] + dsk * bflo(xr.y)) * silu_fast(bflo(zr.y)), o3 = (y[4 * q4 + 3] + dsk * bfhi(xr.y)) * silu_fast(bfhi(zr.y));
                u32x2v w; w.x = cvtpk(o0, o1); w.y = cvtpk(o2, o3);
                *(u32x2v*)(MIX + row * 1024 + h * 64 + pb * 32 + p0) = w;
                sq += (o0 * o0 + o1 * o1) + (o2 * o2 + o3 * o3);
            }
            sq += __shfl_xor(sq, 32);
            if (hi == 0) SSM[row * 32 + h * 2 + pb] = sq;
        } else if (wid < 6) {
            const int nb = wid - 2;
            const float e = __builtin_amdgcn_exp2f(cumT[c * 64 + 63]);
#pragma unroll
            for (int i = 0; i < 16; ++i) hacc[i] *= e;
            bf16x8 xa[4], bb[4];
#pragma unroll
            for (int ks = 0; ks < 4; ++ks) { xa[ks] = trfragS<SL_STR>(Bf + S2_XW, 16 * ks + 8 * hi, 16 * ks + 8 * hi + 4, 0, lane); bb[ks] = trfrag128(Bf + S2_BC, 16 * ks + 8 * hi, 16 * ks + 8 * hi + 4, nb * 32, lane); }
            asm volatile("" ::: "memory"); __builtin_amdgcn_sched_barrier(0);
#pragma unroll
            for (int ks = 0; ks < 4; ++ks) hacc = __builtin_amdgcn_mfma_f32_32x32x16_bf16(xa[ks], bb[ks], hacc, 0, 0, 0);
            unsigned char* HIn = lds + S2_HI + (cur ^ 1) * 8192; const int n = nb * 32 + r32;
#pragma unroll
            for (int r = 0; r < 16; r += 2) { const unsigned pkv = cvtpk(hacc[r], hacc[r + 1]); const int p = krow16(r, hi);
                *(bf16*)(HIn + off128(p, n >> 3) + (n & 7) * 2) = (bf16)(pkv & 0xffffu); *(bf16*)(HIn + off128(p + 1, n >> 3) + (n & 7) * 2) = (bf16)(pkv >> 16); }
        }
        if (c + 1 < T / 64) S2_STORE(c + 1, cur ^ 1);
        __syncthreads();
    }
#undef S2_LOAD
#undef S2_STORE
    if (wid >= 2 && wid < 6) {
        const int n = (wid - 2) * 32 + r32;
#pragma unroll
        for (int r = 0; r < 16; ++r) { const int p = pb * 32 + krow16(r, hi); ssm_out[(((size_t)b * 8 + h) * 64 + p) * 128 + n] = hacc[r]; }
    }
    __syncthreads();
}

__device__ __forceinline__ void hgrn_prepass(const bf16* IN2, const float* lbraw, bf16* QP, bf16* KP, float* DL, int bid) {
    const int tid = threadIdx.x, c0 = 2 * tid;
    const float lb0 = sigmoid_f(lbraw[1024 + c0] - lbraw[c0]), lb1 = sigmoid_f(lbraw[1024 + c0 + 1] - lbraw[c0 + 1]);
    const size_t row0 = (size_t)bid * 64;
    const unsigned* qs = (const unsigned*)(IN2 + row0 * 4096 + c0); const unsigned* fs = (const unsigned*)(IN2 + row0 * 4096 + 1024 + c0);
    unsigned* qd = (unsigned*)(QP + row0 * 1024 + c0); unsigned* kd = (unsigned*)(KP + row0 * 1024 + c0);
    float r0 = 0.f, r1 = 0.f;
    for (int i0 = 0; i0 < 64; i0 += 16) {
        unsigned uq[16], uf[16];
#pragma unroll
        for (int i = 0; i < 16; ++i) { uq[i] = __builtin_nontemporal_load(qs + (long)(i0 + i) * 2048); uf[i] = __builtin_nontemporal_load(fs + (long)(i0 + i) * 2048); }
#pragma unroll
        for (int i = 0; i < 16; ++i) {
            const float f0 = lb0 + (1.0f - lb0) * sigmoid_f(bflo(uf[i])), f1 = lb1 + (1.0f - lb1) * sigmoid_f(bfhi(uf[i]));
            r0 += __builtin_amdgcn_logf(f0); r1 += __builtin_amdgcn_logf(f1);
            const float e0 = __builtin_amdgcn_exp2f(r0), e1 = __builtin_amdgcn_exp2f(r1);
            const float i0v = __builtin_amdgcn_exp2f(fminf(-r0, 120.f)), i1v = __builtin_amdgcn_exp2f(fminf(-r1, 120.f));
            qd[(long)(i0 + i) * 512] = pk2(bflo(uq[i]) * e0, bfhi(uq[i]) * e1);
            kd[(long)(i0 + i) * 512] = pk2((1.0f - f0) * i0v, (1.0f - f1) * i1v);
        }
    }
    *(f32x2v*)(DL + (size_t)bid * 1024 + c0) = (f32x2v){__builtin_amdgcn_exp2f(r0), __builtin_amdgcn_exp2f(r1)};
}
constexpr int H2_QP = 0, H2_KP = H2_QP + 64 * 256, H2_VS = H2_KP + 64 * 256, H2_GS = H2_VS + 64 * SL_STR, H2_DL = H2_GS + 64 * SL_STR, H2_BUF = H2_DL + 512;
constexpr int H2_ST = 2 * H2_BUF, H2_END = H2_ST + 2 * 32 * 256;
static_assert(H2_END <= 131072, "HGRN LDS map");
__device__ __forceinline__ void hgrn_body(unsigned char* lds, const LAS unsigned char* Bf, const LAS unsigned char* STc, int cur, size_t row0, int h, int vq, int wid, int lane, int r32, int hi,
                                          f32x16& sacc, bf16* MIX, float* SSM) {
        if (wid < 2) {
            const int tbk = wid;
            bf16x8 qf[8], af[4];
#pragma unroll
            for (int ks = 0; ks < 8; ++ks) qf[ks] = ldsrow128(Bf + H2_QP, tbk * 32 + r32, 2 * ks + hi);
            f32x16 o;
#pragma unroll
            for (int i = 0; i < 16; ++i) o[i] = 0.f;
#pragma unroll
            for (int kh = 0; kh < 2; ++kh) {
#pragma unroll
                for (int ks = 0; ks < 4; ++ks) af[ks] = ldsrow128(STc, r32, 2 * (4 * kh + ks) + hi);
                asm volatile("" ::: "memory"); __builtin_amdgcn_sched_barrier(0);
#pragma unroll
                for (int ks = 0; ks < 4; ++ks) o = __builtin_amdgcn_mfma_f32_32x32x16_bf16(af[ks], qf[4 * kh + ks], o, 0, 0, 0);
            }
#pragma unroll
            for (int sb = 0; sb < 2; ++sb) {
                if (sb <= tbk) {
                    f32x16 s;
#pragma unroll
                    for (int i = 0; i < 16; ++i) s[i] = 0.f;
#pragma unroll
                    for (int kh = 0; kh < 2; ++kh) {
#pragma unroll
                        for (int ks = 0; ks < 4; ++ks) af[ks] = ldsrow128(Bf + H2_KP, sb * 32 + r32, 2 * (4 * kh + ks) + hi);
                        asm volatile("" ::: "memory"); __builtin_amdgcn_sched_barrier(0);
#pragma unroll
                        for (int ks = 0; ks < 4; ++ks) s = __builtin_amdgcn_mfma_f32_32x32x16_bf16(af[ks], qf[4 * kh + ks], s, 0, 0, 0);
                    }
                    const bf16x8 vt0 = trfragS<SL_STR>(Bf + H2_VS, sb * 32 + 4 * hi, sb * 32 + 8 + 4 * hi, 0, lane), vt1 = trfragS<SL_STR>(Bf + H2_VS, sb * 32 + 16 + 4 * hi, sb * 32 + 24 + 4 * hi, 0, lane);
                    if (sb == tbk) {
#pragma unroll
                        for (int r = 0; r < 16; ++r) if (krow16(r, hi) > r32) s[r] = 0.f;
                    }
                    u32x4 p0, p1;
                    p0.x = cvtpk(s[0], s[1]); p0.y = cvtpk(s[2], s[3]); p0.z = cvtpk(s[4], s[5]); p0.w = cvtpk(s[6], s[7]);
                    p1.x = cvtpk(s[8], s[9]); p1.y = cvtpk(s[10], s[11]); p1.z = cvtpk(s[12], s[13]); p1.w = cvtpk(s[14], s[15]);
                    o = __builtin_amdgcn_mfma_f32_32x32x16_bf16(vt0, __builtin_bit_cast(bf16x8, p0), o, 0, 0, 0);
                    o = __builtin_amdgcn_mfma_f32_32x32x16_bf16(vt1, __builtin_bit_cast(bf16x8, p1), o, 0, 0, 0);
                }
            }
            const int tl = tbk * 32 + r32; const size_t row = row0 + tl; float sq = 0.f;
#pragma unroll
            for (int q4 = 0; q4 < 4; ++q4) {
                const int v0 = 8 * q4 + 4 * hi;
                const u32x2v gr = *(const LAS u32x2v*)(Bf + H2_GS + tl * SL_STR + v0 * 2);
                const float o0 = o[4 * q4], o1 = o[4 * q4 + 1], o2 = o[4 * q4 + 2], o3 = o[4 * q4 + 3];
                u32x2v w; w.x = cvtpk(o0 * silu_fast(bflo(gr.x)), o1 * silu_fast(bfhi(gr.x))); w.y = cvtpk(o2 * silu_fast(bflo(gr.y)), o3 * silu_fast(bfhi(gr.y)));
                *(u32x2v*)(MIX + row * 1024 + h * 128 + vq * 32 + v0) = w;
                sq += (o0 * o0 + o1 * o1) + (o2 * o2 + o3 * o3);
            }
            sq += __shfl_xor(sq, 32);
            if (hi == 0) SSM[row * 32 + h * 4 + vq] = sq;
        } else if (wid < 6) {
            const int kb = wid - 2;
            bf16x8 ka[4], vb4[4];
#pragma unroll
            for (int ks = 0; ks < 4; ++ks) { ka[ks] = trfrag128(Bf + H2_KP, 16 * ks + 8 * hi, 16 * ks + 8 * hi + 4, kb * 32, lane); vb4[ks] = trfragS<SL_STR>(Bf + H2_VS, 16 * ks + 8 * hi, 16 * ks + 8 * hi + 4, 0, lane); }
            asm volatile("" ::: "memory"); __builtin_amdgcn_sched_barrier(0);
#pragma unroll
            for (int ks = 0; ks < 4; ++ks) sacc = __builtin_amdgcn_mfma_f32_32x32x16_bf16(ka[ks], vb4[ks], sacc, 0, 0, 0);
            unsigned char* STn = lds + H2_ST + (cur ^ 1) * 8192;
#pragma unroll
            for (int q4 = 0; q4 < 4; ++q4) {
                const f32x4 d = *(const LAS f32x4*)(Bf + H2_DL + (kb * 32 + 8 * q4 + 4 * hi) * 4);
#pragma unroll
                for (int e = 0; e < 4; ++e) sacc[4 * q4 + e] *= d[e];
                u32x2v w; w.x = cvtpk(sacc[4 * q4], sacc[4 * q4 + 1]); w.y = cvtpk(sacc[4 * q4 + 2], sacc[4 * q4 + 3]);
                *(u32x2v*)(STn + off128(r32, 4 * kb + q4) + 8 * hi) = w;
            }
        }
}
__device__ __forceinline__ void hgrn_unit2(unsigned char* lds, const bf16* QP, const bf16* KP, const float* DL, const bf16* IN2, bf16* MIX, float* SSM, float* hg_out, int b, int h, int vq) {
    const int tid = threadIdx.x, lane = tid & 63, wid = __builtin_amdgcn_readfirstlane(tid >> 6), r32 = lane & 31, hi = lane >> 5;
    const LAS unsigned char* L3 = (const LAS unsigned char*)lds;
    const size_t rowb = (size_t)b * T;
    f32x16 sacc;
#pragma unroll
    for (int i = 0; i < 16; ++i) sacc[i] = 0.f;
    const bool loader = tid >= 256; const int u = tid & 255;
    const int qrow = u >> 4, qch = u & 15, vrow = u >> 2, vch = u & 3;
    __syncthreads();
    *(v4u*)(lds + H2_ST + tid * 16) = (v4u){0u, 0u, 0u, 0u};
    v4u rq[4], rk[4], rv, rg; float rdl = 0.f;
#define H2_LOAD(c_) do { if (loader) { const size_t rn_ = rowb + (size_t)(c_) * 64; \
        _Pragma("unroll") for (int j = 0; j < 4; ++j) { rq[j] = *(const v4u*)(QP + (rn_ + qrow + 16 * j) * 1024 + h * 128 + qch * 8); rk[j] = *(const v4u*)(KP + (rn_ + qrow + 16 * j) * 1024 + h * 128 + qch * 8); } \
        rv = *(const v4u*)(IN2 + (rn_ + vrow) * 4096 + 2048 + h * 128 + vq * 32 + vch * 8); rg = *(const v4u*)(IN2 + (rn_ + vrow) * 4096 + 3072 + h * 128 + vq * 32 + vch * 8); \
        if (u < 128) rdl = DL[((size_t)b * 32 + (c_)) * 1024 + h * 128 + u]; } } while (0)
#define H2_STORE(buf_) do { if (loader) { unsigned char* B_ = lds + (buf_) * H2_BUF; \
        _Pragma("unroll") for (int j = 0; j < 4; ++j) { *(v4u*)(B_ + H2_QP + off128(qrow + 16 * j, qch)) = rq[j]; *(v4u*)(B_ + H2_KP + off128(qrow + 16 * j, qch)) = rk[j]; } \
        *(v4u*)(B_ + H2_VS + vrow * SL_STR + vch * 16) = rv; *(v4u*)(B_ + H2_GS + vrow * SL_STR + vch * 16) = rg; \
        if (u < 128) *(float*)(B_ + H2_DL + u * 4) = rdl; } } while (0)
    H2_LOAD(0);
    H2_STORE(0);
    __syncthreads();
    for (int c = 0; c < T / 64; ++c) {
        const int cur = c & 1;
        if (c + 1 < T / 64) H2_LOAD(c + 1);
        hgrn_body(lds, L3 + cur * H2_BUF, L3 + H2_ST + cur * 8192, cur, rowb + (size_t)c * 64, h, vq, wid, lane, r32, hi, sacc, MIX, SSM);
        if (c + 1 < T / 64) H2_STORE(cur ^ 1);
        __syncthreads();
    }
#undef H2_LOAD
#undef H2_STORE
    if (wid >= 2 && wid < 6) {
        const int kb = wid - 2;
#pragma unroll
        for (int r = 0; r < 16; ++r) { const int k = kb * 32 + krow16(r, hi); hg_out[(((size_t)b * 8 + h) * 128 + k) * 128 + vq * 32 + r32] = sacc[r]; }
    }
    __syncthreads();
}

__device__ __forceinline__ void hgrn_sample_unit(unsigned char* lds, const float* IN2  , const float* shg, const float* lbraw, float* hg_out, float* SO, int seq, int h) {
    const int tid = threadIdx.x;
    float* fT = (float*)lds; float* qT = fT + 128; float* red = qT + 128;
    __syncthreads();
    if (tid < 128) {
        const float lb = sigmoid_f(lbraw[1024 + h * 128 + tid] - lbraw[h * 128 + tid]);
        fT[tid] = lb + (1.0f - lb) * sigmoid_f(IN2[(size_t)seq * 4096 + 1024 + h * 128 + tid]);
        qT[tid] = IN2[(size_t)seq * 4096 + h * 128 + tid];
    }
    __syncthreads();
    const int v = tid & 127, kq = tid >> 7;
    const float vt = IN2[(size_t)seq * 4096 + 2048 + h * 128 + v]; float o = 0.f;
    for (int k0 = 0; k0 < 32; k0 += 16) {
        float sv[16];
#pragma unroll
        for (int kk = 0; kk < 16; ++kk) sv[kk] = __builtin_nontemporal_load(shg + (((size_t)seq * 8 + h) * 128 + kq * 32 + k0 + kk) * 128 + v);
#pragma unroll
        for (int kk = 0; kk < 16; ++kk) {
            const int k = kq * 32 + k0 + kk; const size_t off = (((size_t)seq * 8 + h) * 128 + k) * 128 + v;
            const float f = fT[k]; const float s = f * sv[kk] + (1.0f - f) * vt;
            __builtin_nontemporal_store(s, hg_out + off); o += s * qT[k];
        }
    }
    red[kq * 128 + v] = o;
    __syncthreads();
    if (tid < 128) SO[(size_t)seq * 1024 + h * 128 + tid] = (red[tid] + red[128 + tid]) + (red[256 + tid] + red[384 + tid]);
    __syncthreads();
}

__global__ void __launch_bounds__(NTHR, 2) mk_fwd(Args args) {
    extern __shared__ __attribute__((aligned(16))) unsigned char lds[];
    const int tid = threadIdx.x, lane = tid & 63, wave = __builtin_amdgcn_readfirstlane(tid >> 6);
    const int G = gridDim.x, bid = blockIdx.x;
    LAS unsigned char* ldsl = (LAS unsigned char*)lds;
    volatile LAS unsigned* MISC = (volatile LAS unsigned*)(ldsl + MISC_OFF);
    unsigned char* ws = args.ws;
    gu32* ctl = (gu32*)(ws + WS_CTL);
    for (int u = tid; u < (LDS_BYTES - RING_BYTES) / 4; u += NTHR) ((LAS unsigned*)(ldsl + RING_BYTES))[u] = 0u;
    __syncthreads();
    const int lo = args.ph_lo, hi = args.ph_hi;
    const bool multi = (hi - lo) > 1;
    XcdBarrier bar; bar.bar = (unsigned*)(ctl + CW_BAR); bar.x = 0; bar.st = nullptr;
    if (multi) bar = xcd_barrier_post((unsigned*)(ctl + CW_BAR), MISC + 8);
#ifndef REP_MASK
#define REP_MASK 0
#endif
#if defined(PROBE_A0)
#define PROBE_STAMP(k) do { if (bid == 0 && tid == 0) ((unsigned long long*)(ctl + CW_TS))[k] = __builtin_amdgcn_s_memrealtime(); } while (0)
#define PROBE_STAMP1(k) do { if (bid == 1 && tid == 0) ((unsigned long long*)(ctl + CW_TS))[k] = __builtin_amdgcn_s_memrealtime(); } while (0)
#else
#define PROBE_STAMP(k) do { } while (0)
#define PROBE_STAMP1(k) do { } while (0)
#endif
#define NREP(k) ((((REP_MASK) >> (k)) & 1) ? 2 : 1)
#ifdef ONLY_PH
#define IN(k) ((k) == ONLY_PH && lo <= (k) && (k) < hi)
#else
#define IN(k) (lo <= (k) && (k) < hi)
#endif
#define SEAM(k) do { if (IN(k) && IN((k) + 1)) xcd_barrier(bar); } while (0)
#define x_p ((const float*)args.in[I_XP])
#define x_s ((const float*)args.in[I_XS])
#define cache_k ((const float*)args.in[I_CK])
#define cache_v ((const float*)args.in[I_CV])
#define ptab ((const int*)args.in[I_PT])
#define s_conv ((const float*)args.in[I_SCONV])
#define s_ssm ((const float*)args.in[I_SSSM])
#define s_hg ((const float*)args.in[I_SHG])
#define n_mix ((const float*)args.in[I_NMIX])
#define n_ffn ((const float*)args.in[I_NFFN])
#define n_fin ((const float*)args.in[I_NFIN])
#define w_ine ((const float*)args.in[I_WINE])
#define sb_bias ((const float*)args.in[I_SBB])
#define conv_w ((const float*)args.in[I_CONVW])
#define conv_b ((const float*)args.in[I_CONVB])
#define dt_bias ((const float*)args.in[I_DTB])
#define a_log ((const float*)args.in[I_ALOG])
#define d_skip ((const float*)args.in[I_DSKIP])
#define ssd_norm ((const float*)args.in[I_SSDN])
#define w_oute ((const float*)args.in[I_WOUTE])
#define w_ino ((const float*)args.in[I_WINO])
#define lb_raw ((const float*)args.in[I_LBRAW])
#define hg_norm ((const float*)args.in[I_HGN])
#define w_outo ((const float*)args.in[I_WOUTO])
#define w_ff1 ((const float*)args.in[I_W1])
#define w_ff2 ((const float*)args.in[I_W2])
#define out (args.out)
#define WINE ((bf16*)(ws + WS_WINE))
#define WOUTE ((bf16*)(ws + WS_WOUTE))
#define WINO ((bf16*)(ws + WS_WINO))
#define WOUTO ((bf16*)(ws + WS_WOUTO))
#define W1T ((bf16*)(ws + WS_W1))
#define W2T ((bf16*)(ws + WS_W2))
#define HB ((bf16*)(ws + WS_HB))
#define H ((float*)(ws + WS_H))
#define SSQ ((float*)(ws + WS_SSQ))
#define DTRAW ((float*)(ws + WS_DTRAW))
#define SSM ((float*)(ws + WS_SSM))
#define MIX ((bf16*)(ws + WS_MIX))
#define QKV ((bf16*)(ws + WS_QKV))
#define HID ((bf16*)(ws + WS_HID))
#define S_H ((float*)(ws + WS_SMP + SM_H))
#define S_IN ((float*)(ws + WS_SMP + SM_IN))
#define S_HID ((float*)(ws + WS_SMP + SM_HID))
#define S_YG ((float*)(ws + WS_SMP + SM_YG))
#define S_OPART ((float*)(ws + WS_SMP + SM_OPART))
#define S_LPART ((float*)(ws + WS_SMP + SM_LPART))
#define S_O ((float*)(ws + WS_SMP + SM_O))

    LAS float* rstab = (LAS float*)(ldsl + RING_BYTES + 2048);
    LAS float* midtab = (LAS float*)(ldsl + RING_BYTES + 1024);
#define RSTAB_FILL(S_, SRC_, NP_, INV_) do {   \
        pg8::Unit u_[4]; bool has_[4]; _Pragma("unroll") for (int i_ = 0; i_ < 4; ++i_) has_[i_] = (S_).next(i_, u_[i_]); \
        if (tid < 256) { f32x4 pp_[4][NP_ / 4]; \
            _Pragma("unroll") for (int i_ = 0; i_ < 4; ++i_) if (has_[i_]) { _Pragma("unroll") for (int q_ = 0; q_ < NP_ / 4; ++q_) pp_[i_][q_] = ((const f32x4*)((SRC_) + (size_t)(u_[i_].pm * 256 + tid) * NP_))[q_]; } \
            _Pragma("unroll") for (int i_ = 0; i_ < 4; ++i_) if (has_[i_]) { float sm_ = 0.f; _Pragma("unroll") for (int q_ = 0; q_ < NP_ / 4; ++q_) sm_ += pg8::sum4(pp_[i_][q_]); \
                rstab[i_ * 256 + tid] = 1.0f / sqrtf(sm_ * (INV_) + RMS_EPS); } } \
        } while (0)
    PROBE_STAMP(0);
    if (IN(0)) for (int rep = 0; rep < NREP(0); ++rep) {
        LAS float* scr = (LAS float*)(ldsl + wave * 16384);
        const int gw = bid * NWAVES + wave, NGW = G * NWAVES;
        constexpr int I_INE = (D / 64) * (NES / 32), I_SQ = (D / 64) * (D / 32), I_4K = (D / 64) * (FF / 32), I_DN = (FF / 64) * (D / 32);
        constexpr int NITEMS = I_INE + I_SQ + I_4K + I_SQ + 2 * I_4K + 2 * I_DN;
        {
            constexpr int F_INE = 16 * 24, F_SQ = 16 * 8, F_4K = 16 * 32, F_DN = 64 * 8;
            constexpr int NHALF = 2 * (F_INE + F_SQ + F_4K + F_SQ + 2 * F_4K + 2 * F_DN);
#define P0W_DESC(idx_) ({ int r_ = (idx_) >> 1; const int hf_ = (idx_) & 1; P0W d_; int nbk_; \
            if (r_ < F_INE) { d_ = P0W{w_ine, WINE, n_mix, D, EVEN_IN, 0, 0, 0, 0}; nbk_ = 24; } \
            else if ((r_ -= F_INE) < F_SQ) { d_ = P0W{w_oute, WOUTE, ssd_norm, D, D, 512, 512, 0, 0}; nbk_ = 8; } \
            else if ((r_ -= F_SQ) < F_4K) { d_ = P0W{w_ino, WINO, n_mix + 1024, D, ODD_IN, 0, 0, 0, 0}; nbk_ = 32; } \
            else if ((r_ -= F_4K) < F_SQ) { d_ = P0W{w_outo, WOUTO, hg_norm, D, D, 0, 0, 0, 0}; nbk_ = 8; } \
            else if ((r_ -= F_SQ) < F_4K) { d_ = P0W{w_ff1, W1T, n_ffn, D, FF, 0, 0, 0, 0}; nbk_ = 32; } \
            else if ((r_ -= F_4K) < F_4K) { d_ = P0W{w_ff1 + (size_t)D * FF, W1T + (size_t)FF * D, n_ffn + 1024, D, FF, 0, 0, 0, 0}; nbk_ = 32; } \
            else if ((r_ -= F_4K) < F_DN) { d_ = P0W{w_ff2, W2T, nullptr, FF, D, 0, 0, 0, 0}; nbk_ = 8; } \
            else { r_ -= F_DN; d_ = P0W{w_ff2 + (size_t)FF * D, W2T + (size_t)D * FF, nullptr, FF, D, 0, 0, 0, 0}; nbk_ = 8; } \
            d_.kb32 = 2 * (r_ / nbk_) + hf_; d_.nb = r_ % nbk_; d_.late = 0; d_; })
            unsigned char* wscr = lds + wave * (32 * P0W_STR);
            f32x4 va[16], vb[16]; float sa = 1.f, sb = 1.f;
            int it = gw;
            P0W da = P0W_DESC(it < NHALF ? it : 0), db = da;
            if (it < NHALF) p0w_load(da, va, sa, lane);
            for (; it < NHALF; it += 2 * NGW) {
                const bool hb_ = it + NGW < NHALF;
                if (hb_) { db = P0W_DESC(it + NGW); p0w_load(db, vb, sb, lane); }
                p0w_store(da, va, sa, wscr, lane);
                const bool ha_ = it + 2 * NGW < NHALF;
                if (ha_) { da = P0W_DESC(it + 2 * NGW); p0w_load(da, va, sa, lane); }
                if (hb_) p0w_store(db, vb, sb, wscr, lane);
            }
#undef P0W_DESC
            if (bid < 2) { __syncthreads();     float vn_[32]; const P0Desc dn{w_ine, WINE, n_mix, D, EVEN_IN, NES, 0, 0, gw * (NES / 32) + 96}; p0_load(dn, vn_, lane); p0_store(dn, vn_, scr, lane); }
        }
        __syncthreads();
        float* wd = (float*)lds;
        for (int idx = tid; idx < 8192; idx += NTHR) { const int k = idx >> 3, c = idx & 7; wd[idx] = w_ine[(size_t)k * EVEN_IN + 3072 + c] * n_mix[k]; }
        __syncthreads();
        f32x4 vn[4];
        if (gw < M) {
#pragma unroll
            for (int j = 0; j < 4; ++j) vn[j] = __builtin_nontemporal_load((const f32x4*)(x_p + (size_t)gw * D) + lane + 64 * j);
        }
        for (int m = gw; m < M; m += NGW) {
            f32x4 v[4]; float s = 0.f; float d8[8];
#pragma unroll
            for (int c = 0; c < 8; ++c) d8[c] = 0.f;
#pragma unroll
            for (int j = 0; j < 4; ++j) v[j] = vn[j];
            if (m + NGW < M) {
#pragma unroll
                for (int j = 0; j < 4; ++j) vn[j] = __builtin_nontemporal_load((const f32x4*)(x_p + (size_t)(m + NGW) * D) + lane + 64 * j);
            }
#pragma unroll
            for (int j = 0; j < 4; ++j) s += (v[j].x * v[j].x + v[j].y * v[j].y) + (v[j].z * v[j].z + v[j].w * v[j].w);
#pragma unroll
            for (int j = 0; j < 4; ++j)
#pragma unroll
                for (int e = 0; e < 4; ++e) {
                    const int k = 256 * j + 4 * lane + e; const f32x4 w0 = *(const f32x4*)(wd + k * 8), w1 = *(const f32x4*)(wd + k * 8 + 4); const float xv = v[j][e];
                    d8[0] += xv * w0.x; d8[1] += xv * w0.y; d8[2] += xv * w0.z; d8[3] += xv * w0.w; d8[4] += xv * w1.x; d8[5] += xv * w1.y; d8[6] += xv * w1.z; d8[7] += xv * w1.w;
                }
            s = wave_sum(s);
#pragma unroll
            for (int c = 0; c < 8; ++c) d8[c] = wave_sum(d8[c]);
            const float rstd = 1.0f / sqrtf(s * (1.0f / D) + RMS_EPS);
            GAS unsigned long long* o8 = (GAS unsigned long long*)(HB + (size_t)m * D) + lane;
#pragma unroll
            for (int j = 0; j < 4; ++j) o8[64 * j] = (unsigned long long)pk2(v[j].x, v[j].y) | ((unsigned long long)pk2(v[j].z, v[j].w) << 32);
            if (lane < 4) *(f32x4*)(SSQ + (size_t)m * 16 + lane * 4) = (f32x4){lane == 0 ? s : 0.f, 0.f, 0.f, 0.f};
            if (lane < 2) *(f32x4*)(DTRAW + (size_t)m * 8 + lane * 4) = lane == 0 ? (f32x4){d8[0] * rstd, d8[1] * rstd, d8[2] * rstd, d8[3] * rstd} : (f32x4){d8[4] * rstd, d8[5] * rstd, d8[6] * rstd, d8[7] * rstd};
        }
        __syncthreads();
        if (rep + 1 < NREP(0)) xcd_barrier(bar);
    }
    SEAM(0);
    PROBE_STAMP(1);
    if (IN(1)) for (int rep = 0; rep < NREP(1); ++rep) {
        pg8::Gemm g{HB, WINE, M, NE, D}; pg8::StaticOrder S; S.init(M, NE, G, bid);
        auto pre = [&]() { RSTAB_FILL(S, SSQ, 16, 1.0f / 1024.0f); };
        typedef pg8::EpiBf16S<0, 1> Epi; Epi E{QKV, NE, rstab, out + O_KP, out + O_VP, out + O_CP};
        if (bid < NES / 32) skinny_unit(lds, WINE, D, bid, 0, BuildNorm{x_s}, SEpiInEven{S_IN, out + O_KS, out + O_VS});
        pg8::gemm_phase<Epi, pg8::StaticOrder, true, true>(ldsl, g, S, E, pre);
        if (rep + 1 < NREP(1)) xcd_barrier(bar);
    }
    SEAM(1);
    PROBE_STAMP(2);
    if (IN(2)) for (int rep = 0; rep < NREP(2); ++rep) {
        conv_prepass(QKV, conv_w, conv_b, HID  , bid);
        asm volatile("s_waitcnt vmcnt(0)" ::: "memory");
        __syncthreads();
        if (tid == 0) { __builtin_amdgcn_fence(__ATOMIC_RELEASE, "agent"); asm volatile("s_waitcnt vmcnt(0)" ::: "memory"); __hip_atomic_fetch_add(ctl + CW_CONV + 256 * rep, 1u, __ATOMIC_RELAXED, __HIP_MEMORY_SCOPE_AGENT); }
        ssd_sample_unit(lds, S_IN, s_conv, s_ssm, conv_w, conv_b, dt_bias, a_log, d_skip, out + O_CS, out + O_SS, S_YG, bid >> 3, bid & 7);
#define PULL(cw_) ({ __syncthreads(); if (tid == 0) MISC[16] = __hip_atomic_fetch_add(ctl + (cw_) + 256 * rep, 1u, __ATOMIC_RELAXED, __HIP_MEMORY_SCOPE_AGENT); __syncthreads(); (int)MISC[16]; })
#define RUN_DEC() for (int item; (item = PULL(CW_QDEC)) < MS * NDP; ) decode_unit(lds, S_IN, cache_k, cache_v, ptab, sb_bias, S_OPART, S_LPART, item / NDP, item % NDP)
        if ((bid & 1) == 0) RUN_DEC();
        if (rep + 1 < NREP(2)) xcd_barrier(bar);
    }
    PROBE_STAMP(3);
    if (IN(3)) for (int rep = 0; rep < NREP(3); ++rep) {
        PROBE_STAMP1(20);
        if (bid & 1) {
            const int o_ = bid >> 1, gid_ = (o_ & 3) * 4 + (o_ >> 5), mem_ = (o_ >> 2) & 7;
            const int item = ((gid_ >> 1) << 4) | (((gid_ & 1) * 4 + (mem_ >> 1)) << 1) | (mem_ & 1);
            if (tid == 0) { unsigned sp_ = 0; while (__hip_atomic_load(ctl + CW_CONV + 256 * rep, __ATOMIC_RELAXED, __HIP_MEMORY_SCOPE_AGENT) < (unsigned)G && ++sp_ < (1u << 22)) __builtin_amdgcn_s_sleep(2);
                            __builtin_amdgcn_fence(__ATOMIC_ACQUIRE, "agent"); asm volatile("s_waitcnt vmcnt(0)" ::: "memory"); }
            __syncthreads();
            ssd_unit2(lds, HID  , QKV, DTRAW, dt_bias, a_log, d_skip, MIX, SSM, out + O_SP, item >> 4, (item >> 1) & 7, item & 1);
        }
        PROBE_STAMP1(21);
        for (int item; (item = PULL(CW_QATT)) < 512; ) { const int bh = item & 63; attn_unit_mfma(lds, QKV, sb_bias, MIX, bh >> 3, bh & 7, 7 - (item >> 6)); }
        PROBE_STAMP1(22);
        RUN_DEC();
        PROBE_STAMP1(23);
        __syncthreads();
        if (rep + 1 < NREP(3)) xcd_barrier(bar);
    }
#undef RUN_DEC
#undef PULL
    SEAM(3);
    PROBE_STAMP(4);
    if (IN(4)) for (int rep = 0; rep < NREP(4); ++rep) {
        pg8::Gemm g{MIX, WOUTE, M, D, D}; pg8::StaticOrder S; S.init(M, D, G, bid);
        auto pre = [&]() {
            pg8::Unit u0; if (S.next(0, u0) && tid < 256) {
                const f32x4* p = (const f32x4*)(SSM + (size_t)(u0.pm * 256 + tid) * 32);
                const float sm = (pg8::sum4(p[0]) + pg8::sum4(p[1])) + (pg8::sum4(p[2]) + pg8::sum4(p[3]));
                midtab[tid] = 1.0f / sqrtf(sm * (1.0f / 512.0f) + RMS_EPS);
            }
        };
        typedef pg8::EpiResid<0, 8, false, 2> Epi; Epi E{nullptr, HB, SSQ, nullptr, midtab};
        pg8::gemm_phase<Epi, pg8::StaticOrder, true, true>(ldsl, g, S, E, pre);
        if (bid < D / 32) skinny_unit(lds, WOUTE, D, bid, 0, BuildMixEven{S_YG, S_OPART, S_LPART}, SEpiResid{x_s, S_H});
        if (rep + 1 < NREP(4)) xcd_barrier(bar);
    }
    SEAM(4);
    PROBE_STAMP(5);
    if (IN(5)) for (int rep = 0; rep < NREP(5); ++rep) {
        pg8::Gemm g{HB, W1T, M, FF, D}; pg8::StaticOrder S; S.init(M, FF, G, bid);
        auto pre = [&]() { RSTAB_FILL(S, SSQ, 16, 1.0f / 1024.0f); };
        typedef pg8::EpiBf16S<1, 0> Epi; Epi E{HID, FF, rstab, nullptr, nullptr, nullptr};
        if (bid < FF / 32) skinny_unit(lds, W1T, D, bid, 0, BuildNorm{S_H}, SEpiRelu2{S_HID, FF});
        pg8::gemm_phase<Epi, pg8::StaticOrder, true, true>(ldsl, g, S, E, pre);
        if (rep + 1 < NREP(5)) xcd_barrier(bar);
    }
    SEAM(5);
    PROBE_STAMP(6);
    if (IN(6)) for (int rep = 0; rep < NREP(6); ++rep) {
        pg8::Gemm g{HID, W2T, M, D, FF}; pg8::StaticOrder S; S.init(M, D, G, bid);
        typedef pg8::EpiResid<0, 0, false, 2> Epi; Epi E{nullptr, HB, SSQ, nullptr, nullptr};
        if (bid < 4 * (D / 32)) skinny_unit(lds, W2T, FF, bid & 31, (bid >> 5) * 1024, BuildPlain{S_HID, FF}, SEpiAtomic{S_H});
        pg8::gemm_phase<Epi, pg8::StaticOrder, true, true>(ldsl, g, S, E);
        if (rep + 1 < NREP(6)) xcd_barrier(bar);
    }
    SEAM(6);
    PROBE_STAMP(7);
    if (IN(7)) for (int rep = 0; rep < NREP(7); ++rep) {
        pg8::Gemm g{HB, WINO, M, ODD_IN, D}; pg8::StaticOrder S; S.init(M, ODD_IN, G, bid);
        auto pre = [&]() { RSTAB_FILL(S, SSQ, 16, 1.0f / 1024.0f); };
        typedef pg8::EpiBf16S<0, 0> Epi; Epi E{HID, ODD_IN, rstab, nullptr, nullptr, nullptr};
        if (bid < ODD_IN / 32) skinny_unit(lds, WINO, D, bid, 0, BuildNorm{S_H}, SEpiStore{S_IN, ODD_IN});
        pg8::gemm_phase<Epi, pg8::StaticOrder, true, true>(ldsl, g, S, E, pre);
        if (rep + 1 < NREP(7)) xcd_barrier(bar);
    }
    SEAM(7);
    PROBE_STAMP(8);
    if (IN(8)) for (int rep = 0; rep < NREP(8); ++rep) {
        hgrn_prepass(HID, lb_raw, QKV  , QKV + (size_t)M * 1024  , (float*)(QKV + (size_t)2 * M * 1024)  , bid);
        hgrn_sample_unit(lds, S_IN, s_hg, lb_raw, out + O_GS, S_O, bid >> 3, bid & 7);
        if (rep + 1 < NREP(8)) xcd_barrier(bar);
    }
    SEAM(8);
    PROBE_STAMP(9);
    if (IN(9)) for (int rep = 0; rep < NREP(9); ++rep) {
        {
            const int bh = (bid & 7) | ((bid >> 5) << 3), vq = (bid >> 3) & 3;
            hgrn_unit2(lds, QKV, QKV + (size_t)M * 1024, (const float*)(QKV + (size_t)2 * M * 1024), HID, MIX, SSM, out + O_GP, bh >> 3, bh & 7, vq);
        }
        if (rep + 1 < NREP(9)) xcd_barrier(bar);
    }
    SEAM(9);
    PROBE_STAMP(10);
    if (IN(10)) for (int rep = 0; rep < NREP(10); ++rep) {
        pg8::Gemm g{MIX, WOUTO, M, D, D}; pg8::StaticOrder S; S.init(M, D, G, bid);
        auto pre = [&]() { RSTAB_FILL(S, SSM, 32, 1.0f / 1024.0f); };
        typedef pg8::EpiResid<32, 0, false, 2> Epi; Epi E{nullptr, HB, SSQ, rstab, nullptr};
        pg8::gemm_phase<Epi, pg8::StaticOrder, true, true>(ldsl, g, S, E, pre);
        if (bid < D / 32) skinny_unit(lds, WOUTO, D, bid, 0, BuildMixOdd{S_O, S_IN}, SEpiResid{S_H, S_H});
        if (rep + 1 < NREP(10)) xcd_barrier(bar);
    }
    SEAM(10);
    PROBE_STAMP(11);
    if (IN(11)) for (int rep = 0; rep < NREP(11); ++rep) {
        pg8::Gemm g{HB, W1T + (size_t)FF * D, M, FF, D}; pg8::StaticOrder S; S.init(M, FF, G, bid);
        auto pre = [&]() { RSTAB_FILL(S, SSQ, 16, 1.0f / 1024.0f); };
        typedef pg8::EpiBf16S<1, 0> Epi; Epi E{HID, FF, rstab, nullptr, nullptr, nullptr};
        if (bid < FF / 32) skinny_unit(lds, W1T + (size_t)FF * D, D, bid, 0, BuildNorm{S_H}, SEpiRelu2{S_HID, FF});
        pg8::gemm_phase<Epi, pg8::StaticOrder, true, true>(ldsl, g, S, E, pre);
        if (rep + 1 < NREP(11)) xcd_barrier(bar);
    }
    SEAM(11);
    PROBE_STAMP(12);
    if (IN(12)) for (int rep = 0; rep < NREP(12); ++rep) {
        pg8::Gemm g{HID, W2T + (size_t)D * FF, M, D, FF}; pg8::StaticOrder S; S.init(M, D, G, bid);
        typedef pg8::EpiResid<0, 0, false, 2> Epi; Epi E{nullptr, HB, SSQ, nullptr, nullptr};
        if (bid < 4 * (D / 32)) skinny_unit(lds, W2T + (size_t)D * FF, FF, bid & 31, (bid >> 5) * 1024, BuildPlain{S_HID, FF}, SEpiAtomic{S_H});
        pg8::gemm_phase<Epi, pg8::StaticOrder, true, true>(ldsl, g, S, E);
        if (rep + 1 < NREP(12)) xcd_barrier(bar);
    }
    SEAM(12);
    PROBE_STAMP(13);
    if (IN(13)) for (int rep = 0; rep < NREP(13); ++rep) {
        const int gw = bid * NWAVES + wave, NGW = G * NWAVES;
        f32x4 wf[4];
#pragma unroll
        for (int j = 0; j < 4; ++j) wf[j] = *((const f32x4*)n_fin + lane + 64 * j);
        u32x2v vnx[4]; f32x4 spn[4];
        if (gw < M) {
#pragma unroll
            for (int j = 0; j < 4; ++j) { vnx[j] = __builtin_nontemporal_load((const u32x2v*)(HB + (size_t)gw * D) + lane + 64 * j); spn[j] = ((const f32x4*)(SSQ + (size_t)gw * 16))[j]; }
        }
        for (int m = gw; m < M; m += NGW) {
            u32x2v v[4]; f32x4 sp[4];
#pragma unroll
            for (int j = 0; j < 4; ++j) { v[j] = vnx[j]; sp[j] = spn[j]; }
            if (m + NGW < M) {
#pragma unroll
                for (int j = 0; j < 4; ++j) { vnx[j] = __builtin_nontemporal_load((const u32x2v*)(HB + (size_t)(m + NGW) * D) + lane + 64 * j); spn[j] = ((const f32x4*)(SSQ + (size_t)(m + NGW) * 16))[j]; }
            }
            const float ssum = (pg8::sum4(sp[0]) + pg8::sum4(sp[1])) + (pg8::sum4(sp[2]) + pg8::sum4(sp[3]));
            const float rstd = 1.0f / sqrtf(ssum * (1.0f / D) + RMS_EPS);
            float* dst = out + O_YP + (size_t)m * D;
#pragma unroll
            for (int j = 0; j < 4; ++j) { const f32x4 x = (f32x4){bflo(v[j].x), bfhi(v[j].x), bflo(v[j].y), bfhi(v[j].y)}; __builtin_nontemporal_store(x * rstd * wf[j], (f32x4*)dst + lane + 64 * j); }
        }
#if defined(PROBE_A0)
        float probe_eps = 0.f;
        {
            const unsigned long long* ts = (const unsigned long long*)(ctl + CW_TS);
            const float usB = (float)(long long)(ts[PROBE_B1] - ts[PROBE_B0]) * 0.01f, usA = (float)(long long)(ts[PROBE_A1] - ts[PROBE_A0]) * 0.01f;
            probe_eps = sqrtf(1e-6f * usB);
            if (bid == 0 && tid == 0) out[O_KS] += 0.01f * usA;
        }
#endif
        if (gw < MS) {
            const float* src = S_H + (size_t)gw * D; float* dst = out + O_YS + (size_t)gw * D;
            f32x4 v[4]; float sq = 0.f;
#pragma unroll
            for (int j = 0; j < 4; ++j) { v[j] = *((const f32x4*)src + lane + 64 * j); sq += (v[j].x * v[j].x + v[j].y * v[j].y) + (v[j].z * v[j].z + v[j].w * v[j].w); }
            sq = wave_sum(sq);
            const float rstd = 1.0f / sqrtf(sq * (1.0f / D) + RMS_EPS);
#pragma unroll
            for (int j = 0; j < 4; ++j) {
                f32x4 yv = v[j] * rstd * wf[j];
#if defined(PROBE_A0)
                yv = yv + probe_eps;
#endif
                *((f32x4*)dst + lane + 64 * j) = yv;
            }
        }
    }
#undef IN
#undef SEAM
#undef x_p
#undef x_s
#undef cache_k
#undef cache_v
#undef ptab
#undef s_conv
#undef s_ssm
#undef s_hg
#undef n_mix
#undef n_ffn
#undef n_fin
#undef w_ine
#undef sb_bias
#undef conv_w
#undef conv_b
#undef dt_bias
#undef a_log
#undef d_skip
#undef ssd_norm
#undef w_oute
#undef w_ino
#undef lb_raw
#undef hg_norm
#undef w_outo
#undef w_ff1
#undef w_ff2
#undef out
#undef WINE
#undef WOUTE
#undef WINO
#undef WOUTO
#undef W1T
#undef W2T
#undef HB
#undef H
#undef SSQ
#undef DTRAW
#undef SSM
#undef MIX
#undef QKV
#undef HID
#undef S_H
#undef S_IN
#undef S_HID
#undef S_YG
#undef S_OPART
#undef S_LPART
#undef S_O
}

constexpr int N_PHASES = 14;
#ifndef MK_SPLIT
#define MK_SPLIT 0
#endif
extern "C" void kernel_launch(void* const* d_in, const int* in_sizes, int n_in, void* d_out, int out_size, void* d_ws, size_t ws_size, hipStream_t stream) {
    static int grid = 0;
    if (grid == 0) {
        if (n_in != N_IN || (size_t)out_size != O_END || ws_size < WS_END) { fprintf(stderr, "kernel_launch: unexpected sizes n_in %d out %d ws %zu\n", n_in, out_size, ws_size); if (ws_size < WS_END) { grid = -1; return; } }
        int dev = 0, cus = 0, per_cu = 0;
        if (hipGetDevice(&dev) != hipSuccess || hipDeviceGetAttribute(&cus, hipDeviceAttributeMultiprocessorCount, dev) != hipSuccess) { grid = -1; return; }
        if (hipFuncSetAttribute((const void*)mk_fwd, hipFuncAttributeMaxDynamicSharedMemorySize, LDS_BYTES) != hipSuccess) { fprintf(stderr, "kernel_launch: hipFuncSetAttribute failed\n"); grid = -1; return; }
        if (hipOccupancyMaxActiveBlocksPerMultiprocessor(&per_cu, (const void*)mk_fwd, NTHR, LDS_BYTES) != hipSuccess || per_cu < 1) fprintf(stderr, "kernel_launch: occupancy query says %d\n", per_cu);
        (void)hipGetLastError();
        grid = cus;
        if (grid != 256) fprintf(stderr, "kernel_launch: %d CUs (built for 256)\n", grid);
    }
    if (grid < 0) return;
    (void)hipMemsetAsync((char*)d_ws + WS_CTL, 0, CTL_ZERO_BYTES, stream);
    Args a{};
    for (int i = 0; i < N_IN; ++i) a.in[i] = d_in[i];
    a.out = (float*)d_out; a.ws = (unsigned char*)d_ws;
#if MK_SPLIT
    for (int p = 0; p < N_PHASES; ++p) { a.ph_lo = p; a.ph_hi = p + 1; hipLaunchKernelGGL(mk_fwd, dim3(grid), dim3(NTHR), LDS_BYTES, stream, a); }
#else
    a.ph_lo = 0; a.ph_hi = N_PHASES; hipLaunchKernelGGL(mk_fwd, dim3(grid), dim3(NTHR), LDS_BYTES, stream, a);
#endif
}
```
